# Optimizing an MI355X kernel written in HIP

```python
import jax, jax.numpy as jnp
from jax import lax
import numpy as np

D_MODEL = 2048
BATCH = 2
SEQ = 4096
DEPTH = 1

CHUNK = 64
RET_WIDTH = D_MODEL // 2
ATT_WIDTH = D_MODEL - RET_WIDTH
RET_HEADS = 8
ATT_HEADS = 8
RET_HEAD_DIM = RET_WIDTH // RET_HEADS
ATT_HEAD_DIM = ATT_WIDTH // ATT_HEADS
MIX_WIDTH = RET_WIDTH + ATT_WIDTH
IN_WIDTH = 4 * RET_WIDTH + 3 * ATT_WIDTH
LEFT_CHUNKS = 8
BAND = (LEFT_CHUNKS + 1) * CHUNK
REL_CLIP = 128
REL_SIZE = (CHUNK - 1) + REL_CLIP + 1
D_FF = 4 * D_MODEL
ROPE_BASE = 10000.0
EPS = 1e-6
GN_EPS = 1e-5

kernel_name = "hymba_retention_chunkattn_sqrelu_block"


def rms_norm(x, g):
    xf = x.astype(jnp.float32)
    y = xf * lax.rsqrt(jnp.mean(xf * xf, axis=-1, keepdims=True) + EPS)
    return (y * g.astype(jnp.float32)).astype(x.dtype)


def rotary(x, pos):
    half = x.shape[-1] // 2
    inv_freq = ROPE_BASE ** (-jnp.arange(half, dtype=jnp.float32) / half)
    ang = pos[:, None] * inv_freq[None, :]
    cos = jnp.cos(ang)[None, :, None, :]
    sin = jnp.sin(ang)[None, :, None, :]
    xf = x.astype(jnp.float32)
    x1, x2 = xf[..., :half], xf[..., half:]
    out = jnp.concatenate([x1 * cos - x2 * sin, x1 * sin + x2 * cos], axis=-1)
    return out.astype(x.dtype)


def retention(q, k, v):
    b, s, h, d = q.shape
    nc = s // CHUNK
    f32 = jnp.float32
    q = q.astype(f32).reshape(b, nc, CHUNK, h, d)
    k = k.astype(f32).reshape(b, nc, CHUNK, h, d) * (d ** -0.5)
    v = v.astype(f32).reshape(b, nc, CHUNK, h, d)
    log_g = jnp.log1p(-jnp.exp2(-(5.0 + jnp.arange(h, dtype=f32))))
    pos = jnp.arange(CHUNK, dtype=f32)
    intra_decay = jnp.exp(log_g[:, None, None] * jnp.abs(pos[:, None] - pos[None, :]))
    scores = jnp.einsum('bnihd,bnjhd->bnhij', q, k) * intra_decay
    intra = jnp.einsum('bnhij,bnjhe->bnihe', scores, v)
    k_dec = jnp.exp(log_g[None, :] * (CHUNK - 1.0 - pos)[:, None])
    contrib = jnp.einsum('bnjhd,bnjhe->nbhde', k * k_dec[:, :, None], v)
    chunk_dec = jnp.exp(log_g * CHUNK)[:, None, None]

    def step(state, c):
        return chunk_dec * state + c, state

    _, prev = lax.scan(step, jnp.zeros_like(contrib[0]), contrib)
    q_dec = jnp.exp(log_g[None, :] * (pos + 1.0)[:, None])
    cross = jnp.einsum('bnihd,nbhde->bnihe', q * q_dec[:, :, None], prev)
    return (intra + cross).reshape(b, s, h, d)


def head_group_norm(y, g):
    b, s, h, d = y.shape
    mu = jnp.mean(y, axis=-1, keepdims=True)
    var = jnp.mean(jnp.square(y - mu), axis=-1, keepdims=True)
    yn = (y - mu) * lax.rsqrt(var + GN_EPS) * g.astype(jnp.float32).reshape(h, d)
    return yn.reshape(b, s, h * d)


def chunk_attention(q, k, v, rel_bias):
    b, s, h, d = q.shape
    nc = s // CHUNK
    q = q.reshape(b, nc, CHUNK, h, d)
    pad = ((0, 0), (LEFT_CHUNKS, 0), (0, 0), (0, 0), (0, 0))
    kp = jnp.pad(k.reshape(b, nc, CHUNK, h, d), pad)
    vp = jnp.pad(v.reshape(b, nc, CHUNK, h, d), pad)
    band_idx = jnp.arange(nc)[:, None] + jnp.arange(LEFT_CHUNKS + 1)[None, :]
    kb = jnp.take(kp, band_idx, axis=1).reshape(b, nc, BAND, h, d)
    vb = jnp.take(vp, band_idx, axis=1).reshape(b, nc, BAND, h, d)
    scores = jnp.einsum('bnihd,bnjhd->bnhij', q, kb,
                        preferred_element_type=jnp.float32) * (d ** -0.5)
    qi = jnp.arange(CHUNK)[:, None]
    kj = jnp.arange(BAND)[None, :]
    rel = jnp.clip(qi + LEFT_CHUNKS * CHUNK - kj, -(CHUNK - 1), REL_CLIP) + (CHUNK - 1)
    bias = rel_bias.astype(jnp.float32)[:, rel]
    valid = (jnp.arange(nc)[:, None] - LEFT_CHUNKS + kj // CHUNK) >= 0
    scores = jnp.where(valid[None, :, None, None, :], scores + bias[None, None], -1e30)
    probs = jax.nn.softmax(scores, axis=-1).astype(v.dtype)
    out = jnp.einsum('bnhij,bnjhd->bnihd', probs, vb)
    return out.reshape(b, s, h * d)


def setup_inputs(seed: int = 0) -> dict:
    key = jax.random.key(seed)
    ks = jax.random.split(key, 12)
    f32 = jnp.float32
    nrm = lambda k, shape, scale: jax.random.normal(k, shape, f32) * scale
    return {
        "x": jax.random.normal(ks[0], (BATCH, SEQ, D_MODEL), f32),
        "norm1_g": 1.0 + nrm(ks[1], (DEPTH, D_MODEL), 0.05),
        "w_in": nrm(ks[2], (DEPTH, D_MODEL, IN_WIDTH), D_MODEL ** -0.5),
        "ret_norm_g": 1.0 + nrm(ks[3], (DEPTH, RET_WIDTH), 0.05),
        "q_norm_g": 1.0 + nrm(ks[4], (DEPTH, ATT_HEAD_DIM), 0.05),
        "k_norm_g": 1.0 + nrm(ks[5], (DEPTH, ATT_HEAD_DIM), 0.05),
        "rel_bias": nrm(ks[6], (DEPTH, ATT_HEADS, REL_SIZE), 0.2),
        "w_out": nrm(ks[7], (DEPTH, MIX_WIDTH, D_MODEL), MIX_WIDTH ** -0.5),
        "norm2_g": 1.0 + nrm(ks[8], (DEPTH, D_MODEL), 0.05),
        "w_ff1": nrm(ks[9], (DEPTH, D_MODEL, D_FF), D_MODEL ** -0.5),
        "w_ff2": nrm(ks[10], (DEPTH, D_FF, D_MODEL), D_FF ** -0.5),
    }


def reference(x, norm1_g, w_in, ret_norm_g, q_norm_g, k_norm_g, rel_bias,
              w_out, norm2_g, w_ff1, w_ff2):
    b, s, _ = x.shape
    pos = jnp.arange(s, dtype=jnp.float32)
    split_at = [RET_WIDTH, 2 * RET_WIDTH, 3 * RET_WIDTH, 4 * RET_WIDTH,
                4 * RET_WIDTH + ATT_WIDTH, 4 * RET_WIDTH + 2 * ATT_WIDTH]
    for layer in range(DEPTH):
        h = rms_norm(x, norm1_g[layer])
        proj = h @ w_in[layer]
        rq, rk, rv, rg, aq, ak, av = jnp.split(proj, split_at, axis=-1)
        rq = rotary(rq.reshape(b, s, RET_HEADS, RET_HEAD_DIM), pos)
        rk = rotary(rk.reshape(b, s, RET_HEADS, RET_HEAD_DIM), pos)
        rv = rv.reshape(b, s, RET_HEADS, RET_HEAD_DIM)
        ret = head_group_norm(retention(rq, rk, rv), ret_norm_g[layer])
        ret = (jax.nn.silu(rg.astype(jnp.float32)) * ret).astype(x.dtype)
        aq = rms_norm(aq.reshape(b, s, ATT_HEADS, ATT_HEAD_DIM), q_norm_g[layer])
        ak = rms_norm(ak.reshape(b, s, ATT_HEADS, ATT_HEAD_DIM), k_norm_g[layer])
        av = av.reshape(b, s, ATT_HEADS, ATT_HEAD_DIM)
        att = chunk_attention(aq, ak, av, rel_bias[layer])
        x = x + jnp.concatenate([ret, att], axis=-1) @ w_out[layer]
        h = rms_norm(x, norm2_g[layer])
        x = x + jnp.square(jax.nn.relu(h @ w_ff1[layer])) @ w_ff2[layer]
    return x
```

```cpp
#include <hip/hip_runtime.h>
#include <cstdio>
#include <cstdint>
#include <cmath>
namespace pg8 {
#define PG8_LAS __attribute__((address_space(3)))
typedef unsigned short bf16_t;
typedef short bf16x8 __attribute__((ext_vector_type(8)));
typedef float f32x4 __attribute__((ext_vector_type(4)));
typedef unsigned u32x4 __attribute__((ext_vector_type(4)));
constexpr int BM = 256, BK = 64, HALF = 128, HTB = HALF * BK * 2  , STAGE_BYTES = 8 * HTB, NXCD = 8, WGM = 8;

__host__ __device__ __forceinline__ int lds_byte(int r, int c) { const int st = (r >> 4) * 2 + (c >> 5), rr = r & 15, cc = c & 31, ob = rr * 64 + cc * 2; return st * 1024 + (ob ^ (((ob >> 9) & 1) << 5)); }
__host__ __device__ __forceinline__ void stage_rc(int b, int& R, int& C) { const int st = b / 1024, sb = b % 1024, swz = sb ^ (((sb >> 9) & 1) << 5); R = (st >> 1) * 16 + swz / 64; C = (st & 1) * 32 + (swz % 64) / 2; }
__host__ __device__ __forceinline__ int perm32(int rho) { const int n = rho >> 4, i = rho & 15; return 8 * (i >> 2) + 4 * n + (i & 3); }

struct Unit { int pm, pn; };
struct Gemm { const bf16_t* A; const bf16_t* Bt; int M, N, K; };

struct StaticOrder {
    int nM, nN, nwg, G, c;
    __host__ __device__ void init(int M, int N, int G_, int c_) { nM = M / BM; nN = N / BM; nwg = nM * nN; G = G_; c = c_; }
    __host__ __device__ bool next(int i, Unit& u) const {
        const long L = (long)i * G + c; if (L >= nwg) return false;
        int wgid = (int)L; { const int q = nwg / NXCD, r = nwg % NXCD, xcd = wgid % NXCD, off = wgid / NXCD; wgid = (xcd < r ? xcd * (q + 1) : r * (q + 1) + (xcd - r) * q) + off; }
        const int nig = WGM * nN, gid = wgid / nig, fm = gid * WGM, gsz = (nM - fm) < WGM ? (nM - fm) : WGM;
        u.pm = fm + ((wgid % nig) % gsz); u.pn = (wgid % nig) / gsz; return true;
    }
    __device__ __forceinline__ void a_ready(const Unit&) const {}
    __device__ __forceinline__ void done(const Unit&) const {}
};

__device__ __forceinline__ unsigned cvt_pk_bf16(float lo, float hi) { unsigned r; asm volatile("v_cvt_pk_bf16_f32 %0, %1, %2" : "=v"(r) : "v"(lo), "v"(hi)); return r; }
typedef float f32x2 __attribute__((ext_vector_type(2)));
typedef unsigned u32x2 __attribute__((ext_vector_type(2)));
constexpr int PROJ_LD = 7168;
struct EpiProj {
    static constexpr bool PERM = true, AFTER_DRAIN = false;
    bf16_t* P; const float* cs; const float* qg; const float* kg; PG8_LAS float* xch;
    __device__ __forceinline__ void operator()(const f32x4 (&acc)[2][2][4][2], const Unit& u, int wr, int wc, int fr, int fq) const {
        const int sec = u.pn >> 2;
        const int row0 = u.pm * BM + wr * 64 + fr;
        const int ch0 = wc * 32 + 8 * fq;
        bf16_t* base = P + (size_t)row0 * PROJ_LD + u.pn * BM;
        if (sec <= 1) {
            const float ksc = (sec == 1) ? 0.08838834764831845f : 1.0f;
            const int p0 = ch0 >> 1;
#pragma unroll
            for (int ai = 0; ai < 2; ++ai)
#pragma unroll
                for (int m = 0; m < 4; ++m) {
                    const int r = row0 + ai * HALF + m * 16; const int pos = r & 4095;
                    const float* cp = cs + ((size_t)pos * 64 + p0) * 2;
                    const f32x4 ca = *(const f32x4*)cp, cb = *(const f32x4*)(cp + 4);
                    bf16_t* rp = base + (size_t)(ai * HALF + m * 16) * PROJ_LD;
#pragma unroll
                    for (int bj = 0; bj < 2; ++bj) {
                        const f32x4 v0 = acc[ai][bj][m][0] * ksc, v1 = acc[ai][bj][m][1] * ksc;
                        const float a0 = v0[0] * ca[0] - v0[1] * ca[1], b0 = v0[0] * ca[1] + v0[1] * ca[0];
                        const float a1 = v0[2] * ca[2] - v0[3] * ca[3], b1 = v0[2] * ca[3] + v0[3] * ca[2];
                        const float a2 = v1[0] * cb[0] - v1[1] * cb[1], b2 = v1[0] * cb[1] + v1[1] * cb[0];
                        const float a3 = v1[2] * cb[2] - v1[3] * cb[3], b3 = v1[2] * cb[3] + v1[3] * cb[2];
                        u32x2 w1, w2; w1.x = cvt_pk_bf16(a0, a1); w1.y = cvt_pk_bf16(a2, a3); w2.x = cvt_pk_bf16(b0, b1); w2.y = cvt_pk_bf16(b2, b3);
                        *(u32x2*)(rp + bj * HALF + p0) = w1; *(u32x2*)(rp + bj * HALF + 64 + p0) = w2;
                    }
                }
        } else if (sec == 4 || sec == 5) {
            const float* g = (sec == 4) ? qg : kg;
            const float osc = (sec == 4) ? (0.08838834764831845f * 1.4426950408889634f) : 1.0f;
            const f32x4 g0 = *(const f32x4*)(g + ch0) * osc, g1 = *(const f32x4*)(g + ch0 + 4) * osc;
#pragma unroll
            for (int ai = 0; ai < 2; ++ai)
#pragma unroll
                for (int m = 0; m < 4; ++m)
#pragma unroll
                    for (int bj = 0; bj < 2; ++bj) {
                        const f32x4 v0 = acc[ai][bj][m][0], v1 = acc[ai][bj][m][1];
                        float s = (v0[0] * v0[0] + v0[1] * v0[1]) + (v0[2] * v0[2] + v0[3] * v0[3]) + (v1[0] * v1[0] + v1[1] * v1[1]) + (v1[2] * v1[2] + v1[3] * v1[3]);
                        s += __shfl_xor(s, 16); s += __shfl_xor(s, 32);
                        if (fq == 0) xch[((ai * HALF + wr * 64 + m * 16 + fr) * 2 + bj) * 4 + wc] = s;
                    }
            asm volatile("s_waitcnt lgkmcnt(0)" ::: "memory"); __builtin_amdgcn_s_barrier(); asm volatile("" ::: "memory");
#pragma unroll
            for (int ai = 0; ai < 2; ++ai)
#pragma unroll
                for (int m = 0; m < 4; ++m) {
                    bf16_t* rp = base + (size_t)(ai * HALF + m * 16) * PROJ_LD;
#pragma unroll
                    for (int bj = 0; bj < 2; ++bj) {
                        const f32x4 pp = *(const PG8_LAS f32x4*)(xch + ((ai * HALF + wr * 64 + m * 16 + fr) * 2 + bj) * 4);
                        const float rstd = 1.0f / sqrtf(((pp[0] + pp[1]) + (pp[2] + pp[3])) * (1.0f / 128.0f) + 1e-6f);
                        const f32x4 v0 = acc[ai][bj][m][0] * rstd * g0, v1 = acc[ai][bj][m][1] * rstd * g1;
                        u32x4 w; w.x = cvt_pk_bf16(v0[0], v0[1]); w.y = cvt_pk_bf16(v0[2], v0[3]); w.z = cvt_pk_bf16(v1[0], v1[1]); w.w = cvt_pk_bf16(v1[2], v1[3]);
                        *(u32x4*)(rp + bj * HALF + ch0) = w;
                    }
                }
        } else {
#pragma unroll
            for (int ai = 0; ai < 2; ++ai)
#pragma unroll
                for (int m = 0; m < 4; ++m) {
                    bf16_t* rp = base + (size_t)(ai * HALF + m * 16) * PROJ_LD;
#pragma unroll
                    for (int bj = 0; bj < 2; ++bj) {
                        f32x4 v0 = acc[ai][bj][m][0], v1 = acc[ai][bj][m][1];
                        if (sec == 3) {
#pragma unroll
                            for (int j = 0; j < 4; ++j) { v0[j] = v0[j] * __builtin_amdgcn_rcpf(1.0f + __builtin_amdgcn_exp2f(-1.4426950408889634f * v0[j]));
                                                          v1[j] = v1[j] * __builtin_amdgcn_rcpf(1.0f + __builtin_amdgcn_exp2f(-1.4426950408889634f * v1[j])); }
                        }
                        u32x4 w; w.x = cvt_pk_bf16(v0[0], v0[1]); w.y = cvt_pk_bf16(v0[2], v0[3]); w.z = cvt_pk_bf16(v1[0], v1[1]); w.w = cvt_pk_bf16(v1[2], v1[3]);
                        *(u32x4*)(rp + bj * HALF + ch0) = w;
                    }
                }
        }
    }
};
struct EpiOut {
    static constexpr bool PERM = true, AFTER_DRAIN = false;
    const float* x; float* out; bf16_t* XG; const float* g2; float* rowss; int ldc;
    __device__ __forceinline__ void operator()(const f32x4 (&acc)[2][2][4][2], const Unit& u, int wr, int wc, int fr, int fq) const {
        const int row0 = u.pm * BM + wr * 64 + fr, col0 = u.pn * BM + wc * 32 + 8 * fq;
        f32x4 gv[2][2];
#pragma unroll
        for (int bj = 0; bj < 2; ++bj)
#pragma unroll
            for (int n = 0; n < 2; ++n) gv[bj][n] = *(const f32x4*)(g2 + col0 + bj * HALF + 4 * n);
#pragma unroll
        for (int ai = 0; ai < 2; ++ai)
#pragma unroll
            for (int m = 0; m < 4; ++m) {
                const int r = row0 + ai * HALF + m * 16; float ss = 0.f;
#pragma unroll
                for (int bj = 0; bj < 2; ++bj) {
                    const size_t off = (size_t)r * ldc + col0 + bj * HALF;
                    const f32x4 y0 = *(const f32x4*)(x + off) + acc[ai][bj][m][0], y1 = *(const f32x4*)(x + off + 4) + acc[ai][bj][m][1];
                    *(f32x4*)(out + off) = y0; *(f32x4*)(out + off + 4) = y1;
                    ss += (y0[0] * y0[0] + y0[1] * y0[1]) + (y0[2] * y0[2] + y0[3] * y0[3]) + (y1[0] * y1[0] + y1[1] * y1[1]) + (y1[2] * y1[2] + y1[3] * y1[3]);
                    const f32x4 z0 = y0 * gv[bj][0], z1 = y1 * gv[bj][1];
                    u32x4 w; w.x = cvt_pk_bf16(z0[0], z0[1]); w.y = cvt_pk_bf16(z0[2], z0[3]); w.z = cvt_pk_bf16(z1[0], z1[1]); w.w = cvt_pk_bf16(z1[2], z1[3]);
                    *(u32x4*)(XG + off) = w;
                }
                ss += __shfl_xor(ss, 16); ss += __shfl_xor(ss, 32);
                if (fq == 0) rowss[(size_t)r * 32 + u.pn * 4 + wc] = ss;
            }
    }
};
struct EpiRelu2 {
    static constexpr bool PERM = true, AFTER_DRAIN = false;
    bf16_t* O; int ldc;
    __device__ __forceinline__ void operator()(const f32x4 (&acc)[2][2][4][2], const Unit& u, int wr, int wc, int fr, int fq) const {
        const int row0 = u.pm * BM + wr * 64 + fr, col0 = u.pn * BM + wc * 32 + 8 * fq;
#pragma unroll
        for (int ai = 0; ai < 2; ++ai)
#pragma unroll
            for (int m = 0; m < 4; ++m) {
                bf16_t* rp = O + (size_t)(row0 + ai * HALF + m * 16) * ldc + col0;
#pragma unroll
                for (int bj = 0; bj < 2; ++bj) {
                    f32x4 v0 = acc[ai][bj][m][0], v1 = acc[ai][bj][m][1];
#pragma unroll
                    for (int j = 0; j < 4; ++j) { const float a = fmaxf(v0[j], 0.f), b = fmaxf(v1[j], 0.f); v0[j] = a * a; v1[j] = b * b; }
                    u32x4 w; w.x = cvt_pk_bf16(v0[0], v0[1]); w.y = cvt_pk_bf16(v0[2], v0[3]); w.z = cvt_pk_bf16(v1[0], v1[1]); w.w = cvt_pk_bf16(v1[2], v1[3]);
                    *(u32x4*)(rp + bj * HALF) = w;
                }
            }
    }
};
struct EpiFinal {
    static constexpr bool PERM = false, AFTER_DRAIN = false;
    float* out; const float* rowss; int ldc;
    __device__ __forceinline__ void operator()(const f32x4 (&acc)[2][2][4][2], const Unit& u, int wr, int wc, int fr, int fq) const {
        const int row0 = u.pm * BM + wr * 64 + fr, col0 = u.pn * BM + wc * 32 + 4 * fq;
#pragma unroll
        for (int ai = 0; ai < 2; ++ai)
#pragma unroll
            for (int m = 0; m < 4; ++m) {
                const int r = row0 + ai * HALF + m * 16;
                const f32x4* rs = (const f32x4*)(rowss + (size_t)r * 32);
                f32x4 s4 = rs[0];
#pragma unroll
                for (int j = 1; j < 8; ++j) s4 += rs[j];
                const float r2 = 1.0f / (((s4[0] + s4[1]) + (s4[2] + s4[3])) * (1.0f / 2048.0f) + 1e-6f);
#pragma unroll
                for (int bj = 0; bj < 2; ++bj)
#pragma unroll
                    for (int n = 0; n < 2; ++n) {
                        float* p = out + (size_t)r * ldc + col0 + bj * HALF + n * 16;
                        *(f32x4*)p = *(const f32x4*)p + acc[ai][bj][m][n] * r2;
                    }
            }
    }
};
template <class Epi, class Sched, bool ALIGN_EPI = false, bool SP2 = false>
__device__ __forceinline__ void gemm_phase(PG8_LAS unsigned char* lds, const Gemm g, const Sched& S, const Epi& E) {
    const int tid = threadIdx.x, wid = __builtin_amdgcn_readfirstlane(tid >> 6), lane = tid & 63, wr = wid >> 2, wc = wid & 3, fr = lane & 15, fq = lane >> 4;
    const int K = g.K, nt = K / BK;
    unsigned voffA[2], voffB[2];
#pragma unroll
    for (int i = 0; i < 2; ++i) { int R, C; stage_rc(tid * 16 + i * 8192, R, C); const int Rb = Epi::PERM ? ((R & ~31) + perm32(R & 31)) : R;
        voffA[i] = (unsigned)(R * K + C) * 2u; voffB[i] = (unsigned)(Rb * K + C) * 2u; }
    const size_t kstep = (size_t)(BK * 2);
    const size_t hstep = (size_t)HALF * K * 2;
    const size_t tstep = 2 * hstep;
    const unsigned ldsw = (unsigned)wid * 1024u;
    const int aoff = lds_byte(wr * 64 + fr, fq * 8), boff = lds_byte(wc * 32 + fr, fq * 8);
#define PG8_SA(b, h) (((b) * 2 + (h)) * HTB)
#define PG8_SB(b, h) ((4 + (b) * 2 + (h)) * HTB)
#define PG8_STAGE(bufoff, gbase, voff) do { _Pragma("unroll") for (int _i = 0; _i < 2; ++_i) \
        __builtin_amdgcn_global_load_lds((const unsigned*)((const char*)(gbase) + (voff)[_i]), (PG8_LAS unsigned*)(lds + (bufoff) + ldsw + _i * 8192), 16, 0, 0); } while (0)
#define PG8_LDA(dst, b, h) do { _Pragma("unroll") for (int m = 0; m < 4; ++m) _Pragma("unroll") for (int k = 0; k < 2; ++k) dst[m][k] = *(const PG8_LAS bf16x8*)(lds + PG8_SA(b, h) + aoff + m * 2048 + k * 1024); } while (0)
#define PG8_LDB(dst, b, h) do { _Pragma("unroll") for (int n = 0; n < 2; ++n) _Pragma("unroll") for (int k = 0; k < 2; ++k) dst[n][k] = *(const PG8_LAS bf16x8*)(lds + PG8_SB(b, h) + boff + n * 2048 + k * 1024); } while (0)
#define PG8_MMA(ai, bj, At, Bt) do { __builtin_amdgcn_s_setprio(1); _Pragma("unroll") for (int m = 0; m < 4; ++m) _Pragma("unroll") for (int n = 0; n < 2; ++n) _Pragma("unroll") for (int k = 0; k < 2; ++k) \
        acc[ai][bj][m][n] = __builtin_amdgcn_mfma_f32_16x16x32_bf16(Bt[n][k], At[m][k], acc[ai][bj][m][n], 0, 0, 0); __builtin_amdgcn_s_setprio(0); } while (0)
#define PG8_WAIT_V(n) asm volatile("s_waitcnt vmcnt(" #n ")" ::: "memory")
#define PG8_WAIT_L(n) asm volatile("s_waitcnt lgkmcnt(" #n ")" ::: "memory")
#define PG8_BAR __builtin_amdgcn_s_barrier()
#define PG8_SCHED __builtin_amdgcn_sched_barrier(0)
    Unit cur, nxt; int ui = 0;
    if (!S.next(0, cur)) return;
    f32x4 acc[2][2][4][2];
#pragma unroll
    for (int a = 0; a < 2; ++a)
#pragma unroll
        for (int b = 0; b < 2; ++b)
#pragma unroll
            for (int m = 0; m < 4; ++m)
#pragma unroll
                for (int n = 0; n < 2; ++n) acc[a][b][m][n] = (f32x4){0.f, 0.f, 0.f, 0.f};
    bf16x8 At[4][2], B0[2][2], B1[2][2];
    const char* cA = (const char*)g.A + (size_t)cur.pm * tstep; const char* cB = (const char*)g.Bt + (size_t)cur.pn * tstep;
    S.a_ready(cur);
    if constexpr (SP2) {
        PG8_STAGE(PG8_SB(0, 0), cB, voffB); PG8_STAGE(PG8_SB(0, 1), cB + hstep, voffB); PG8_STAGE(PG8_SA(0, 0), cA, voffA); PG8_STAGE(PG8_SA(0, 1), cA + hstep, voffA);
        if (wr == 1) PG8_BAR;
        PG8_WAIT_V(2); PG8_BAR;
        PG8_STAGE(PG8_SB(1, 0), cB + kstep, voffB); PG8_STAGE(PG8_SA(1, 0), cA + kstep, voffA); PG8_STAGE(PG8_SB(1, 1), cB + hstep + kstep, voffB);
        PG8_WAIT_V(6); PG8_BAR;
    } else {
        PG8_STAGE(PG8_SB(0, 0), cB, voffB); PG8_STAGE(PG8_SA(0, 0), cA, voffA); PG8_STAGE(PG8_SB(0, 1), cB + hstep, voffB); PG8_STAGE(PG8_SA(0, 1), cA + hstep, voffA);
        if (wr == 1) PG8_BAR;
        PG8_WAIT_V(4); PG8_BAR;
        PG8_STAGE(PG8_SB(1, 0), cB + kstep, voffB); PG8_STAGE(PG8_SA(1, 0), cA + kstep, voffA); PG8_STAGE(PG8_SB(1, 1), cB + hstep + kstep, voffB);
        PG8_WAIT_V(6); PG8_BAR;
    }
    for (;;) {
        const bool has_next = S.next(ui + 1, nxt);
        const char* nA = has_next ? (const char*)g.A + (size_t)nxt.pm * tstep : cA; const char* nB = has_next ? (const char*)g.Bt + (size_t)nxt.pn * tstep : cB;
        for (int t = 0; t < nt; t += 2) {
            const bool last = (t == nt - 2);
            const char* a1 = cA + (size_t)(t + 1) * kstep;
            const char* a2 = last ? nA : cA + (size_t)(t + 2) * kstep; const char* b2 = last ? nB : cB + (size_t)(t + 2) * kstep;
            const char* a3 = a2 + kstep; const char* b3 = b2 + kstep;
            if (last && has_next) S.a_ready(nxt);
            if constexpr (SP2) {
            PG8_LDB(B0, 0, 0); PG8_LDB(B1, 0, 1); PG8_SCHED; PG8_LDA(At, 0, 0); PG8_STAGE(PG8_SA(1, 1), a1 + hstep, voffA);
            PG8_WAIT_V(8); PG8_WAIT_L(0); PG8_BAR; PG8_MMA(0, 0, At, B0); PG8_MMA(0, 1, At, B1); PG8_BAR; PG8_SCHED;
            PG8_LDA(At, 0, 1); PG8_STAGE(PG8_SB(0, 0), b2, voffB); PG8_STAGE(PG8_SB(0, 1), b2 + hstep, voffB); PG8_STAGE(PG8_SA(0, 0), a2, voffA);
            PG8_WAIT_V(8); PG8_WAIT_L(0); PG8_BAR; PG8_MMA(1, 0, At, B0); PG8_MMA(1, 1, At, B1); PG8_BAR; PG8_SCHED;
            PG8_LDB(B0, 1, 0); PG8_LDB(B1, 1, 1); PG8_SCHED; PG8_LDA(At, 1, 0); PG8_STAGE(PG8_SA(0, 1), a2 + hstep, voffA);
            PG8_WAIT_V(8); PG8_WAIT_L(0); PG8_BAR; PG8_MMA(0, 0, At, B0); PG8_MMA(0, 1, At, B1); PG8_BAR; PG8_SCHED;
            PG8_LDA(At, 1, 1); PG8_STAGE(PG8_SB(1, 0), b3, voffB); PG8_STAGE(PG8_SB(1, 1), b3 + hstep, voffB); PG8_STAGE(PG8_SA(1, 0), a3, voffA);
            PG8_WAIT_V(8); PG8_WAIT_L(0); PG8_BAR; PG8_MMA(1, 0, At, B0); PG8_MMA(1, 1, At, B1); PG8_BAR; PG8_SCHED;
            } else {
            PG8_LDB(B0, 0, 0); PG8_SCHED; PG8_LDA(At, 0, 0); PG8_STAGE(PG8_SA(1, 1), a1 + hstep, voffA);
            PG8_WAIT_L(8); PG8_BAR; PG8_WAIT_L(0); PG8_MMA(0, 0, At, B0); PG8_BAR; PG8_SCHED;
            PG8_LDB(B1, 0, 1); PG8_STAGE(PG8_SB(0, 0), b2, voffB);
            PG8_BAR; PG8_WAIT_L(0); PG8_MMA(0, 1, At, B1); PG8_BAR;
            PG8_LDA(At, 0, 1); PG8_STAGE(PG8_SA(0, 0), a2, voffA);
            PG8_BAR; PG8_WAIT_L(0); PG8_MMA(1, 0, At, B0); PG8_BAR; PG8_SCHED;
            PG8_STAGE(PG8_SB(0, 1), b2 + hstep, voffB);
            PG8_WAIT_V(6); PG8_BAR; PG8_MMA(1, 1, At, B1); PG8_BAR;
            PG8_LDB(B0, 1, 0); PG8_SCHED; PG8_LDA(At, 1, 0); PG8_STAGE(PG8_SA(0, 1), a2 + hstep, voffA);
            PG8_WAIT_L(8); PG8_BAR; PG8_WAIT_L(0); PG8_MMA(0, 0, At, B0); PG8_BAR; PG8_SCHED;
            PG8_LDB(B1, 1, 1); PG8_STAGE(PG8_SB(1, 0), b3, voffB);
            PG8_BAR; PG8_WAIT_L(0); PG8_MMA(0, 1, At, B1); PG8_BAR;
            PG8_LDA(At, 1, 1); PG8_STAGE(PG8_SA(1, 0), a3, voffA);
            PG8_BAR; PG8_WAIT_L(0); PG8_MMA(1, 0, At, B0); PG8_BAR; PG8_SCHED;
            PG8_STAGE(PG8_SB(1, 1), b3 + hstep, voffB);
            PG8_WAIT_V(6); PG8_BAR; PG8_MMA(1, 1, At, B1); PG8_BAR;
            }
        }
        if constexpr (ALIGN_EPI) { if (wr == 0) PG8_BAR; }
        if constexpr (!Epi::AFTER_DRAIN) { E(acc, cur, wr, wc, fr, fq); S.done(cur); }
        if (!has_next) break;
#pragma unroll
        for (int a = 0; a < 2; ++a)
#pragma unroll
            for (int b = 0; b < 2; ++b)
#pragma unroll
                for (int m = 0; m < 4; ++m)
#pragma unroll
                    for (int n = 0; n < 2; ++n) acc[a][b][m][n] = (f32x4){0.f, 0.f, 0.f, 0.f};
        cur = nxt; cA = nA; cB = nB; ++ui;
        if constexpr (ALIGN_EPI) { if (wr == 1) PG8_BAR; }
    }
    PG8_WAIT_V(0);
    if constexpr (!ALIGN_EPI) { if (wr == 0) PG8_BAR; }
    PG8_BAR;
    if constexpr (Epi::AFTER_DRAIN) { E.fused(acc, cur, wr, wc, fr, fq, lds, wid, lane); S.done(cur); }
#undef PG8_SA
#undef PG8_SB
#undef PG8_STAGE
#undef PG8_LDA
#undef PG8_LDB
#undef PG8_MMA
#undef PG8_WAIT_V
#undef PG8_WAIT_L
#undef PG8_BAR
#undef PG8_SCHED
}
}
#define GAS __attribute__((address_space(1)))
#define LAS __attribute__((address_space(3)))
typedef unsigned short bf16;
typedef unsigned v4u __attribute__((ext_vector_type(4)));
typedef float f32x4 __attribute__((ext_vector_type(4)));
typedef short bf16x8 __attribute__((ext_vector_type(8)));
typedef GAS unsigned gu32;
typedef GAS unsigned long long gu64;
#define RLX_AGENT __ATOMIC_RELAXED, __HIP_MEMORY_SCOPE_AGENT
#define LDS_WAIT() asm volatile("s_waitcnt lgkmcnt(0)" ::: "memory")
#define VM_WAIT() asm volatile("s_waitcnt vmcnt(0)" ::: "memory")
__device__ __forceinline__ unsigned long long rt() { return __builtin_amdgcn_s_memrealtime(); }
__device__ __forceinline__ unsigned f2bf(float f) { unsigned u = __builtin_bit_cast(unsigned, f); return (u + 0x7fffu + ((u >> 16) & 1u)) >> 16; }
__device__ __forceinline__ unsigned pk2(float lo, float hi) { return f2bf(lo) | (f2bf(hi) << 16); }

#define XB_TMO      128
#define XB_XCNT(j)  (256  + 64 * (j))
#define XB_XSUB(j)  (1280 + 64 * (j))
#define XB_XGEN(j)  (2304 + 64 * (j))
#define XB_TOP      3328
#define XB_TOPGEN   3392
#define XCD_BAR_WORDS 3456
#define XB_SPIN_CAP (1u << 18)

__device__ __forceinline__ unsigned xb_ld(unsigned* p)              { return __hip_atomic_load(p, __ATOMIC_RELAXED, __HIP_MEMORY_SCOPE_AGENT); }
__device__ __forceinline__ unsigned xb_add(unsigned* p, unsigned v) { return __hip_atomic_fetch_add(p, v, __ATOMIC_RELAXED, __HIP_MEMORY_SCOPE_AGENT); }
__device__ __forceinline__ unsigned xb_xcc_id() { return (unsigned)__builtin_amdgcn_s_getreg((3 << 11) | 20) & 0xFu; }
#define XB_SPIN(cond, bar) do { unsigned _sp = 0; while (cond) { __builtin_amdgcn_s_sleep(1); \
    if ((++_sp & 255u) == 0u) { if (xb_ld(&(bar)[XB_TMO])) break; if (_sp > XB_SPIN_CAP) { atomicAdd(&(bar)[XB_TMO], 1u); break; } } } } while (0)

struct XcdBarrier {
    unsigned* bar; unsigned x;
    volatile LAS unsigned* st;
};

__device__ __forceinline__ XcdBarrier xcd_barrier_post(unsigned* bar, volatile LAS unsigned* st) {
    XcdBarrier b; b.bar = bar; b.x = xb_xcc_id(); b.st = st;
    if (threadIdx.x == 0) (void)xb_add(&bar[XB_XCNT(b.x)], 1u);
    return b;
}
__device__ __forceinline__ void xcd_barrier_complete(unsigned* bar, unsigned x, unsigned& nloc, unsigned& nx) {
    const unsigned G = gridDim.x * gridDim.y * gridDim.z;
    unsigned sum, cnt, mine, sp = 0u;
    for (;;) {
        sum = 0u; cnt = 0u; mine = 0u;
#pragma unroll
        for (unsigned j = 0; j < 16; ++j) { const unsigned c = xb_ld(&bar[XB_XCNT(j)]); sum += c; cnt += (c > 0u) ? 1u : 0u; mine = (j == x) ? c : mine; }
        if (sum == G) break;
        __builtin_amdgcn_s_sleep(1);
        if ((++sp & 255u) == 0u) { if (xb_ld(&bar[XB_TMO])) break; if (sp > XB_SPIN_CAP) { atomicAdd(&bar[XB_TMO], 1u); break; } }
    }
    nloc = mine > 0u ? mine : 1u; nx = cnt > 0u ? cnt : 1u;
}

__device__ __forceinline__ void xcd_barrier(const XcdBarrier& b) {
    asm volatile("s_waitcnt vmcnt(0)" ::: "memory");
    __syncthreads();
    if (threadIdx.x == 0) {
        unsigned* bar = b.bar;
        __builtin_amdgcn_s_waitcnt(0);
        unsigned nloc = b.st[0], nx = b.st[1];
        if (nloc == 0u) { xcd_barrier_complete(bar, b.x, nloc, nx); b.st[0] = nloc; b.st[1] = nx; }
        const unsigned old = xb_add(&bar[XB_XSUB(b.x)], 1u);
        const unsigned gen = old / nloc;
        if (old + 1u == (gen + 1u) * nloc) {
            __builtin_amdgcn_fence(__ATOMIC_RELEASE, "agent");
            asm volatile("s_waitcnt vmcnt(0)" ::: "memory");
            const unsigned og = xb_add(&bar[XB_TOP], 1u);
            const unsigned tg = og / nx;
            if (og + 1u == (tg + 1u) * nx) xb_add(&bar[XB_TOPGEN], 1u);
            else XB_SPIN(xb_ld(&bar[XB_TOPGEN]) == tg, bar);
            __builtin_amdgcn_fence(__ATOMIC_ACQUIRE, "agent");
            xb_add(&bar[XB_XGEN(b.x)], 1u);
            asm volatile("s_waitcnt vmcnt(0)" ::: "memory");
        } else {
            XB_SPIN(xb_ld(&bar[XB_XGEN(b.x)]) == gen, bar);
            __builtin_amdgcn_fence(__ATOMIC_ACQUIRE, "agent");
            asm volatile("s_waitcnt vmcnt(0)" ::: "memory");
        }
    }
    __syncthreads();
}
constexpr int NWAVES = 8;
#ifndef MK_N_LAUNCHES
#define MK_N_LAUNCHES 8
#endif
constexpr int PER_PHASE = 8;
constexpr int N_LAUNCHES = MK_N_LAUNCHES;

constexpr int BATCH = 2, SEQ = 4096, DM = 2048, M = BATCH * SEQ, NIN = 7168, DFF = 8192;
constexpr int CH = 64, NCH = SEQ / CH, NH = 8, HD = 128, LEFT = 8, RELSZ = 192;
constexpr float EPS = 1e-6f, GN_EPS = 1e-5f, LOG2E = 1.4426950408889634f;
constexpr int SEC_RQ = 0, SEC_RK = 1024, SEC_RV = 2048, SEC_RG = 3072, SEC_AQ = 4096, SEC_AK = 5120, SEC_AV = 6144;

constexpr size_t MiB = 1u << 20;
constexpr size_t WS_CTL = 0, CTL_ZERO_BYTES = 1 * MiB;
constexpr size_t WS_WOT = 1 * MiB, WS_W1T = 9 * MiB, WS_W2T = 41 * MiB, WS_WINT = 73 * MiB;
constexpr size_t WS_MIX = 73 * MiB;
constexpr size_t WS_PROJ = 105 * MiB;
constexpr size_t WS_PREV = 217 * MiB;
constexpr size_t WS_XG = 217 * MiB;
constexpr size_t WS_CS = 249 * MiB;
constexpr size_t WS_ROWSS = 251 * MiB;
constexpr size_t WS_U = 73 * MiB;
constexpr size_t WS_END = 252 * MiB;
constexpr size_t OUT_XN = 0, OUT_CONTRIB = 32 * MiB;
static_assert(WS_U + (size_t)M * DFF * 2 <= WS_XG && WS_WINT + (size_t)NIN * DM * 2 <= WS_PROJ && WS_PROJ + (size_t)M * NIN * 2 <= WS_PREV, "d_ws map");
constexpr int CW_TMO = 0, CW_CODE = 1;
constexpr int CW_BAR = 4096;

constexpr int RING_OFF = 0, RING_BYTES = 131072;
constexpr int XCH_OFF = RING_BYTES, XCH_BYTES = 8192;
constexpr int LDSCTL_OFF = XCH_OFF + XCH_BYTES, MISC_OFF = LDSCTL_OFF + 320;
constexpr int LDS_BYTES = 147456;
static_assert(MISC_OFF + 128 <= LDS_BYTES, "LDS map");

struct Frame {
    LAS unsigned char* lds;
    volatile LAS unsigned* MISC;
    gu32* ctl;
    int tid, lane, wave;
    int vcu, G;
};
__device__ __forceinline__ float wave_sum(float v) {
#pragma unroll
    for (int o = 1; o < 64; o <<= 1) v += __shfl_xor(v, o);
    return v;
}
__device__ __forceinline__ float wave_max(float v) {
#pragma unroll
    for (int o = 1; o < 64; o <<= 1) v = fmaxf(v, __shfl_xor(v, o));
    return v;
}
__device__ __forceinline__ float bf_lo(unsigned u) { return __uint_as_float(u << 16); }
__device__ __forceinline__ float bf_hi(unsigned u) { return __uint_as_float(u & 0xffff0000u); }

template <bool ROT>
__device__ __forceinline__ void p0_transpose_item(const float* W, int K, int N, bf16* WT, LAS float* scr, int item, int lane) {
    const int nblk = N / 32, kb = item / nblk, nb = item % nblk, k0 = 64 * kb, n0 = 32 * nb;
#pragma unroll 8
    for (int i = 0; i < 32; ++i) { const int kk = 2 * i + (lane >> 5); scr[kk * 33 + (lane & 31)] = W[(size_t)(k0 + kk) * N + n0 + (lane & 31)]; }
    LDS_WAIT(); asm volatile("" ::: "memory");
    const int c = lane & 7;
#pragma unroll
    for (int j = 0; j < 4; ++j) { const int n = (lane >> 3) + 8 * j; const LAS float* s = scr + (8 * c) * 33 + n;
        v4u o; o.x = pk2(s[0 * 33], s[1 * 33]); o.y = pk2(s[2 * 33], s[3 * 33]); o.z = pk2(s[4 * 33], s[5 * 33]); o.w = pk2(s[6 * 33], s[7 * 33]);
        int row = n0 + n;
        if (ROT && row < 2048) { const int d = row & 127; row = (row & ~127) + 2 * (d & 63) + (d >> 6); }
        *(GAS v4u*)(WT + (size_t)row * K + k0 + 8 * c) = o; }
    LDS_WAIT(); asm volatile("" ::: "memory");
}

struct Args { const float* in[11]; float* out; unsigned char* ws; float lg[8]; int ph_lo, ph_hi, li, pad; };
#define LGSEL(h) ((h) == 0 ? args.lg[0] : (h) == 1 ? args.lg[1] : (h) == 2 ? args.lg[2] : (h) == 3 ? args.lg[3] : (h) == 4 ? args.lg[4] : (h) == 5 ? args.lg[5] : (h) == 6 ? args.lg[6] : args.lg[7])

__global__ void __launch_bounds__(NWAVES * 64, 2) hymba_fwd(Args args) {
    extern __shared__ __attribute__((aligned(16))) unsigned char lds[];
    Frame F;
    F.lds = (LAS unsigned char*)lds;
    F.MISC = (volatile LAS unsigned*)(F.lds + MISC_OFF);
    F.tid = threadIdx.x; F.lane = F.tid & 63; F.wave = __builtin_amdgcn_readfirstlane(F.tid >> 6);
    F.G = gridDim.x; { const int bx = blockIdx.x; F.vcu = (F.G % 8 == 0) ? (bx % 8) * (F.G / 8) + bx / 8 : bx; }
    unsigned char* ws = args.ws;
    F.ctl = (gu32*)(ws + WS_CTL);
    const float* x = args.in[0]; const float* g1 = args.in[1]; const float* w_in = args.in[2]; const float* gn = args.in[3];
    const float* qg = args.in[4]; const float* kg = args.in[5]; const float* relb = args.in[6]; const float* w_out = args.in[7];
    const float* g2 = args.in[8]; const float* w1 = args.in[9]; const float* w2 = args.in[10];
    float* out = args.out;
    bf16* WinT = (bf16*)(ws + WS_WINT); bf16* WoT = (bf16*)(ws + WS_WOT); bf16* W1T = (bf16*)(ws + WS_W1T); bf16* W2T = (bf16*)(ws + WS_W2T);
    bf16* MIX = (bf16*)(ws + WS_MIX); bf16* PROJ = (bf16*)(ws + WS_PROJ); bf16* PREV = (bf16*)(ws + WS_PREV); bf16* XG = (bf16*)(ws + WS_XG);
    float* CS = (float*)(ws + WS_CS); float* ROWSS = (float*)(ws + WS_ROWSS); bf16* U = (bf16*)(ws + WS_U);
    bf16* XN = (bf16*)((unsigned char*)out + OUT_XN); bf16* CONTRIB = (bf16*)((unsigned char*)out + OUT_CONTRIB);

    for (int u = F.tid; u < (LDS_BYTES - LDSCTL_OFF) / 4; u += NWAVES * 64) ((LAS unsigned*)(F.lds + LDSCTL_OFF))[u] = 0u;
    __syncthreads();
    XcdBarrier bar; bar.bar = (unsigned*)(F.ctl + CW_BAR); bar.x = 0; bar.st = nullptr;
    if (N_LAUNCHES != PER_PHASE) bar = xcd_barrier_post((unsigned*)(F.ctl + CW_BAR), F.MISC + 8);
#define GRID_BAR(seam) do { if (N_LAUNCHES == PER_PHASE) { if (F.tid == 0) __hip_atomic_store(F.ctl + CW_TMO, 0xBADBA0u | (unsigned)(seam), RLX_AGENT); } \
    else { xcd_barrier(bar); } } while (0)
    const int lo = args.ph_lo, hi = args.ph_hi;
#define IN(k) (lo <= (k) && (k) < hi)
#define BOTH(k) (IN(k) && IN((k) + 1))
    const int gw = F.vcu * NWAVES + F.wave, NGW = F.G * NWAVES;

    if (IN(0)) {
        LAS float* scr = (LAS float*)(F.lds + RING_OFF + F.wave * 16384);
        constexpr int I_IN = (DM / 64) * (NIN / 32), I_O = (DM / 64) * (DM / 32), I_1 = (DM / 64) * (DFF / 32), I_2 = (DFF / 64) * (DM / 32);
        constexpr int NITEMS = I_IN + I_O + I_1 + I_2;
        for (int it = gw; it < NITEMS; it += NGW) {
            int r = it;
            if (r < I_IN) { p0_transpose_item<true>(w_in, DM, NIN, WinT, scr, r, F.lane); continue; } r -= I_IN;
            if (r < I_O) { p0_transpose_item<false>(w_out, DM, DM, WoT, scr, r, F.lane); continue; } r -= I_O;
            if (r < I_1) { p0_transpose_item<false>(w1, DM, DFF, W1T, scr, r, F.lane); continue; } r -= I_1;
            p0_transpose_item<false>(w2, DFF, DM, W2T, scr, r, F.lane);
        }
        for (int m = gw; m < M; m += NGW) {
            const GAS f32x4* xr = (const GAS f32x4*)(x + (size_t)m * DM) + F.lane;
            const GAS f32x4* gr = (const GAS f32x4*)g1 + F.lane;
            f32x4 v[8]; float s = 0.f;
#pragma unroll
            for (int j = 0; j < 8; ++j) { v[j] = xr[64 * j]; s += (v[j].x * v[j].x + v[j].y * v[j].y) + (v[j].z * v[j].z + v[j].w * v[j].w); }
            const float rstd = 1.f / sqrtf(wave_sum(s) * (1.f / DM) + EPS);
            GAS unsigned long long* o8 = (GAS unsigned long long*)(XN + (size_t)m * DM) + F.lane;
#pragma unroll
            for (int j = 0; j < 8; ++j) { const f32x4 g = gr[64 * j]; const f32x4 y = v[j] * rstd * g;
                o8[64 * j] = (unsigned long long)pk2(y.x, y.y) | ((unsigned long long)pk2(y.z, y.w) << 32); }
        }
        for (int i = (F.vcu * NWAVES * 64) + F.tid; i < SEQ * 64; i += F.G * NWAVES * 64) {
            const int pos = i >> 6, p = i & 63;
            const float invf = __builtin_amdgcn_exp2f(-(float)p * 0.20762050593046014f);
            const double rev = (double)pos * (double)invf * 0.15915494309189535;
            const float fr = (float)(rev - __builtin_floor(rev));
            CS[2 * i] = __builtin_amdgcn_cosf(fr); CS[2 * i + 1] = __builtin_amdgcn_sinf(fr);
        }
        if (BOTH(0)) GRID_BAR(0);
    }

    if (IN(1)) {
        pg8::Gemm g{XN, WinT, M, NIN, DM}; pg8::StaticOrder S; S.init(M, NIN, F.G, (int)blockIdx.x);
        pg8::EpiProj E{PROJ, CS, qg, kg, (LAS float*)(F.lds + XCH_OFF)};
        pg8::gemm_phase<pg8::EpiProj, pg8::StaticOrder, true, true>(F.lds + RING_OFF, g, S, E);
        if (BOTH(1)) GRID_BAR(1);
    }

    if (IN(2)) {
        LAS float* pl = (LAS float*)(F.lds + RING_OFF + F.wave * 4096);
        for (int t0 = gw * 32; t0 < M * NH; t0 += NGW * 32) {
            for (int tt = 0; tt < 32; ++tt) {
                const int t = t0 + tt;
                const int i = t & 63, n = (t >> 6) & 63, h = (t >> 12) & 7, b = t >> 15;
                const int r = b * SEQ + n * CH + i;
                unsigned qp[64];
                { const GAS v4u* qrow = (const GAS v4u*)(PROJ + (size_t)r * NIN + SEC_AQ + h * HD);
#pragma unroll
                  for (int c = 0; c < 16; ++c) { const v4u q4 = qrow[c]; qp[4 * c] = q4.x; qp[4 * c + 1] = q4.y; qp[4 * c + 2] = q4.z; qp[4 * c + 3] = q4.w; } }
                const int tb0 = (n >= LEFT) ? 0 : (LEFT - n);
                float sc[9];
#pragma unroll
                for (int tb = 0; tb < 9; ++tb) {
                    sc[tb] = -INFINITY;
                    if (tb >= tb0) {
                        const int kj = tb * 64 + F.lane; const int kpos = (n - LEFT) * CH + kj;
                        const GAS v4u* krow = (const GAS v4u*)(PROJ + (size_t)(b * SEQ + kpos) * NIN + SEC_AK + h * HD);
                        float s = 0.f;
#pragma unroll
                        for (int c = 0; c < 16; ++c) { const v4u k4 = krow[c];
                            s += bf_lo(k4.x) * bf_lo(qp[4 * c]) + bf_hi(k4.x) * bf_hi(qp[4 * c]);
                            s += bf_lo(k4.y) * bf_lo(qp[4 * c + 1]) + bf_hi(k4.y) * bf_hi(qp[4 * c + 1]);
                            s += bf_lo(k4.z) * bf_lo(qp[4 * c + 2]) + bf_hi(k4.z) * bf_hi(qp[4 * c + 2]);
                            s += bf_lo(k4.w) * bf_lo(qp[4 * c + 3]) + bf_hi(k4.w) * bf_hi(qp[4 * c + 3]); }
                        int rel = i + LEFT * CH - kj; rel = rel < -(CH - 1) ? -(CH - 1) : (rel > 128 ? 128 : rel);
                        sc[tb] = s + relb[h * RELSZ + rel + (CH - 1)] * LOG2E;
                    }
                }
                float mx = sc[0];
#pragma unroll
                for (int tb = 1; tb < 9; ++tb) mx = fmaxf(mx, sc[tb]);
                mx = wave_max(mx);
                float l = 0.f;
#pragma unroll
                for (int tb = 0; tb < 9; ++tb) { const float p = (tb >= tb0) ? __builtin_amdgcn_exp2f(sc[tb] - mx) : 0.f; l += p; pl[tb * 64 + F.lane] = p; }
                l = wave_sum(l);
                LDS_WAIT(); asm volatile("" ::: "memory");
                float o0 = 0.f, o1 = 0.f;
                const GAS unsigned* vb = (const GAS unsigned*)(PROJ + (long)(b * SEQ + (n - LEFT) * CH) * NIN + SEC_AV + h * HD) + F.lane;
#pragma unroll 8
                for (int kj = tb0 * 64; kj < 9 * 64; ++kj) { const float p = pl[kj]; const unsigned v2 = vb[(long)kj * (NIN / 2)]; o0 += p * bf_lo(v2); o1 += p * bf_hi(v2); }
                const float il = 1.f / l;
                *((GAS unsigned*)(MIX + (size_t)r * DM + 1024 + h * HD) + F.lane) = pk2(o0 * il, o1 * il);
                LDS_WAIT(); asm volatile("" ::: "memory");
            }
        }
        for (int unit = F.vcu; unit < BATCH * NH * NCH; unit += F.G) {
            const int n = unit & 63, h = (unit >> 6) & 7, b = unit >> 9;
            const int dv = F.tid >> 2, dk0 = (F.tid & 3) * 32;
            const float lgh = LGSEL(h);
            float acc[32];
#pragma unroll
            for (int q = 0; q < 32; ++q) acc[q] = 0.f;
            const bf16* base = PROJ + (size_t)(b * SEQ + n * CH) * NIN + h * HD;
            for (int j = 0; j < CH; ++j) {
                const float kd = __builtin_amdgcn_exp2f(lgh * LOG2E * (float)(CH - 1 - j));
                const float vv = bf_lo((unsigned)base[(size_t)j * NIN + SEC_RV + dv]) * kd;
                const GAS v4u* kr = (const GAS v4u*)(base + (size_t)j * NIN + SEC_RK + dk0);
#pragma unroll
                for (int c = 0; c < 4; ++c) { const v4u k4 = kr[c];
                    acc[8 * c + 0] += vv * bf_lo(k4.x); acc[8 * c + 1] += vv * bf_hi(k4.x); acc[8 * c + 2] += vv * bf_lo(k4.y); acc[8 * c + 3] += vv * bf_hi(k4.y);
                    acc[8 * c + 4] += vv * bf_lo(k4.z); acc[8 * c + 5] += vv * bf_hi(k4.z); acc[8 * c + 6] += vv * bf_lo(k4.w); acc[8 * c + 7] += vv * bf_hi(k4.w); }
            }
            GAS v4u* o = (GAS v4u*)(CONTRIB + (size_t)unit * (HD * HD) + dv * HD + dk0);
#pragma unroll
            for (int c = 0; c < 4; ++c) { v4u w; w.x = pk2(acc[8 * c], acc[8 * c + 1]); w.y = pk2(acc[8 * c + 2], acc[8 * c + 3]); w.z = pk2(acc[8 * c + 4], acc[8 * c + 5]); w.w = pk2(acc[8 * c + 6], acc[8 * c + 7]); o[c] = w; }
        }
        if (BOTH(2)) GRID_BAR(2);
    }

    if (IN(3)) {
        for (int e = F.vcu * (NWAVES * 64) + F.tid; e < BATCH * NH * HD * HD; e += F.G * NWAVES * 64) {
            const int bh = e >> 14, idx = e & 16383, h = bh & 7;
            const float dec = __builtin_amdgcn_exp2f(LGSEL(h) * LOG2E * (float)CH);
            float st = 0.f;
            for (int n = 0; n < NCH; ++n) {
                const size_t a = (size_t)(bh * NCH + n) * (HD * HD) + idx;
                const float c = bf_lo((unsigned)CONTRIB[a]);
                PREV[a] = (bf16)f2bf(st);
                st = dec * st + c;
            }
        }
        if (BOTH(3)) GRID_BAR(3);
    }

    if (IN(4)) {
        LAS float* sl = (LAS float*)(F.lds + RING_OFF + F.wave * 4096);
        LAS float* ql = sl + 64;
        for (int t0 = gw * 32; t0 < M * NH; t0 += NGW * 32) {
            for (int tt = 0; tt < 32; ++tt) {
                const int t = t0 + tt;
                const int i = t & 63, n = (t >> 6) & 63, h = (t >> 12) & 7, b = t >> 15;
                const int r = b * SEQ + n * CH + i; const int unit = (b * NH + h) * NCH + n;
                const float lgh = LGSEL(h) * LOG2E;
                unsigned qp[64];
                { const GAS v4u* qrow = (const GAS v4u*)(PROJ + (size_t)r * NIN + SEC_RQ + h * HD);
#pragma unroll
                  for (int c = 0; c < 16; ++c) { const v4u q4 = qrow[c]; qp[4 * c] = q4.x; qp[4 * c + 1] = q4.y; qp[4 * c + 2] = q4.z; qp[4 * c + 3] = q4.w; } }
                { const unsigned q2 = *((const GAS unsigned*)(PROJ + (size_t)r * NIN + SEC_RQ + h * HD) + F.lane); ql[2 * F.lane] = bf_lo(q2); ql[2 * F.lane + 1] = bf_hi(q2); }
                {
                    const GAS v4u* krow = (const GAS v4u*)(PROJ + (size_t)(b * SEQ + n * CH + F.lane) * NIN + SEC_RK + h * HD);
                    float s = 0.f;
#pragma unroll
                    for (int c = 0; c < 16; ++c) { const v4u k4 = krow[c];
                        s += bf_lo(k4.x) * bf_lo(qp[4 * c]) + bf_hi(k4.x) * bf_hi(qp[4 * c]);
                        s += bf_lo(k4.y) * bf_lo(qp[4 * c + 1]) + bf_hi(k4.y) * bf_hi(qp[4 * c + 1]);
                        s += bf_lo(k4.z) * bf_lo(qp[4 * c + 2]) + bf_hi(k4.z) * bf_hi(qp[4 * c + 2]);
                        s += bf_lo(k4.w) * bf_lo(qp[4 * c + 3]) + bf_hi(k4.w) * bf_hi(qp[4 * c + 3]); }
                    const int dist = i > F.lane ? i - F.lane : F.lane - i;
                    sl[F.lane] = s * __builtin_amdgcn_exp2f(lgh * (float)dist);
                }
                LDS_WAIT(); asm volatile("" ::: "memory");
                float y0 = 0.f, y1 = 0.f;
                { const GAS unsigned* vb = (const GAS unsigned*)(PROJ + (size_t)(b * SEQ + n * CH) * NIN + SEC_RV + h * HD) + F.lane;
#pragma unroll 8
                  for (int j = 0; j < CH; ++j) { const float s = sl[j]; const unsigned v2 = vb[(size_t)j * (NIN / 2)]; y0 += s * bf_lo(v2); y1 += s * bf_hi(v2); } }
                {
                    const float qdec = __builtin_amdgcn_exp2f(lgh * (float)(i + 1));
                    const GAS v4u* pa = (const GAS v4u*)(PREV + (size_t)unit * (HD * HD) + (2 * F.lane) * HD);
                    float c0 = 0.f, c1 = 0.f;
#pragma unroll 4
                    for (int c = 0; c < 16; ++c) { const v4u a4 = pa[c], b4 = pa[16 + c]; const LAS float* q8 = ql + 8 * c;
                        c0 += bf_lo(a4.x) * q8[0] + bf_hi(a4.x) * q8[1] + bf_lo(a4.y) * q8[2] + bf_hi(a4.y) * q8[3] + bf_lo(a4.z) * q8[4] + bf_hi(a4.z) * q8[5] + bf_lo(a4.w) * q8[6] + bf_hi(a4.w) * q8[7];
                        c1 += bf_lo(b4.x) * q8[0] + bf_hi(b4.x) * q8[1] + bf_lo(b4.y) * q8[2] + bf_hi(b4.y) * q8[3] + bf_lo(b4.z) * q8[4] + bf_hi(b4.z) * q8[5] + bf_lo(b4.w) * q8[6] + bf_hi(b4.w) * q8[7]; }
                    y0 += qdec * c0; y1 += qdec * c1;
                }
                const float mu = wave_sum(y0 + y1) * (1.f / HD);
                const float d0 = y0 - mu, d1 = y1 - mu;
                const float var = wave_sum(d0 * d0 + d1 * d1) * (1.f / HD);
                const float rs = 1.f / sqrtf(var + GN_EPS);
                const float ga = gn[h * HD + 2 * F.lane], gb = gn[h * HD + 2 * F.lane + 1];
                const unsigned sg = *((const GAS unsigned*)(PROJ + (size_t)r * NIN + SEC_RG + h * HD) + F.lane);
                *((GAS unsigned*)(MIX + (size_t)r * DM + h * HD) + F.lane) = pk2(d0 * rs * ga * bf_lo(sg), d1 * rs * gb * bf_hi(sg));
                LDS_WAIT(); asm volatile("" ::: "memory");
            }
        }
        if (BOTH(4)) GRID_BAR(4);
    }

    if (IN(5)) {
        pg8::Gemm g{MIX, WoT, M, DM, DM}; pg8::StaticOrder S; S.init(M, DM, F.G, (int)blockIdx.x);
        pg8::EpiOut E{x, out, XG, g2, ROWSS, DM};
        pg8::gemm_phase<pg8::EpiOut, pg8::StaticOrder, true, true>(F.lds + RING_OFF, g, S, E);
        if (BOTH(5)) GRID_BAR(5);
    }

    if (IN(6)) {
        pg8::Gemm g{XG, W1T, M, DFF, DM}; pg8::StaticOrder S; S.init(M, DFF, F.G, (int)blockIdx.x);
        pg8::EpiRelu2 E{U, DFF};
        pg8::gemm_phase<pg8::EpiRelu2, pg8::StaticOrder, true, true>(F.lds + RING_OFF, g, S, E);
        if (BOTH(6)) GRID_BAR(6);
    }

    if (IN(7)) {
        pg8::Gemm g{U, W2T, M, DM, DFF}; pg8::StaticOrder S; S.init(M, DM, F.G, (int)blockIdx.x);
        pg8::EpiFinal E{out, ROWSS, DM};
        pg8::gemm_phase<pg8::EpiFinal, pg8::StaticOrder, true, true>(F.lds + RING_OFF, g, S, E);
    }
#undef IN
#undef BOTH
}

extern "C" void kernel_launch(void* const* d_in, const int* in_sizes, int n_in, void* d_out, int out_size, void* d_ws, size_t ws_size, hipStream_t stream) {
    static int grid = 0;
    if (grid == 0) {
        if (n_in != 11 || in_sizes[0] != M * DM || out_size != M * DM || ws_size < WS_END) { fprintf(stderr, "kernel_launch: shape/workspace mismatch: n_in %d in0 %d out %d ws %zu (need %zu)\n", n_in, n_in > 0 ? in_sizes[0] : -1, out_size, ws_size, (size_t)WS_END); grid = -1; return; }
        int dev = 0, cus = 0, per_cu = 0;
        if (hipGetDevice(&dev) != hipSuccess || hipDeviceGetAttribute(&cus, hipDeviceAttributeMultiprocessorCount, dev) != hipSuccess) { fprintf(stderr, "kernel_launch: device query failed\n"); grid = -1; return; }
        if (hipFuncSetAttribute((const void*)hymba_fwd, hipFuncAttributeMaxDynamicSharedMemorySize, LDS_BYTES) != hipSuccess) { fprintf(stderr, "kernel_launch: hipFuncSetAttribute failed\n"); grid = -1; return; }
        if (hipOccupancyMaxActiveBlocksPerMultiprocessor(&per_cu, (const void*)hymba_fwd, NWAVES * 64, LDS_BYTES) != hipSuccess || per_cu < 1)
            fprintf(stderr, "kernel_launch: note: occupancy query reports %d workgroups per CU\n", per_cu);
        (void)hipGetLastError();
        grid = cus;
    }
    if (grid < 0) return;
    if (hipMemsetAsync((char*)d_ws + WS_CTL, 0, CTL_ZERO_BYTES, stream) != hipSuccess) { fprintf(stderr, "kernel_launch: hipMemsetAsync failed\n"); return; }
    Args a{};
    for (int i = 0; i < 11; ++i) a.in[i] = (const float*)d_in[i];
    a.out = (float*)d_out; a.ws = (unsigned char*)d_ws;
    for (int h = 0; h < 8; ++h) a.lg[h] = (float)log1p(-exp2(-(5.0 + (double)h)));
    for (int li = 0; li < N_LAUNCHES; ++li) {
        a.ph_lo = (N_LAUNCHES == PER_PHASE) ? li : 0; a.ph_hi = (N_LAUNCHES == PER_PHASE) ? li + 1 : PER_PHASE; a.li = li;
        hipLaunchKernelGGL(hymba_fwd, dim3(grid), dim3(NWAVES * 64), LDS_BYTES, stream, a);
        const hipError_t le = hipPeekAtLastError();
        if (le != hipSuccess) { fprintf(stderr, "kernel_launch: launch %d failed: %s\n", li, hipGetErrorName(le)); break; }
    }
}
```

```cpp
#include <hip/hip_runtime.h>
#include <cstdio>
#include <cstdint>
#include <cmath>
namespace pg8 {
#define PG8_LAS __attribute__((address_space(3)))
typedef unsigned short bf16_t;
typedef short bf16x8 __attribute__((ext_vector_type(8)));
typedef float f32x4 __attribute__((ext_vector_type(4)));
typedef unsigned u32x4 __attribute__((ext_vector_type(4)));
constexpr int BM = 256, BK = 64, HALF = 128, HTB = HALF * BK * 2  , STAGE_BYTES = 8 * HTB, NXCD = 8, WGM = 8;

__host__ __device__ __forceinline__ int lds_byte(int r, int c) { const int st = (r >> 4) * 2 + (c >> 5), rr = r & 15, cc = c & 31, ob = rr * 64 + cc * 2; return st * 1024 + (ob ^ (((ob >> 9) & 1) << 5)); }
__host__ __device__ __forceinline__ void stage_rc(int b, int& R, int& C) { const int st = b / 1024, sb = b % 1024, swz = sb ^ (((sb >> 9) & 1) << 5); R = (st >> 1) * 16 + swz / 64; C = (st & 1) * 32 + (swz % 64) / 2; }
__host__ __device__ __forceinline__ int perm32(int rho) { const int n = rho >> 4, i = rho & 15; return 8 * (i >> 2) + 4 * n + (i & 3); }

struct Unit { int pm, pn; };
struct Gemm { const bf16_t* A; const bf16_t* Bt; int M, N, K; };

struct StaticOrder {
    int nM, nN, nwg, G, c;
    __host__ __device__ void init(int M, int N, int G_, int c_) { nM = M / BM; nN = N / BM; nwg = nM * nN; G = G_; c = c_; }
    __host__ __device__ bool next(int i, Unit& u) const {
        const long L = (long)i * G + c; if (L >= nwg) return false;
        int wgid = (int)L; { const int q = nwg / NXCD, r = nwg % NXCD, xcd = wgid % NXCD, off = wgid / NXCD; wgid = (xcd < r ? xcd * (q + 1) : r * (q + 1) + (xcd - r) * q) + off; }
        const int nig = WGM * nN, gid = wgid / nig, fm = gid * WGM, gsz = (nM - fm) < WGM ? (nM - fm) : WGM;
        u.pm = fm + ((wgid % nig) % gsz); u.pn = (wgid % nig) / gsz; return true;
    }
    __device__ __forceinline__ void a_ready(const Unit&) const {}
    __device__ __forceinline__ void done(const Unit&) const {}
};

typedef float f32x2c_t __attribute__((ext_vector_type(2))); typedef __bf16 bf16x2c_t __attribute__((ext_vector_type(2)));
__device__ __forceinline__ unsigned cvt_pk_bf16(float lo, float hi) { f32x2c_t v = {lo, hi}; bf16x2c_t b = __builtin_convertvector(v, bf16x2c_t); return __builtin_bit_cast(unsigned, b); }
typedef float f32x2 __attribute__((ext_vector_type(2)));
typedef unsigned u32x2 __attribute__((ext_vector_type(2)));
constexpr int PROJ_LD = 7168;
struct EpiProj {
    static constexpr bool PERM = true, AFTER_DRAIN = false, WIDE = true;
    bf16_t* P; const float* cs; const float* csstep; const float* qg; const float* kg; PG8_LAS float* xch; int force_sec;
    __device__ __forceinline__ void operator()(const f32x4 (&acc)[2][2][4][2], const Unit& u, int wr, int wc, int fr, int fq) const {
        const int sec = force_sec >= 0 ? force_sec : (u.pn >> 2);
        const int row0 = u.pm * BM + wr * 64 + fr;
        const int tc0 = wc * 64 + 8 * fq, ch0 = tc0 & 127;
        bf16_t* base = P + (size_t)row0 * PROJ_LD + u.pn * BM;
        if (sec <= 1) {
            const float ksc = (sec == 1) ? 0.08838834764831845f : 1.0f;
            const int p0 = ch0 >> 1;
            f32x4 cb_[2][2][2], st_[2][2];
#pragma unroll
            for (int bj = 0; bj < 2; ++bj) { const float* sp = csstep + (p0 + 16 * bj) * 2; st_[bj][0] = *(const f32x4*)sp; st_[bj][1] = *(const f32x4*)(sp + 4);
#pragma unroll
                for (int ai = 0; ai < 2; ++ai) { const int pos = (row0 + ai * HALF) & 4095; const float* cp = cs + ((size_t)pos * 64 + p0 + 16 * bj) * 2;
                    cb_[ai][bj][0] = *(const f32x4*)cp; cb_[ai][bj][1] = *(const f32x4*)(cp + 4); } }
            asm volatile("" ::: "memory");
#pragma unroll
            for (int ai = 0; ai < 2; ++ai)
#pragma unroll
                for (int m = 0; m < 4; ++m) {
                    bf16_t* rp = base + (size_t)(ai * HALF + m * 16) * PROJ_LD + tc0;
#pragma unroll
                    for (int bj = 0; bj < 2; ++bj) {
                        const f32x4 ca = cb_[ai][bj][0], cb = cb_[ai][bj][1];
                        const f32x4 v0 = acc[ai][bj][m][0] * ksc, v1 = acc[ai][bj][m][1] * ksc;
                        const float a0 = v0[0] * ca[0] - v0[1] * ca[1], b0 = v0[0] * ca[1] + v0[1] * ca[0];
                        const float a1 = v0[2] * ca[2] - v0[3] * ca[3], b1 = v0[2] * ca[3] + v0[3] * ca[2];
                        const float a2 = v1[0] * cb[0] - v1[1] * cb[1], b2 = v1[0] * cb[1] + v1[1] * cb[0];
                        const float a3 = v1[2] * cb[2] - v1[3] * cb[3], b3 = v1[2] * cb[3] + v1[3] * cb[2];
                        u32x4 w; w.x = cvt_pk_bf16(a0, b0); w.y = cvt_pk_bf16(a1, b1); w.z = cvt_pk_bf16(a2, b2); w.w = cvt_pk_bf16(a3, b3);
                        *(u32x4*)(rp + 32 * bj) = w;
                        if (m < 3) {
#pragma unroll
                            for (int q = 0; q < 2; ++q) { const f32x4 c = cb_[ai][bj][q], t = st_[bj][q];
                                cb_[ai][bj][q] = (f32x4){c[0] * t[0] - c[1] * t[1], c[1] * t[0] + c[0] * t[1], c[2] * t[2] - c[3] * t[3], c[3] * t[2] + c[2] * t[3]}; }
                        }
                    }
                }
        } else if (sec == 4 || sec == 5) {
            const float* g = (sec == 4) ? qg : kg;
            const float osc = (sec == 4) ? (0.08838834764831845f * 1.4426950408889634f) : 1.0f;
            f32x4 gv[2][2];
#pragma unroll
            for (int bj = 0; bj < 2; ++bj) { gv[bj][0] = *(const f32x4*)(g + ch0 + 32 * bj) * osc; gv[bj][1] = *(const f32x4*)(g + ch0 + 32 * bj + 4) * osc; }
#pragma unroll
            for (int ai = 0; ai < 2; ++ai)
#pragma unroll
                for (int m = 0; m < 4; ++m) {
                    float s = 0.f;
#pragma unroll
                    for (int bj = 0; bj < 2; ++bj) { const f32x4 v0 = acc[ai][bj][m][0], v1 = acc[ai][bj][m][1];
                        s += (v0[0] * v0[0] + v0[1] * v0[1]) + (v0[2] * v0[2] + v0[3] * v0[3]) + (v1[0] * v1[0] + v1[1] * v1[1]) + (v1[2] * v1[2] + v1[3] * v1[3]); }
                    s += __shfl_xor(s, 16); s += __shfl_xor(s, 32);
                    if (fq == 0) xch[(ai * HALF + wr * 64 + m * 16 + fr) * 4 + wc] = s;
                }
            asm volatile("s_waitcnt lgkmcnt(0)" ::: "memory"); __builtin_amdgcn_s_barrier(); asm volatile("" ::: "memory");
#pragma unroll
            for (int ai = 0; ai < 2; ++ai)
#pragma unroll
                for (int m = 0; m < 4; ++m) {
                    bf16_t* rp = base + (size_t)(ai * HALF + m * 16) * PROJ_LD + tc0;
                    const PG8_LAS float* xp = xch + (ai * HALF + wr * 64 + m * 16 + fr) * 4 + (wc & 2);
                    const float rstd = 1.0f / sqrtf((xp[0] + xp[1]) * (1.0f / 128.0f) + 1e-6f);
#pragma unroll
                    for (int bj = 0; bj < 2; ++bj) {
                        const f32x4 v0 = acc[ai][bj][m][0] * rstd * gv[bj][0], v1 = acc[ai][bj][m][1] * rstd * gv[bj][1];
                        u32x4 w; w.x = cvt_pk_bf16(v0[0], v0[1]); w.y = cvt_pk_bf16(v0[2], v0[3]); w.z = cvt_pk_bf16(v1[0], v1[1]); w.w = cvt_pk_bf16(v1[2], v1[3]);
                        *(u32x4*)(rp + 32 * bj) = w;
                    }
                }
        } else {
#pragma unroll
            for (int ai = 0; ai < 2; ++ai)
#pragma unroll
                for (int m = 0; m < 4; ++m) {
                    bf16_t* rp = base + (size_t)(ai * HALF + m * 16) * PROJ_LD + tc0;
#pragma unroll
                    for (int bj = 0; bj < 2; ++bj) {
                        f32x4 v0 = acc[ai][bj][m][0], v1 = acc[ai][bj][m][1];
                        if (sec == 3) {
#pragma unroll
                            for (int j = 0; j < 4; ++j) { v0[j] = v0[j] * __builtin_amdgcn_rcpf(1.0f + __builtin_amdgcn_exp2f(-1.4426950408889634f * v0[j]));
                                                          v1[j] = v1[j] * __builtin_amdgcn_rcpf(1.0f + __builtin_amdgcn_exp2f(-1.4426950408889634f * v1[j])); }
                        }
                        u32x4 w; w.x = cvt_pk_bf16(v0[0], v0[1]); w.y = cvt_pk_bf16(v0[2], v0[3]); w.z = cvt_pk_bf16(v1[0], v1[1]); w.w = cvt_pk_bf16(v1[2], v1[3]);
                        *(u32x4*)(rp + 32 * bj) = w;
                    }
                }
        }
    }
};
struct EpiOut {
    static constexpr bool PERM = true, AFTER_DRAIN = false, WIDE = true;
    const float* x; bf16_t* X1B; float* rowss; int ldc;
    __device__ __forceinline__ void operator()(const f32x4 (&acc)[2][2][4][2], const Unit& u, int wr, int wc, int fr, int fq) const {
        const int row0 = u.pm * BM + wr * 64 + fr, col0 = u.pn * BM + wc * 64 + 8 * fq;
#pragma unroll
        for (int ai = 0; ai < 2; ++ai) {
            f32x4 xv[4][2][2];
#pragma unroll
            for (int m = 0; m < 4; ++m)
#pragma unroll
                for (int bj = 0; bj < 2; ++bj) { const size_t off = (size_t)(row0 + ai * HALF + m * 16) * ldc + col0 + bj * 32;
                    xv[m][bj][0] = __builtin_nontemporal_load((const f32x4*)(x + off)); xv[m][bj][1] = __builtin_nontemporal_load((const f32x4*)(x + off + 4)); }
            asm volatile("" ::: "memory");
#pragma unroll
            for (int m = 0; m < 4; ++m) {
                const int r = row0 + ai * HALF + m * 16; float ss = 0.f;
#pragma unroll
                for (int bj = 0; bj < 2; ++bj) {
                    const size_t off = (size_t)r * ldc + col0 + bj * 32;
                    const f32x4 y0 = xv[m][bj][0] + acc[ai][bj][m][0], y1 = xv[m][bj][1] + acc[ai][bj][m][1];
                    u32x4 w1; w1.x = cvt_pk_bf16(y0[0], y0[1]); w1.y = cvt_pk_bf16(y0[2], y0[3]); w1.z = cvt_pk_bf16(y1[0], y1[1]); w1.w = cvt_pk_bf16(y1[2], y1[3]); *(u32x4*)(X1B + off) = w1;
                    ss += (y0[0] * y0[0] + y0[1] * y0[1]) + (y0[2] * y0[2] + y0[3] * y0[3]) + (y1[0] * y1[0] + y1[1] * y1[1]) + (y1[2] * y1[2] + y1[3] * y1[3]);
                }
                ss += __shfl_xor(ss, 16); ss += __shfl_xor(ss, 32);
                if (fq == 0) rowss[(size_t)r * 32 + u.pn * 4 + wc] = ss;
            }
            asm volatile("" ::: "memory");
        }
    }
};
struct EpiRelu2 {
    static constexpr bool PERM = true, AFTER_DRAIN = false, WIDE = true;
    bf16_t* O; int ldc;
    __device__ __forceinline__ void operator()(const f32x4 (&acc)[2][2][4][2], const Unit& u, int wr, int wc, int fr, int fq) const {
        char* tb = (char*)O + ((size_t)u.pm * (ldc / 64) + u.pn * 4 + wc) * 32768 + (wr * 64 + fr) * 128 + (8 * fq) * 2;
#pragma unroll
        for (int ai = 0; ai < 2; ++ai)
#pragma unroll
            for (int m = 0; m < 4; ++m) {
#pragma unroll
                for (int bj = 0; bj < 2; ++bj) {
                    f32x4 v0 = acc[ai][bj][m][0], v1 = acc[ai][bj][m][1];
#pragma unroll
                    for (int j = 0; j < 4; ++j) { const float a = fmaxf(v0[j], 0.f), b = fmaxf(v1[j], 0.f); v0[j] = a * a; v1[j] = b * b; }
                    u32x4 w; w.x = cvt_pk_bf16(v0[0], v0[1]); w.y = cvt_pk_bf16(v0[2], v0[3]); w.z = cvt_pk_bf16(v1[0], v1[1]); w.w = cvt_pk_bf16(v1[2], v1[3]);
                    *(u32x4*)(tb + bj * 64 + (ai * HALF + m * 16) * 128) = w;
                }
            }
    }
};
struct EpiFinal {
    static constexpr bool PERM = true, AFTER_DRAIN = false, WIDE = true;
    float* out; const PG8_LAS float* r2l; int ldc; const float* rowss; int pm0; const bf16_t* X1B;
    __device__ __forceinline__ void operator()(const f32x4 (&acc)[2][2][4][2], const Unit& u, int wr, int wc, int fr, int fq) const {
        const int rl0 = wr * 64 + fr, col0 = u.pn * BM + wc * 64 + 8 * fq;
        const size_t boff = (size_t)(u.pm * BM + rl0) * ldc + col0;
#pragma unroll
        for (int ai = 0; ai < 2; ++ai) {
            u32x4 xv[4][2]; float r2[4];
#pragma unroll
            for (int m = 0; m < 4; ++m) {
                if (u.pm == pm0) r2[m] = r2l[rl0 + ai * HALF + m * 16];
                else { const f32x4* rs = (const f32x4*)(rowss + (size_t)(u.pm * BM + rl0 + ai * HALF + m * 16) * 32); f32x4 s4 = rs[0];
#pragma unroll
                    for (int j = 1; j < 8; ++j) s4 += rs[j];
                    r2[m] = 1.0f / (((s4[0] + s4[1]) + (s4[2] + s4[3])) * (1.0f / 2048.0f) + 1e-6f); }
#pragma unroll
                for (int bj = 0; bj < 2; ++bj) xv[m][bj] = *(const u32x4*)(X1B + boff + (size_t)(ai * HALF + m * 16) * ldc + bj * 32); }
            asm volatile("" ::: "memory");
#pragma unroll
            for (int m = 0; m < 4; ++m)
#pragma unroll
                for (int bj = 0; bj < 2; ++bj) { const u32x4 w = xv[m][bj]; float* p = out + boff + (size_t)(ai * HALF + m * 16) * ldc + bj * 32;
                    const f32x4 x0 = {__uint_as_float(w.x << 16), __uint_as_float(w.x & 0xffff0000u), __uint_as_float(w.y << 16), __uint_as_float(w.y & 0xffff0000u)};
                    const f32x4 x1 = {__uint_as_float(w.z << 16), __uint_as_float(w.z & 0xffff0000u), __uint_as_float(w.w << 16), __uint_as_float(w.w & 0xffff0000u)};
                    *(f32x4*)p = x0 + acc[ai][bj][m][0] * r2[m]; *(f32x4*)(p + 4) = x1 + acc[ai][bj][m][1] * r2[m]; }
            asm volatile("" ::: "memory");
        }
    }
};
struct EpiNull {
    static constexpr bool PERM = false, AFTER_DRAIN = false, WIDE = false;
    float* sink;
    __device__ __forceinline__ void operator()(const f32x4 (&acc)[2][2][4][2], const Unit& u, int wr, int wc, int fr, int fq) const {
        float s = 0.f;
#pragma unroll
        for (int ai = 0; ai < 2; ++ai)
#pragma unroll
            for (int bj = 0; bj < 2; ++bj)
#pragma unroll
                for (int m = 0; m < 4; ++m)
#pragma unroll
                    for (int n = 0; n < 2; ++n) s += (acc[ai][bj][m][n][0] + acc[ai][bj][m][n][1]) + (acc[ai][bj][m][n][2] + acc[ai][bj][m][n][3]);
        if (s == 123456.789f) sink[u.pm * 8 + u.pn] = s;
    }
};
struct StaticOrderA0 : StaticOrder {
    __host__ __device__ bool next(int i, Unit& u) const { const bool r = StaticOrder::next(i, u); u.pm = 0; return r; }
};
template <class Epi, class Sched, bool ALIGN_EPI = false, bool SP2 = false, bool BLK = false>
__device__ __forceinline__ void gemm_phase(PG8_LAS unsigned char* lds, const Gemm g, const Sched& S, const Epi& E) {
    const int tid = threadIdx.x, wid = __builtin_amdgcn_readfirstlane(tid >> 6), lane = tid & 63, wr = wid >> 2, wc = wid & 3, fr = lane & 15, fq = lane >> 4;
    const int K = g.K, nt = K / BK;
    constexpr bool WIDE = Epi::PERM && Epi::WIDE;
    unsigned voffA[2], voffB[2];
#pragma unroll
    for (int i = 0; i < 2; ++i) { int R, C; stage_rc(tid * 16 + i * 8192, R, C); const int Rb = Epi::PERM ? ((WIDE ? 64 * (R >> 5) : (R & ~31)) + perm32(R & 31)) : R;
        voffA[i] = BLK ? (unsigned)(R * 128 + C * 2) : (unsigned)(R * K + C) * 2u; voffB[i] = BLK ? (unsigned)(Rb * 128 + C * 2) : (unsigned)(Rb * K + C) * 2u; }
    const size_t kstep = BLK ? (size_t)32768 : (size_t)(BK * 2);
    const size_t hstep = BLK ? (size_t)(HALF * 128) : (size_t)HALF * K * 2;
    const size_t hstepB = WIDE ? hstep / 4 : hstep;
    const size_t tstep = BLK ? (size_t)(K / BK) * 32768 : 2 * hstep;
    const unsigned ldsw = (unsigned)wid * 1024u;
    const int aoff = lds_byte(wr * 64 + fr, fq * 8), boff = lds_byte(wc * 32 + fr, fq * 8);
#define PG8_SA(b, h) (((b) * 2 + (h)) * HTB)
#define PG8_SB(b, h) ((4 + (b) * 2 + (h)) * HTB)
#define PG8_STAGE(bufoff, gbase, voff) do { _Pragma("unroll") for (int _i = 0; _i < 2; ++_i) \
        __builtin_amdgcn_global_load_lds((const unsigned*)((const char*)(gbase) + (voff)[_i]), (PG8_LAS unsigned*)(lds + (bufoff) + ldsw + _i * 8192), 16, 0, 0); } while (0)
#define PG8_LDA(dst, b, h) do { _Pragma("unroll") for (int m = 0; m < 4; ++m) _Pragma("unroll") for (int k = 0; k < 2; ++k) dst[m][k] = *(const PG8_LAS bf16x8*)(lds + PG8_SA(b, h) + aoff + m * 2048 + k * 1024); } while (0)
#define PG8_LDB(dst, b, h) do { _Pragma("unroll") for (int n = 0; n < 2; ++n) _Pragma("unroll") for (int k = 0; k < 2; ++k) dst[n][k] = *(const PG8_LAS bf16x8*)(lds + PG8_SB(b, h) + boff + n * 2048 + k * 1024); } while (0)
#define PG8_MMA(ai, bj, At, Bt) do { __builtin_amdgcn_s_setprio(1); _Pragma("unroll") for (int m = 0; m < 4; ++m) _Pragma("unroll") for (int n = 0; n < 2; ++n) _Pragma("unroll") for (int k = 0; k < 2; ++k) \
        acc[ai][bj][m][n] = __builtin_amdgcn_mfma_f32_16x16x32_bf16(Bt[n][k], At[m][k], acc[ai][bj][m][n], 0, 0, 0); __builtin_amdgcn_s_setprio(0); } while (0)
#define PG8_WAIT_V(n) asm volatile("s_waitcnt vmcnt(" #n ")" ::: "memory")
#define PG8_WAIT_L(n) asm volatile("s_waitcnt lgkmcnt(" #n ")" ::: "memory")
#define PG8_BAR __builtin_amdgcn_s_barrier()
#define PG8_SCHED __builtin_amdgcn_sched_barrier(0)
    Unit cur, nxt; int ui = 0;
    if (!S.next(0, cur)) return;
    f32x4 acc[2][2][4][2];
#pragma unroll
    for (int a = 0; a < 2; ++a)
#pragma unroll
        for (int b = 0; b < 2; ++b)
#pragma unroll
            for (int m = 0; m < 4; ++m)
#pragma unroll
                for (int n = 0; n < 2; ++n) acc[a][b][m][n] = (f32x4){0.f, 0.f, 0.f, 0.f};
    bf16x8 At[4][2], B0[2][2], B1[2][2];
    const char* cA = (const char*)g.A + (size_t)cur.pm * tstep; const char* cB = (const char*)g.Bt + (size_t)cur.pn * tstep;
    S.a_ready(cur);
    if constexpr (SP2) {
        PG8_STAGE(PG8_SB(0, 0), cB, voffB); PG8_STAGE(PG8_SB(0, 1), cB + hstepB, voffB); PG8_STAGE(PG8_SA(0, 0), cA, voffA); PG8_STAGE(PG8_SA(0, 1), cA + hstep, voffA);
        if (wr == 1) PG8_BAR;
        PG8_WAIT_V(2); PG8_BAR;
        PG8_STAGE(PG8_SB(1, 0), cB + kstep, voffB); PG8_STAGE(PG8_SA(1, 0), cA + kstep, voffA); PG8_STAGE(PG8_SB(1, 1), cB + hstepB + kstep, voffB);
        PG8_WAIT_V(6); PG8_BAR;
    } else {
        PG8_STAGE(PG8_SB(0, 0), cB, voffB); PG8_STAGE(PG8_SA(0, 0), cA, voffA); PG8_STAGE(PG8_SB(0, 1), cB + hstepB, voffB); PG8_STAGE(PG8_SA(0, 1), cA + hstep, voffA);
        if (wr == 1) PG8_BAR;
        PG8_WAIT_V(4); PG8_BAR;
        PG8_STAGE(PG8_SB(1, 0), cB + kstep, voffB); PG8_STAGE(PG8_SA(1, 0), cA + kstep, voffA); PG8_STAGE(PG8_SB(1, 1), cB + hstepB + kstep, voffB);
        PG8_WAIT_V(6); PG8_BAR;
    }
    for (;;) {
        const bool has_next = S.next(ui + 1, nxt);
        const char* nA = has_next ? (const char*)g.A + (size_t)nxt.pm * tstep : cA; const char* nB = has_next ? (const char*)g.Bt + (size_t)nxt.pn * tstep : cB;
        for (int t = 0; t < nt; t += 2) {
            const bool last = (t == nt - 2);
            const char* a1 = cA + (size_t)(t + 1) * kstep;
            const char* a2 = last ? nA : cA + (size_t)(t + 2) * kstep; const char* b2 = last ? nB : cB + (size_t)(t + 2) * kstep;
            const char* a3 = a2 + kstep; const char* b3 = b2 + kstep;
            if (last && has_next) S.a_ready(nxt);
            if constexpr (SP2) {
            PG8_LDB(B0, 0, 0); PG8_LDB(B1, 0, 1); PG8_SCHED; PG8_LDA(At, 0, 0); PG8_STAGE(PG8_SA(1, 1), a1 + hstep, voffA);
            PG8_WAIT_V(8); PG8_WAIT_L(0); PG8_BAR; PG8_MMA(0, 0, At, B0); PG8_MMA(0, 1, At, B1); PG8_BAR; PG8_SCHED;
            PG8_LDA(At, 0, 1); PG8_STAGE(PG8_SB(0, 0), b2, voffB); PG8_STAGE(PG8_SB(0, 1), b2 + hstepB, voffB); PG8_STAGE(PG8_SA(0, 0), a2, voffA);
            PG8_WAIT_V(8); PG8_WAIT_L(0); PG8_BAR; PG8_MMA(1, 0, At, B0); PG8_MMA(1, 1, At, B1); PG8_BAR; PG8_SCHED;
            PG8_LDB(B0, 1, 0); PG8_LDB(B1, 1, 1); PG8_SCHED; PG8_LDA(At, 1, 0); PG8_STAGE(PG8_SA(0, 1), a2 + hstep, voffA);
            PG8_WAIT_V(8); PG8_WAIT_L(0); PG8_BAR; PG8_MMA(0, 0, At, B0); PG8_MMA(0, 1, At, B1); PG8_BAR; PG8_SCHED;
            PG8_LDA(At, 1, 1); PG8_STAGE(PG8_SB(1, 0), b3, voffB); PG8_STAGE(PG8_SB(1, 1), b3 + hstepB, voffB); PG8_STAGE(PG8_SA(1, 0), a3, voffA);
            PG8_WAIT_V(8); PG8_WAIT_L(0); PG8_BAR; PG8_MMA(1, 0, At, B0); PG8_MMA(1, 1, At, B1); PG8_BAR; PG8_SCHED;
            } else {
            PG8_LDB(B0, 0, 0); PG8_SCHED; PG8_LDA(At, 0, 0); PG8_STAGE(PG8_SA(1, 1), a1 + hstep, voffA);
            PG8_WAIT_L(8); PG8_BAR; PG8_WAIT_L(0); PG8_MMA(0, 0, At, B0); PG8_BAR; PG8_SCHED;
            PG8_LDB(B1, 0, 1); PG8_STAGE(PG8_SB(0, 0), b2, voffB);
            PG8_BAR; PG8_WAIT_L(0); PG8_MMA(0, 1, At, B1); PG8_BAR;
            PG8_LDA(At, 0, 1); PG8_STAGE(PG8_SA(0, 0), a2, voffA);
            PG8_BAR; PG8_WAIT_L(0); PG8_MMA(1, 0, At, B0); PG8_BAR; PG8_SCHED;
            PG8_STAGE(PG8_SB(0, 1), b2 + hstepB, voffB);
            PG8_WAIT_V(6); PG8_BAR; PG8_MMA(1, 1, At, B1); PG8_BAR;
            PG8_LDB(B0, 1, 0); PG8_SCHED; PG8_LDA(At, 1, 0); PG8_STAGE(PG8_SA(0, 1), a2 + hstep, voffA);
            PG8_WAIT_L(8); PG8_BAR; PG8_WAIT_L(0); PG8_MMA(0, 0, At, B0); PG8_BAR; PG8_SCHED;
            PG8_LDB(B1, 1, 1); PG8_STAGE(PG8_SB(1, 0), b3, voffB);
            PG8_BAR; PG8_WAIT_L(0); PG8_MMA(0, 1, At, B1); PG8_BAR;
            PG8_LDA(At, 1, 1); PG8_STAGE(PG8_SA(1, 0), a3, voffA);
            PG8_BAR; PG8_WAIT_L(0); PG8_MMA(1, 0, At, B0); PG8_BAR; PG8_SCHED;
            PG8_STAGE(PG8_SB(1, 1), b3 + hstepB, voffB);
            PG8_WAIT_V(6); PG8_BAR; PG8_MMA(1, 1, At, B1); PG8_BAR;
            }
        }
        if constexpr (ALIGN_EPI) { if (wr == 0) PG8_BAR; }
        if constexpr (!Epi::AFTER_DRAIN) { E(acc, cur, wr, wc, fr, fq); S.done(cur); }
        if (!has_next) break;
#pragma unroll
        for (int a = 0; a < 2; ++a)
#pragma unroll
            for (int b = 0; b < 2; ++b)
#pragma unroll
                for (int m = 0; m < 4; ++m)
#pragma unroll
                    for (int n = 0; n < 2; ++n) acc[a][b][m][n] = (f32x4){0.f, 0.f, 0.f, 0.f};
        cur = nxt; cA = nA; cB = nB; ++ui;
        if constexpr (ALIGN_EPI) { if (wr == 1) PG8_BAR; }
    }
    PG8_WAIT_V(0);
    if constexpr (!ALIGN_EPI) { if (wr == 0) PG8_BAR; }
    PG8_BAR;
    if constexpr (Epi::AFTER_DRAIN) { E.fused(acc, cur, wr, wc, fr, fq, lds, wid, lane); S.done(cur); }
#undef PG8_SA
#undef PG8_SB
#undef PG8_STAGE
#undef PG8_LDA
#undef PG8_LDB
#undef PG8_MMA
#undef PG8_WAIT_V
#undef PG8_WAIT_L
#undef PG8_BAR
#undef PG8_SCHED
}
}
#define GAS __attribute__((address_space(1)))
#define LAS __attribute__((address_space(3)))
typedef unsigned short bf16;
typedef unsigned v4u __attribute__((ext_vector_type(4)));
typedef float f32x4 __attribute__((ext_vector_type(4)));
typedef short bf16x8 __attribute__((ext_vector_type(8)));
typedef GAS unsigned gu32;
typedef GAS unsigned long long gu64;
#define RLX_AGENT __ATOMIC_RELAXED, __HIP_MEMORY_SCOPE_AGENT
#define LDS_WAIT() asm volatile("s_waitcnt lgkmcnt(0)" ::: "memory")
#define VM_WAIT() asm volatile("s_waitcnt vmcnt(0)" ::: "memory")
__device__ __forceinline__ unsigned long long rt() { return __builtin_amdgcn_s_memrealtime(); }
__device__ __forceinline__ unsigned f2bf(float f) { unsigned u = __builtin_bit_cast(unsigned, f); return (u + 0x7fffu + ((u >> 16) & 1u)) >> 16; }
__device__ __forceinline__ unsigned pk2(float lo, float hi) { return f2bf(lo) | (f2bf(hi) << 16); }

#define XB_TMO      128
#define XB_XCNT(j)  (256  + 64 * (j))
#define XB_XSUB(j)  (1280 + 64 * (j))
#define XB_XGEN(j)  (2304 + 64 * (j))
#define XB_TOP      3328
#define XB_TOPGEN   3392
#define XCD_BAR_WORDS 3456
#define XB_SPIN_CAP (1u << 18)

__device__ __forceinline__ unsigned xb_ld(unsigned* p)              { return __hip_atomic_load(p, __ATOMIC_RELAXED, __HIP_MEMORY_SCOPE_AGENT); }
__device__ __forceinline__ unsigned xb_add(unsigned* p, unsigned v) { return __hip_atomic_fetch_add(p, v, __ATOMIC_RELAXED, __HIP_MEMORY_SCOPE_AGENT); }
__device__ __forceinline__ unsigned xb_xcc_id() { return (unsigned)__builtin_amdgcn_s_getreg((3 << 11) | 20) & 0xFu; }
#define XB_SPIN(cond, bar) do { unsigned _sp = 0; while (cond) { __builtin_amdgcn_s_sleep(1); \
    if ((++_sp & 255u) == 0u) { if (xb_ld(&(bar)[XB_TMO])) break; if (_sp > XB_SPIN_CAP) { atomicAdd(&(bar)[XB_TMO], 1u); break; } } } } while (0)

struct XcdBarrier {
    unsigned* bar; unsigned x;
    volatile LAS unsigned* st;
};

__device__ __forceinline__ XcdBarrier xcd_barrier_post(unsigned* bar, volatile LAS unsigned* st) {
    XcdBarrier b; b.bar = bar; b.x = xb_xcc_id(); b.st = st;
    if (threadIdx.x == 0) (void)xb_add(&bar[XB_XCNT(b.x)], 1u);
    return b;
}
__device__ __forceinline__ void xcd_barrier_complete(unsigned* bar, unsigned x, unsigned& nloc, unsigned& nx) {
    const unsigned G = gridDim.x * gridDim.y * gridDim.z;
    unsigned sum, cnt, mine, sp = 0u;
    for (;;) {
        sum = 0u; cnt = 0u; mine = 0u;
#pragma unroll
        for (unsigned j = 0; j < 16; ++j) { const unsigned c = xb_ld(&bar[XB_XCNT(j)]); sum += c; cnt += (c > 0u) ? 1u : 0u; mine = (j == x) ? c : mine; }
        if (sum == G) break;
        __builtin_amdgcn_s_sleep(1);
        if ((++sp & 255u) == 0u) { if (xb_ld(&bar[XB_TMO])) break; if (sp > XB_SPIN_CAP) { atomicAdd(&bar[XB_TMO], 1u); break; } }
    }
    nloc = mine > 0u ? mine : 1u; nx = cnt > 0u ? cnt : 1u;
}

__device__ __forceinline__ void xcd_barrier(const XcdBarrier& b) {
    asm volatile("s_waitcnt vmcnt(0)" ::: "memory");
    __syncthreads();
    if (threadIdx.x == 0) {
        unsigned* bar = b.bar;
        __builtin_amdgcn_s_waitcnt(0);
        unsigned nloc = b.st[0], nx = b.st[1];
        if (nloc == 0u) { xcd_barrier_complete(bar, b.x, nloc, nx); b.st[0] = nloc; b.st[1] = nx; }
        const unsigned old = xb_add(&bar[XB_XSUB(b.x)], 1u);
        const unsigned gen = old / nloc;
        if (old + 1u == (gen + 1u) * nloc) {
            __builtin_amdgcn_fence(__ATOMIC_RELEASE, "agent");
            asm volatile("s_waitcnt vmcnt(0)" ::: "memory");
            const unsigned og = xb_add(&bar[XB_TOP], 1u);
            const unsigned tg = og / nx;
            if (og + 1u == (tg + 1u) * nx) xb_add(&bar[XB_TOPGEN], 1u);
            else XB_SPIN(xb_ld(&bar[XB_TOPGEN]) == tg, bar);
            __builtin_amdgcn_fence(__ATOMIC_ACQUIRE, "agent");
            xb_add(&bar[XB_XGEN(b.x)], 1u);
            asm volatile("s_waitcnt vmcnt(0)" ::: "memory");
        } else {
            XB_SPIN(xb_ld(&bar[XB_XGEN(b.x)]) == gen, bar);
            __builtin_amdgcn_fence(__ATOMIC_ACQUIRE, "agent");
            asm volatile("s_waitcnt vmcnt(0)" ::: "memory");
        }
    }
    __syncthreads();
}
namespace att {
using bf16x8 = __attribute__((ext_vector_type(8))) short;
using s16x4  = __attribute__((ext_vector_type(4))) short;
using f32x16 = __attribute__((ext_vector_type(16))) float;
using u32x4  = __attribute__((ext_vector_type(4))) unsigned;
using u32x2  = __attribute__((ext_vector_type(2))) unsigned;
using f32x4  = __attribute__((ext_vector_type(4))) float;
typedef unsigned short bf16;
constexpr int LD = 7168;
constexpr int TILE_B = 64 * 128 * 2;
#define KSWZ(row, colB) ((row) * 256 + ((colB) ^ (((row) & 7) << 4)))
#define SBAR() __builtin_amdgcn_sched_barrier(0)
__device__ __forceinline__ int crow(int r, int hi) { return (r & 3) + 8 * (r >> 2) + 4 * hi; }
typedef float f32x2_t __attribute__((ext_vector_type(2))); typedef __bf16 bf16x2_t __attribute__((ext_vector_type(2)));
__device__ __forceinline__ unsigned cvtpk(float lo, float hi) { f32x2_t v = {lo, hi}; bf16x2_t b = __builtin_convertvector(v, bf16x2_t); return __builtin_bit_cast(unsigned, b); }
__device__ __forceinline__ bf16x8 ld8(const bf16* p) { return *reinterpret_cast<const bf16x8*>(p); }

constexpr float THR2 = 8.0f;
__device__ __forceinline__ void partialSM(f32x16& p0, f32x16& p1, float& m_reg, float& mn, float& alpha) {
  float pmax = p0[0];
#pragma unroll
  for (int r = 1; r < 16; ++r) pmax = fmaxf(pmax, p0[r]);
#pragma unroll
  for (int r = 0; r < 16; ++r) pmax = fmaxf(pmax, p1[r]);
  { auto rr = __builtin_amdgcn_permlane32_swap(__float_as_uint(pmax), __float_as_uint(pmax), false, false);
    pmax = fmaxf(__uint_as_float(rr[0]), __uint_as_float(rr[1])); }
  if (__builtin_expect(__all(pmax - m_reg <= THR2), 1)) { mn = m_reg; alpha = 1.f; }
  else { mn = fmaxf(m_reg, pmax); alpha = __builtin_amdgcn_exp2f(m_reg - mn); m_reg = mn; }
#pragma unroll
  for (int r = 0; r < 16; ++r) p0[r] = __builtin_amdgcn_exp2f(p0[r] - mn);
#pragma unroll
  for (int r = 0; r < 16; ++r) p1[r] -= mn;
}
#define ATT_PK4(P, BASE, OUT) do { unsigned a0 = cvtpk(P[BASE + 0], P[BASE + 1]), a1 = cvtpk(P[BASE + 2], P[BASE + 3]);   \
    unsigned b0 = cvtpk(P[BASE + 4], P[BASE + 5]), b1 = cvtpk(P[BASE + 6], P[BASE + 7]);                              \
    auto r0 = __builtin_amdgcn_permlane32_swap(a0, b0, false, false); auto r1 = __builtin_amdgcn_permlane32_swap(a1, b1, false, false); \
    u32x4 w = {r0[0], r1[0], r0[1], r1[1]}; OUT = *reinterpret_cast<bf16x8*>(&w); } while (0)
__device__ __forceinline__ void finishSM(f32x16& p0, f32x16& p1, float alpha, float& l_reg, bf16x8& pa0, bf16x8& pa1, bf16x8& pa2, bf16x8& pa3) {
#pragma unroll
  for (int r = 0; r < 16; ++r) p1[r] = __builtin_amdgcn_exp2f(p1[r]);
  float ps = 0;
#pragma unroll
  for (int r = 0; r < 16; ++r) ps += p0[r];
#pragma unroll
  for (int r = 0; r < 16; ++r) ps += p1[r];
  { auto rr = __builtin_amdgcn_permlane32_swap(__float_as_uint(ps), __float_as_uint(ps), false, false);
    ps = __uint_as_float(rr[0]) + __uint_as_float(rr[1]); }
  l_reg = l_reg * alpha + ps;
  ATT_PK4(p0, 0, pa0); ATT_PK4(p0, 8, pa1); ATT_PK4(p1, 0, pa2); ATT_PK4(p1, 8, pa3);
}
template <bool BATCH> __device__ __forceinline__ void qkt(f32x16& p0, f32x16& p1, const char* Ks, const bf16x8* qr, int r32, int hi) {
  if (BATCH) {
    bf16x8 b0[8], b1[8];
#pragma unroll
    for (int d0 = 0; d0 < 8; ++d0) { const int cb = (d0 * 16 + hi * 8) * 2;
      b0[d0] = *reinterpret_cast<const bf16x8*>(Ks + KSWZ(r32, cb)); b1[d0] = *reinterpret_cast<const bf16x8*>(Ks + KSWZ(32 + r32, cb)); }
#pragma unroll
    for (int d0 = 0; d0 < 8; ++d0) {
      p0 = __builtin_amdgcn_mfma_f32_32x32x16_bf16(b0[d0], qr[d0], p0, 0, 0, 0);
      p1 = __builtin_amdgcn_mfma_f32_32x32x16_bf16(b1[d0], qr[d0], p1, 0, 0, 0); }
  } else {
#pragma unroll
    for (int d0 = 0; d0 < 8; ++d0) { const int cb = (d0 * 16 + hi * 8) * 2;
      const bf16x8 b0 = *reinterpret_cast<const bf16x8*>(Ks + KSWZ(r32, cb));
      const bf16x8 b1 = *reinterpret_cast<const bf16x8*>(Ks + KSWZ(32 + r32, cb));
      p0 = __builtin_amdgcn_mfma_f32_32x32x16_bf16(b0, qr[d0], p0, 0, 0, 0);
      p1 = __builtin_amdgcn_mfma_f32_32x32x16_bf16(b1, qr[d0], p1, 0, 0, 0); }
  }
}
__device__ __forceinline__ int v_st(int k, int c) { const int kk = (k & ~0xC) | ((k & 4) << 1) | ((k & 8) >> 1); return ((kk >> 3) * 4 + (c >> 5)) * 512 + ((kk & 7) * 32 + (c & 31)) * 2; }
__device__ __forceinline__ int v_rd_base(int lane) { return ((lane & 3) << 3) | (((lane >> 2) & 3) << 6) | (((lane >> 4) & 1) << 5) | (((lane >> 5) & 1) << 8); }
constexpr int v_rd_off(int d0, int ks, int half) { return d0 * 512 + ks * 4096 + half * 2048; }
template <int OFF> __device__ __forceinline__ s16x4 tr_read(int vb) {
  s16x4 r; asm volatile("ds_read_b64_tr_b16 %0, %1 offset:%2" : "=&v"(r) : "v"(vb), "i"(OFF) : "memory"); return r;
}
#define ATT_PK(L, H) (bf16x8){L[0], L[1], L[2], L[3], H[0], H[1], H[2], H[3]}
template <int D0, bool TRANS> __device__ __forceinline__ void pv_one(f32x16& od, int vb, bf16x8 pa0, bf16x8 pa1, bf16x8 pa2, bf16x8 pa3) {
  const s16x4 l0 = tr_read<v_rd_off(D0, 0, 0)>(vb), h0 = tr_read<v_rd_off(D0, 0, 1)>(vb), l1 = tr_read<v_rd_off(D0, 1, 0)>(vb), h1 = tr_read<v_rd_off(D0, 1, 1)>(vb);
  const s16x4 l2 = tr_read<v_rd_off(D0, 2, 0)>(vb), h2 = tr_read<v_rd_off(D0, 2, 1)>(vb), l3 = tr_read<v_rd_off(D0, 3, 0)>(vb), h3 = tr_read<v_rd_off(D0, 3, 1)>(vb);
  asm volatile("s_waitcnt lgkmcnt(0)" ::: "memory"); SBAR();
  if (TRANS) {
    od = __builtin_amdgcn_mfma_f32_32x32x16_bf16(ATT_PK(l0, h0), pa0, od, 0, 0, 0);
    od = __builtin_amdgcn_mfma_f32_32x32x16_bf16(ATT_PK(l1, h1), pa1, od, 0, 0, 0);
    od = __builtin_amdgcn_mfma_f32_32x32x16_bf16(ATT_PK(l2, h2), pa2, od, 0, 0, 0);
    od = __builtin_amdgcn_mfma_f32_32x32x16_bf16(ATT_PK(l3, h3), pa3, od, 0, 0, 0);
  } else {
    od = __builtin_amdgcn_mfma_f32_32x32x16_bf16(pa0, ATT_PK(l0, h0), od, 0, 0, 0);
    od = __builtin_amdgcn_mfma_f32_32x32x16_bf16(pa1, ATT_PK(l1, h1), od, 0, 0, 0);
    od = __builtin_amdgcn_mfma_f32_32x32x16_bf16(pa2, ATT_PK(l2, h2), od, 0, 0, 0);
    od = __builtin_amdgcn_mfma_f32_32x32x16_bf16(pa3, ATT_PK(l3, h3), od, 0, 0, 0);
  }
}
template <int DA, bool TRANS> __device__ __forceinline__ void pv_two(f32x16& oa, f32x16& ob, int vb, bf16x8 pa0, bf16x8 pa1, bf16x8 pa2, bf16x8 pa3) {
  constexpr int DB = DA + 1;
  const s16x4 al0 = tr_read<v_rd_off(DA, 0, 0)>(vb), ah0 = tr_read<v_rd_off(DA, 0, 1)>(vb), al1 = tr_read<v_rd_off(DA, 1, 0)>(vb), ah1 = tr_read<v_rd_off(DA, 1, 1)>(vb);
  const s16x4 al2 = tr_read<v_rd_off(DA, 2, 0)>(vb), ah2 = tr_read<v_rd_off(DA, 2, 1)>(vb), al3 = tr_read<v_rd_off(DA, 3, 0)>(vb), ah3 = tr_read<v_rd_off(DA, 3, 1)>(vb);
  const s16x4 bl0 = tr_read<v_rd_off(DB, 0, 0)>(vb), bh0 = tr_read<v_rd_off(DB, 0, 1)>(vb), bl1 = tr_read<v_rd_off(DB, 1, 0)>(vb), bh1 = tr_read<v_rd_off(DB, 1, 1)>(vb);
  const s16x4 bl2 = tr_read<v_rd_off(DB, 2, 0)>(vb), bh2 = tr_read<v_rd_off(DB, 2, 1)>(vb), bl3 = tr_read<v_rd_off(DB, 3, 0)>(vb), bh3 = tr_read<v_rd_off(DB, 3, 1)>(vb);
  asm volatile("s_waitcnt lgkmcnt(0)" ::: "memory"); SBAR();
  if (TRANS) {
    oa = __builtin_amdgcn_mfma_f32_32x32x16_bf16(ATT_PK(al0, ah0), pa0, oa, 0, 0, 0); ob = __builtin_amdgcn_mfma_f32_32x32x16_bf16(ATT_PK(bl0, bh0), pa0, ob, 0, 0, 0);
    oa = __builtin_amdgcn_mfma_f32_32x32x16_bf16(ATT_PK(al1, ah1), pa1, oa, 0, 0, 0); ob = __builtin_amdgcn_mfma_f32_32x32x16_bf16(ATT_PK(bl1, bh1), pa1, ob, 0, 0, 0);
    oa = __builtin_amdgcn_mfma_f32_32x32x16_bf16(ATT_PK(al2, ah2), pa2, oa, 0, 0, 0); ob = __builtin_amdgcn_mfma_f32_32x32x16_bf16(ATT_PK(bl2, bh2), pa2, ob, 0, 0, 0);
    oa = __builtin_amdgcn_mfma_f32_32x32x16_bf16(ATT_PK(al3, ah3), pa3, oa, 0, 0, 0); ob = __builtin_amdgcn_mfma_f32_32x32x16_bf16(ATT_PK(bl3, bh3), pa3, ob, 0, 0, 0);
  } else {
    oa = __builtin_amdgcn_mfma_f32_32x32x16_bf16(pa0, ATT_PK(al0, ah0), oa, 0, 0, 0); ob = __builtin_amdgcn_mfma_f32_32x32x16_bf16(pa0, ATT_PK(bl0, bh0), ob, 0, 0, 0);
    oa = __builtin_amdgcn_mfma_f32_32x32x16_bf16(pa1, ATT_PK(al1, ah1), oa, 0, 0, 0); ob = __builtin_amdgcn_mfma_f32_32x32x16_bf16(pa1, ATT_PK(bl1, bh1), ob, 0, 0, 0);
    oa = __builtin_amdgcn_mfma_f32_32x32x16_bf16(pa2, ATT_PK(al2, ah2), oa, 0, 0, 0); ob = __builtin_amdgcn_mfma_f32_32x32x16_bf16(pa2, ATT_PK(bl2, bh2), ob, 0, 0, 0);
    oa = __builtin_amdgcn_mfma_f32_32x32x16_bf16(pa3, ATT_PK(al3, ah3), oa, 0, 0, 0); ob = __builtin_amdgcn_mfma_f32_32x32x16_bf16(pa3, ATT_PK(bl3, bh3), ob, 0, 0, 0);
  }
}
template <bool TRANS> __device__ __forceinline__ void pv_d0(f32x16* o, int vb, bf16x8 pa0, bf16x8 pa1, bf16x8 pa2, bf16x8 pa3) {
  if (TRANS) {
    pv_one<0, TRANS>(o[0], vb, pa0, pa1, pa2, pa3); pv_one<1, TRANS>(o[1], vb, pa0, pa1, pa2, pa3); pv_one<2, TRANS>(o[2], vb, pa0, pa1, pa2, pa3); pv_one<3, TRANS>(o[3], vb, pa0, pa1, pa2, pa3);
  } else { pv_two<0, TRANS>(o[0], o[1], vb, pa0, pa1, pa2, pa3); pv_two<2, TRANS>(o[2], o[3], vb, pa0, pa1, pa2, pa3); }
}

constexpr int A_V = 0, A_K = 2 * TILE_B, A_WS = 4 * TILE_B, A_BT = A_WS + 8 * 256, A_BYTES = A_BT + 768;
__device__ __forceinline__ void attn_unit(int b, int h, int g, const bf16* __restrict__ PROJ, const float* __restrict__ relb, bf16* __restrict__ MIX, char* lds) {
  const int tid = threadIdx.x, wid = __builtin_amdgcn_readfirstlane(tid >> 6), lane = tid & 63, r32 = lane & 31, hi = lane >> 5;
  char* V_lds = lds + A_V; char* K_lds = lds + A_K;
  float* ws = (float*)(lds + A_WS) + wid * 64; float* li_l = ws; float* al_l = ws + 32;
  float* btab = (float*)(lds + A_BT);
  if (tid < 192) btab[tid] = relb[h * 192 + tid] * 1.4426950408889634f;
  const int n = 4 * g + (wid >> 1), qi = (wid & 1) * 32 + r32;
  const long rowq = (long)b * 4096 + n * 64 + qi;
  float m_reg = -1e30f, l_reg = 0; f32x16 o[4] = {}; bf16x8 qr[8];
  { const bf16* Qw = PROJ + rowq * LD + 4096 + h * 128 + hi * 8;
#pragma unroll
    for (int d0 = 0; d0 < 8; ++d0) qr[d0] = ld8(Qw + d0 * 16); }
  const bf16* Kh = PROJ + (long)b * 4096 * LD + 5120 + h * 128; const bf16* Vh = Kh + 1024;
  const int sr = tid >> 4, sc = (tid & 15) * 8, vst0 = v_st(sr, sc), vst1 = v_st(32 + sr, sc);
  const int vb0 = (int)(uintptr_t)V_lds + v_rd_base(lane);
  bf16x8 vsA0, vsA1, ksA0, ksA1;
#define A_SLOAD(S, k0) do { vs##S##0 = ld8(&Vh[(long)((k0) + sr) * LD + sc]); vs##S##1 = ld8(&Vh[(long)((k0) + 32 + sr) * LD + sc]); \
    ks##S##0 = ld8(&Kh[(long)((k0) + sr) * LD + sc]); ks##S##1 = ld8(&Kh[(long)((k0) + 32 + sr) * LD + sc]); } while (0)
#define A_SWRITE(S, bb) do { *(bf16x8*)(V_lds + (bb) * TILE_B + vst0) = vs##S##0; *(bf16x8*)(V_lds + (bb) * TILE_B + vst1) = vs##S##1; \
    *(bf16x8*)(K_lds + (bb) * TILE_B + KSWZ(sr, sc * 2)) = ks##S##0; *(bf16x8*)(K_lds + (bb) * TILE_B + KSWZ(32 + sr, sc * 2)) = ks##S##1; } while (0)
  const int kc0 = (4 * g - 8) > 0 ? (4 * g - 8) : 0, NT = 4 * g + 4 - kc0;
  A_SLOAD(A, kc0 * 64); A_SWRITE(A, 0); __syncthreads();
#define A_COMPUTE(j, bb) do { const int kc = kc0 + (j); const int delta = n - kc;                                            \
    if (delta >= 0 && delta <= 8) { \
      f32x16 p0, p1; \
      if (delta >= 3) { const float bc = btab[191]; \
        _Pragma("unroll") for (int r = 0; r < 16; ++r) { p0[r] = bc; p1[r] = bc; } } \
      else { const int base = 64 * delta + qi + 63;                     \
        _Pragma("unroll") for (int r = 0; r < 16; ++r) { const int kl = crow(r, hi); int i0 = base - kl, i1 = base - kl - 32; i0 = i0 > 191 ? 191 : i0; i1 = i1 > 191 ? 191 : i1; p0[r] = btab[i0]; p1[r] = btab[i1]; } } \
      qkt<true>(p0, p1, K_lds + (bb) * TILE_B, qr, r32, hi); \
      float mn, alpha; bf16x8 pa0, pa1, pa2, pa3; \
      partialSM(p0, p1, m_reg, mn, alpha); \
      if (__any(alpha < 1.f)) { if (hi == 0) al_l[r32] = alpha; asm volatile("s_waitcnt lgkmcnt(0)" ::: "memory"); \
        _Pragma("unroll") for (int d = 0; d < 4; ++d) _Pragma("unroll") for (int r = 0; r < 16; ++r) o[d][r] *= al_l[crow(r, hi)]; } \
      finishSM(p0, p1, alpha, l_reg, pa0, pa1, pa2, pa3); SBAR(); \
      pv_d0<false>(o, vb0 + (bb) * TILE_B, pa0, pa1, pa2, pa3); \
    } } while (0)
  for (int j = 0; j < NT; j += 2) {
    A_SLOAD(A, (kc0 + j + 1) * 64);
    A_COMPUTE(j, 0);
    A_SWRITE(A, 1);
    __syncthreads();
    if (j + 2 < NT) A_SLOAD(A, (kc0 + j + 2) * 64);
    A_COMPUTE(j + 1, 1);
    if (j + 2 < NT) A_SWRITE(A, 0);
    __syncthreads();
  }
#undef A_COMPUTE
  if (hi == 0) li_l[r32] = l_reg; asm volatile("s_waitcnt lgkmcnt(0)" ::: "memory");
  { bf16* stg = (bf16*)(lds + wid * 8192);
#pragma unroll
    for (int r = 0; r < 16; ++r) { const int orow = crow(r, hi); const float rl = __builtin_amdgcn_rcpf(li_l[orow]);
#pragma unroll
      for (int d0 = 0; d0 < 4; ++d0) { const unsigned w = cvtpk(o[d0][r] * rl, 0.f); stg[orow * 128 + d0 * 32 + r32] = (bf16)(w & 0xffffu); } }
    asm volatile("s_waitcnt lgkmcnt(0)" ::: "memory");
    bf16* Ow = MIX + ((long)b * 4096 + n * 64 + (wid & 1) * 32) * 2048 + 1024 + h * 128;
#pragma unroll
    for (int i = 0; i < 8; ++i) { const int row = i * 4 + (lane >> 4), ch = lane & 15; const u32x4 v = *(const u32x4*)(stg + row * 128 + ch * 8); *(u32x4*)(Ow + (long)row * 2048 + ch * 8) = v; } }
  __syncthreads();
#undef A_SLOAD
#undef A_SWRITE
}

constexpr int R_K = 0, R_V = 4 * TILE_B;
__device__ __forceinline__ bf16x8 scale8(bf16x8 x, float s) {
  const u32x4 w = *reinterpret_cast<const u32x4*>(&x); u32x4 o;
#pragma unroll
  for (int i = 0; i < 4; ++i) o[i] = cvtpk(__uint_as_float(w[i] << 16) * s, __uint_as_float(w[i] & 0xffff0000u) * s);
  return *reinterpret_cast<bf16x8*>(&o);
}
template <bool KIMG> __device__ __forceinline__ void ret_stage(int b, int h, int g, const bf16* __restrict__ PROJ, char* lds, float lg2h) {
  const int tid = threadIdx.x, c = __builtin_amdgcn_readfirstlane(tid >> 7), t2 = tid & 127, sr = t2 >> 4, sc = (t2 & 15) * 8;
  const bf16* Kc = PROJ + ((long)b * 4096 + (4 * g + c) * 64) * LD + 1024 + h * 128; const bf16* Vc = Kc + 1024;
  char* Kt = lds + R_K + c * TILE_B; char* Vt = lds + R_V + c * TILE_B;
  constexpr int NB = 2, PB = 8 / NB;
#pragma unroll
  for (int hb = 0; hb < NB; ++hb) {
    bf16x8 kv[PB], vv[PB];
#pragma unroll
    for (int i = 0; i < PB; ++i) { const int row = sr + 8 * (PB * hb + i); kv[i] = ld8(Kc + (long)row * LD + sc); vv[i] = ld8(Vc + (long)row * LD + sc); }
#pragma unroll
    for (int i = 0; i < PB; ++i) { const int row = sr + 8 * (PB * hb + i);
      if (KIMG) *(bf16x8*)(Kt + v_st(row, sc)) = scale8(kv[i], __builtin_amdgcn_exp2f(lg2h * (float)(63 - row)));
      else *(bf16x8*)(Kt + KSWZ(row, sc * 2)) = kv[i];
      *(bf16x8*)(Vt + v_st(row, sc)) = vv[i]; }
  }
  __syncthreads();
}
template <int D0, int KS> __device__ __forceinline__ bf16x8 img_frag(int vb) {
  const s16x4 l = tr_read<v_rd_off(D0, KS, 0)>(vb), hh = tr_read<v_rd_off(D0, KS, 1)>(vb);
  asm volatile("s_waitcnt lgkmcnt(0)" ::: "memory"); SBAR();
  return ATT_PK(l, hh);
}
__device__ __forceinline__ void contrib_unit(int b, int h, int g, const bf16* __restrict__ PROJ, bf16* __restrict__ CONTRIB, char* lds, float lg2h) {
  ret_stage<true>(b, h, g, PROJ, lds, lg2h);
  const int tid = threadIdx.x, wid = __builtin_amdgcn_readfirstlane(tid >> 6), lane = tid & 63, r32 = lane & 31, hi = lane >> 5, c = wid >> 1, dvh = wid & 1;
  const int kb = (int)(uintptr_t)(lds + R_K + c * TILE_B) + v_rd_base(lane), vb = (int)(uintptr_t)(lds + R_V + c * TILE_B) + v_rd_base(lane);
  f32x16 acc[4][2] = {};
#define C_RD(D0, KS, B, L, H) const s16x4 L = tr_read<v_rd_off(D0, KS, 0)>(B), H = tr_read<v_rd_off(D0, KS, 1)>(B)
#define C_STEP(KS) do { bf16x8 v0, v1; { s16x4 v0l, v0h, v1l, v1h; if (dvh) { v0l = tr_read<v_rd_off(2, KS, 0)>(vb); v0h = tr_read<v_rd_off(2, KS, 1)>(vb); v1l = tr_read<v_rd_off(3, KS, 0)>(vb); v1h = tr_read<v_rd_off(3, KS, 1)>(vb); } \
      else { v0l = tr_read<v_rd_off(0, KS, 0)>(vb); v0h = tr_read<v_rd_off(0, KS, 1)>(vb); v1l = tr_read<v_rd_off(1, KS, 0)>(vb); v1h = tr_read<v_rd_off(1, KS, 1)>(vb); } \
      asm volatile("s_waitcnt lgkmcnt(0)" ::: "memory"); SBAR(); v0 = ATT_PK(v0l, v0h); v1 = ATT_PK(v1l, v1h); } \
    C_RD(0, KS, kb, k0l, k0h); C_RD(1, KS, kb, k1l, k1h); C_RD(2, KS, kb, k2l, k2h); C_RD(3, KS, kb, k3l, k3h); \
    asm volatile("s_waitcnt lgkmcnt(0)" ::: "memory"); SBAR();        \
    const bf16x8 ka0 = ATT_PK(k0l, k0h), ka1 = ATT_PK(k1l, k1h), ka2 = ATT_PK(k2l, k2h), ka3 = ATT_PK(k3l, k3h); \
    acc[0][0] = __builtin_amdgcn_mfma_f32_32x32x16_bf16(ka0, v0, acc[0][0], 0, 0, 0); acc[0][1] = __builtin_amdgcn_mfma_f32_32x32x16_bf16(ka0, v1, acc[0][1], 0, 0, 0); \
    acc[1][0] = __builtin_amdgcn_mfma_f32_32x32x16_bf16(ka1, v0, acc[1][0], 0, 0, 0); acc[1][1] = __builtin_amdgcn_mfma_f32_32x32x16_bf16(ka1, v1, acc[1][1], 0, 0, 0); \
    acc[2][0] = __builtin_amdgcn_mfma_f32_32x32x16_bf16(ka2, v0, acc[2][0], 0, 0, 0); acc[2][1] = __builtin_amdgcn_mfma_f32_32x32x16_bf16(ka2, v1, acc[2][1], 0, 0, 0); \
    acc[3][0] = __builtin_amdgcn_mfma_f32_32x32x16_bf16(ka3, v0, acc[3][0], 0, 0, 0); acc[3][1] = __builtin_amdgcn_mfma_f32_32x32x16_bf16(ka3, v1, acc[3][1], 0, 0, 0); } while (0)
  C_STEP(0); C_STEP(1); C_STEP(2); C_STEP(3);
#undef C_STEP
#undef C_RD
  const int unit = (b * 8 + h) * 64 + 4 * g + c;
  bf16* Cb = CONTRIB + (long)unit * 16384 + dvh * 64 * 128;
  __syncthreads();
  { char* stg = lds + wid * 16384;
#pragma unroll
    for (int dkb = 0; dkb < 4; ++dkb)
#pragma unroll
      for (int dvb = 0; dvb < 2; ++dvb) { const int row = 32 * dvb + r32;
#pragma unroll
        for (int rq = 0; rq < 4; ++rq) { const int dk = 32 * dkb + 8 * rq + 4 * hi; const f32x16& a = acc[dkb][dvb];
          u32x2 w; w.x = cvtpk(a[4 * rq], a[4 * rq + 1]); w.y = cvtpk(a[4 * rq + 2], a[4 * rq + 3]);
          *(u32x2*)(stg + row * 256 + ((((dk >> 3) ^ (row & 15)) << 4) | ((dk & 4) << 1))) = w; } }
    asm volatile("s_waitcnt lgkmcnt(0)" ::: "memory");
#pragma unroll
    for (int i = 0; i < 16; ++i) { const int row = i * 4 + (lane >> 4), ch = lane & 15; const u32x4 v = *(const u32x4*)(stg + row * 256 + ((ch ^ (row & 15)) << 4)); *(u32x4*)(Cb + row * 128 + ch * 8) = v; } }
  __syncthreads();
}
template <int RT_EXP = 0> __device__ __forceinline__ void retout_unit(int b, int h, int g, const bf16* __restrict__ PROJ, const bf16* __restrict__ PREV, const float* __restrict__ gn, bf16* __restrict__ MIX, char* lds, float* dtab, float lg2h) {
  const int tid = threadIdx.x, wid = __builtin_amdgcn_readfirstlane(tid >> 6), lane = tid & 63, r32 = lane & 31, hi = lane >> 5, c = wid >> 1;
  if (tid < 64) dtab[tid] = __builtin_amdgcn_exp2f(lg2h * (float)tid);
  const int n = 4 * g + c, qi = (wid & 1) * 32 + r32;
  const long rowq = (long)b * 4096 + n * 64 + qi;
  bf16x8 qr[8];
  { const bf16* Qw = PROJ + rowq * LD + h * 128 + hi * 8;
#pragma unroll
    for (int d0 = 0; d0 < 8; ++d0) qr[d0] = ld8(Qw + d0 * 16); }
  ret_stage<false>(b, h, g, PROJ, lds, lg2h);
  f32x16 p0 = {}, p1 = {};
  if (RT_EXP != 2) qkt<false>(p0, p1, lds + R_K + c * TILE_B, qr, r32, hi);
  { const float iq = __builtin_amdgcn_exp2f(-lg2h * (float)(qi + 1));
#pragma unroll
    for (int r = 0; r < 16; ++r) { const int kl = crow(r, hi); const int d0 = qi > kl ? qi - kl : kl - qi; const int d1 = qi > kl + 32 ? qi - kl - 32 : kl + 32 - qi;
      p0[r] *= dtab[d0] * iq; p1[r] *= dtab[d1] * iq; } }
  bf16x8 pa0, pa1, pa2, pa3;
  ATT_PK4(p0, 0, pa0); ATT_PK4(p0, 8, pa1); ATT_PK4(p1, 0, pa2); ATT_PK4(p1, 8, pa3);
  f32x16 o[4] = {};
  if (RT_EXP != 2) pv_d0<true>(o, (int)(uintptr_t)(lds + R_V + c * TILE_B) + v_rd_base(lane), pa0, pa1, pa2, pa3);
  if (RT_EXP != 1) { const int unit = (b * 8 + h) * 64 + n; const bf16* Pb = PREV + (long)unit * 16384 + hi * 8;
#pragma unroll
    for (int d0 = 0; d0 < 4; ++d0) { bf16x8 a[8]; asm volatile("" ::: "memory");
#pragma unroll
      for (int s = 0; s < 8; ++s) a[s] = ld8(Pb + (32 * d0 + r32) * 128 + 16 * s);
#pragma unroll
      for (int s = 0; s < 8; ++s) o[d0] = __builtin_amdgcn_mfma_f32_32x32x16_bf16(a[s], qr[s], o[d0], 0, 0, 0); } }
  float s1 = 0.f;
#pragma unroll
  for (int d0 = 0; d0 < 4; ++d0)
#pragma unroll
    for (int r = 0; r < 16; ++r) s1 += o[d0][r];
  { auto rr = __builtin_amdgcn_permlane32_swap(__float_as_uint(s1), __float_as_uint(s1), false, false); s1 = __uint_as_float(rr[0]) + __uint_as_float(rr[1]); }
  const float mu = s1 * (1.f / 128.f); float s2 = 0.f;
#pragma unroll
  for (int d0 = 0; d0 < 4; ++d0)
#pragma unroll
    for (int r = 0; r < 16; ++r) { o[d0][r] -= mu; s2 += o[d0][r] * o[d0][r]; }
  { auto rr = __builtin_amdgcn_permlane32_swap(__float_as_uint(s2), __float_as_uint(s2), false, false); s2 = __uint_as_float(rr[0]) + __uint_as_float(rr[1]); }
  const float qd = __builtin_amdgcn_exp2f(lg2h * (float)(qi + 1));
  const float sc = qd / sqrtf(qd * qd * s2 * (1.f / 128.f) + 1e-5f);
  const bf16* Gq = PROJ + rowq * LD + 3072 + h * 128; const float* gnh = gn + h * 128;
  __syncthreads();
  { char* stg = lds + wid * 8192;
#pragma unroll
    for (int d0 = 0; d0 < 4; ++d0) { asm volatile("" ::: "memory");
#pragma unroll
      for (int rq = 0; rq < 4; ++rq) { const int dv = 32 * d0 + 8 * rq + 4 * hi;
        const u32x2 gt = *(const u32x2*)(Gq + dv); const f32x4 gg = *(const f32x4*)(gnh + dv);
        const float y0 = o[d0][4 * rq] * sc * gg[0] * __uint_as_float(gt.x << 16), y1 = o[d0][4 * rq + 1] * sc * gg[1] * __uint_as_float(gt.x & 0xffff0000u);
        const float y2 = o[d0][4 * rq + 2] * sc * gg[2] * __uint_as_float(gt.y << 16), y3 = o[d0][4 * rq + 3] * sc * gg[3] * __uint_as_float(gt.y & 0xffff0000u);
        u32x2 w; w.x = cvtpk(y0, y1); w.y = cvtpk(y2, y3);
        *(u32x2*)(stg + r32 * 256 + ((((dv >> 3) ^ (r32 & 15)) << 4) | ((dv & 4) << 1))) = w; } }
    asm volatile("s_waitcnt lgkmcnt(0)" ::: "memory");
    bf16* Ow = MIX + ((long)b * 4096 + n * 64 + (wid & 1) * 32) * 2048 + h * 128;
#pragma unroll
    for (int i = 0; i < 8; ++i) { const int row = i * 4 + (lane >> 4), ch = lane & 15; const u32x4 v = *(const u32x4*)(stg + row * 256 + ((ch ^ (row & 15)) << 4)); *(u32x4*)(Ow + (long)row * 2048 + ch * 8) = v; } }
  __syncthreads();
}
}
#ifndef NAIVE_CONTRIB
#define NAIVE_CONTRIB 0
#endif
#ifndef NAIVE_RETOUT
#define NAIVE_RETOUT 0
#endif
#ifndef PROBE_REPEAT_MASK
#define PROBE_REPEAT_MASK 0
#endif
#ifndef PROBE_EXTRA_BARS
#define PROBE_EXTRA_BARS 0
#endif
#define REPS(k)
#ifndef CONV_C1
#define CONV_C1 18432
#endif
#ifndef CONV_C2
#define CONV_C2 18432
#endif
#ifndef CONV_C3
#define CONV_C3 18432
#endif
#ifndef CONV_WGS
#define CONV_WGS 32
#endif
#ifndef CV_PW
#define CV_PW 4
#endif
#ifndef PROBE_X
#define PROBE_X 7
#endif
#ifndef PROBE_XN
#define PROBE_XN 1
#endif
#ifndef PROBE_T
#define PROBE_T 0
#endif
#ifndef PROBE_TA
#define PROBE_TA 0
#endif
#ifndef PROBE_TB
#define PROBE_TB 8
#endif
#ifndef PROBE_TOFF
#define PROBE_TOFF 0
#endif
#ifndef PROBE_TQ
#define PROBE_TQ 1
#endif
#ifndef PROBE_TTHR
#define PROBE_TTHR 0
#endif
constexpr int NWAVES = 8;
#ifndef MK_N_LAUNCHES
#define MK_N_LAUNCHES 8
#endif
constexpr int PER_PHASE = 8;
constexpr int N_LAUNCHES = MK_N_LAUNCHES;

constexpr int BATCH = 2, SEQ = 4096, DM = 2048, M = BATCH * SEQ, NIN = 7168, DFF = 8192;
constexpr int CH = 64, NCH = SEQ / CH, NH = 8, HD = 128, LEFT = 8, RELSZ = 192;
constexpr float EPS = 1e-6f, GN_EPS = 1e-5f, LOG2E = 1.4426950408889634f;
constexpr int SEC_RQ = 0, SEC_RK = 1024, SEC_RV = 2048, SEC_RG = 3072, SEC_AQ = 4096, SEC_AK = 5120, SEC_AV = 6144;

constexpr size_t MiB = 1u << 20;
constexpr size_t WS_CTL = 0, CTL_ZERO_BYTES = 32768;
constexpr size_t WS_WOT = 1 * MiB, WS_W1T = 9 * MiB, WS_W2T = 41 * MiB, WS_WINT = 73 * MiB;
constexpr size_t WS_MIX = 73 * MiB;
constexpr size_t WS_PROJ = 105 * MiB;
constexpr size_t WS_PREV = 217 * MiB;
constexpr size_t WS_X1B = 217 * MiB;
constexpr size_t WS_CS = 249 * MiB;
constexpr size_t WS_ROWSS = 251 * MiB;
constexpr size_t WS_U = 73 * MiB;
constexpr size_t WS_CSSTEP = 252 * MiB;
constexpr size_t WS_END = 252 * MiB + 4096;
constexpr size_t OUT_XN = 0, OUT_CONTRIB = 32 * MiB;
static_assert(WS_U + (size_t)M * DFF * 2 <= WS_X1B && WS_WINT + (size_t)NIN * DM * 2 <= WS_PROJ && WS_PROJ + (size_t)M * NIN * 2 <= WS_PREV, "d_ws map");
constexpr int CW_TMO = 0, CW_CODE = 1;
constexpr int CW_BAR = 4096;
constexpr int CW_CONV = 1024;

constexpr int RING_OFF = 0, RING_BYTES = 131072;
constexpr int XCH_OFF = RING_BYTES, XCH_BYTES = 8192;
constexpr int LDSCTL_OFF = XCH_OFF + XCH_BYTES, MISC_OFF = LDSCTL_OFF + 320;
constexpr int LDS_BYTES = 147456;
static_assert(MISC_OFF + 128 <= LDS_BYTES, "LDS map");

struct Frame {
    LAS unsigned char* lds;
    volatile LAS unsigned* MISC;
    gu32* ctl;
    int tid, lane, wave;
    int vcu, G;
};
__device__ __forceinline__ float wave_sum(float v) {
#pragma unroll
    for (int o = 1; o < 64; o <<= 1) v += __shfl_xor(v, o);
    return v;
}
__device__ __forceinline__ float wave_max(float v) {
#pragma unroll
    for (int o = 1; o < 64; o <<= 1) v = fmaxf(v, __shfl_xor(v, o));
    return v;
}
__device__ __forceinline__ float bf_lo(unsigned u) { return __uint_as_float(u << 16); }
__device__ __forceinline__ float bf_hi(unsigned u) { return __uint_as_float(u & 0xffff0000u); }

template <bool ROT, bool BLKOUT = false>
__device__ __forceinline__ void p0_transpose_item(const float* W, int K, int N, bf16* WT, LAS float* scr, int item, int lane) {
    const int nblk = N / 32, kb = item / nblk, nb = item % nblk, k0 = 64 * kb, n0 = 32 * nb;
    f32x4 v[8];
    { const float* p = W + (size_t)(k0 + (lane >> 3)) * N + n0 + 4 * (lane & 7);
#pragma unroll
      for (int i = 0; i < 8; ++i) v[i] = __builtin_nontemporal_load((const GAS f32x4*)(p + (size_t)(8 * i) * N)); }
#pragma unroll
    for (int i = 0; i < 8; ++i) { LAS float* d = scr + (8 * i + (lane >> 3)) * 33 + 4 * (lane & 7); d[0] = v[i].x; d[1] = v[i].y; d[2] = v[i].z; d[3] = v[i].w; }
    LDS_WAIT(); asm volatile("" ::: "memory");
    const int c = lane & 7;
#pragma unroll
    for (int j = 0; j < 4; ++j) { const int n = (lane >> 3) + 8 * j; const LAS float* s = scr + (8 * c) * 33 + n;
        v4u o; o.x = pk2(s[0 * 33], s[1 * 33]); o.y = pk2(s[2 * 33], s[3 * 33]); o.z = pk2(s[4 * 33], s[5 * 33]); o.w = pk2(s[6 * 33], s[7 * 33]);
        int row = n0 + n;
        if (ROT && row < 2048) { const int d = row & 127; row = (row & ~127) + 2 * (d & 63) + (d >> 6); }
        if (BLKOUT) *(GAS v4u*)((GAS char*)WT + ((size_t)(row >> 8) * (K / 64) + kb) * 32768 + (row & 255) * 128 + 16 * c) = o;
        else *(GAS v4u*)(WT + (size_t)row * K + k0 + 8 * c) = o; }
    LDS_WAIT(); asm volatile("" ::: "memory");
}

__device__ __forceinline__ void tr_load(const float* W, int N, int item, f32x4 (&v)[8], int lane) {
    const int nblk = N / 32, kb = item / nblk, nb = item % nblk;
    const float* p = W + (size_t)(64 * kb + (lane >> 3)) * N + 32 * nb + 4 * (lane & 7);
#pragma unroll
    for (int i = 0; i < 8; ++i) v[i] = __builtin_nontemporal_load((const GAS f32x4*)(p + (size_t)(8 * i) * N));
}
template <bool ROT>
__device__ __forceinline__ void tr_finish(bf16* WT, int K, int N, int item, const f32x4 (&v)[8], LAS float* scr, int lane) {
    const int nblk = N / 32, kb = item / nblk, nb = item % nblk, k0 = 64 * kb, n0 = 32 * nb;
#pragma unroll
    for (int i = 0; i < 8; ++i) { LAS float* d = scr + (8 * i + (lane >> 3)) * 33 + 4 * (lane & 7); d[0] = v[i].x; d[1] = v[i].y; d[2] = v[i].z; d[3] = v[i].w; }
    LDS_WAIT(); asm volatile("" ::: "memory");
    const int c = lane & 7;
#pragma unroll
    for (int j = 0; j < 4; ++j) { const int n = (lane >> 3) + 8 * j; const LAS float* s = scr + (8 * c) * 33 + n;
        v4u o; o.x = pk2(s[0 * 33], s[1 * 33]); o.y = pk2(s[2 * 33], s[3 * 33]); o.z = pk2(s[4 * 33], s[5 * 33]); o.w = pk2(s[6 * 33], s[7 * 33]);
        int row = n0 + n;
        if (ROT && row < 2048) { const int d = row & 127; row = (row & ~127) + 2 * (d & 63) + (d >> 6); }
        *(GAS v4u*)(WT + (size_t)row * K + k0 + 8 * c) = o; }
    LDS_WAIT(); asm volatile("" ::: "memory");
}
struct CvMats { const float* w_out; const float* w1; const float* w2; bf16* WoT; bf16* W1T; bf16* W2T; const float* g2; };
constexpr int CV_I_O = (DM / 64) * (DM / 32), CV_I_1 = (DM / 64) * (DFF / 32), CV_I_2 = (DFF / 64) * (DM / 32);
__device__ __forceinline__ void cv_load(const CvMats& m, int r, f32x4 (&v)[8], int lane) {
    const float* W; int N, item;
    if (r < CV_I_O) { W = m.w_out; N = DM; item = r; } else if (r < CV_I_O + CV_I_1) { W = m.w1; N = DFF; item = r - CV_I_O; } else { W = m.w2; N = DM; item = r - CV_I_O - CV_I_1; }
    const int nblk = N / 32, kb = item / nblk, nb = item % nblk;
    const float* p = W + (size_t)(64 * kb + (lane >> 3)) * N + 32 * nb + 4 * (lane & 7);
#pragma unroll
    for (int i = 0; i < 8; ++i) v[i] = __builtin_nontemporal_load((const GAS f32x4*)(p + (size_t)(8 * i) * N));
    if (r >= CV_I_O && r < CV_I_O + CV_I_1) {
#pragma unroll
        for (int i = 0; i < 8; ++i) v[i] *= m.g2[64 * kb + 8 * i + (lane >> 3)];
    }
}
__device__ __forceinline__ void cv_finish(const CvMats& m, int r, const f32x4 (&v)[8], LAS float* scr, int lane) {
    bf16* WT; int K, N, item; bool blk = false;
    if (r < CV_I_O) { WT = m.WoT; K = DM; N = DM; item = r; } else if (r < CV_I_O + CV_I_1) { WT = m.W1T; K = DM; N = DFF; item = r - CV_I_O; } else { WT = m.W2T; K = DFF; N = DM; item = r - CV_I_O - CV_I_1; blk = true; }
    const int nblk = N / 32, kb = item / nblk, nb = item % nblk, k0 = 64 * kb, n0 = 32 * nb;
#pragma unroll
    for (int i = 0; i < 8; ++i) { LAS float* d = scr + (8 * i + (lane >> 3)) * 33 + 4 * (lane & 7); d[0] = v[i].x; d[1] = v[i].y; d[2] = v[i].z; d[3] = v[i].w; }
    LDS_WAIT(); asm volatile("" ::: "memory");
    const int c = lane & 7;
#pragma unroll
    for (int j = 0; j < 4; ++j) { const int n = (lane >> 3) + 8 * j; const LAS float* s = scr + (8 * c) * 33 + n;
        v4u o; o.x = pk2(s[0 * 33], s[1 * 33]); o.y = pk2(s[2 * 33], s[3 * 33]); o.z = pk2(s[4 * 33], s[5 * 33]); o.w = pk2(s[6 * 33], s[7 * 33]);
        const int row = n0 + n;
        if (blk) __builtin_nontemporal_store(o, (GAS v4u*)((GAS char*)WT + ((size_t)(row >> 8) * (K / 64) + kb) * 32768 + (row & 255) * 128 + 16 * c));
        else __builtin_nontemporal_store(o, (GAS v4u*)(WT + (size_t)row * K + k0 + 8 * c)); }
    LDS_WAIT(); asm volatile("" ::: "memory");
}
struct Args { const float* in[11]; float* out; unsigned char* ws; float lg[8]; int ph_lo, ph_hi, li, pad; };
#define LGSEL(h) ((h) == 0 ? args.lg[0] : (h) == 1 ? args.lg[1] : (h) == 2 ? args.lg[2] : (h) == 3 ? args.lg[3] : (h) == 4 ? args.lg[4] : (h) == 5 ? args.lg[5] : (h) == 6 ? args.lg[6] : args.lg[7])

__global__ void __launch_bounds__(NWAVES * 64, 2) hymba_fwd(Args args) {
    extern __shared__ __attribute__((aligned(16))) unsigned char lds[];
    Frame F;
    F.lds = (LAS unsigned char*)lds;
    F.MISC = (volatile LAS unsigned*)(F.lds + MISC_OFF);
    F.tid = threadIdx.x; F.lane = F.tid & 63; F.wave = __builtin_amdgcn_readfirstlane(F.tid >> 6);
    F.G = gridDim.x; { const int bx = blockIdx.x; F.vcu = (F.G % 8 == 0) ? (bx % 8) * (F.G / 8) + bx / 8 : bx; }
    unsigned char* ws = args.ws;
    F.ctl = (gu32*)(ws + WS_CTL);
    const float* x = args.in[0]; const float* g1 = args.in[1]; const float* w_in = args.in[2]; const float* gn = args.in[3];
    const float* qg = args.in[4]; const float* kg = args.in[5]; const float* relb = args.in[6]; const float* w_out = args.in[7];
    const float* g2 = args.in[8]; const float* w1 = args.in[9]; const float* w2 = args.in[10];
    float* out = args.out;
    bf16* WinT = (bf16*)(ws + WS_WINT); bf16* WoT = (bf16*)(ws + WS_WOT); bf16* W1T = (bf16*)(ws + WS_W1T); bf16* W2T = (bf16*)(ws + WS_W2T);
    bf16* MIX = (bf16*)(ws + WS_MIX); bf16* PROJ = (bf16*)(ws + WS_PROJ); bf16* PREV = (bf16*)(ws + WS_PREV); bf16* X1B = (bf16*)(ws + WS_X1B);
    float* CS = (float*)(ws + WS_CS); float* ROWSS = (float*)(ws + WS_ROWSS); bf16* U = (bf16*)(ws + WS_U);
    bf16* XN = (bf16*)((unsigned char*)out + OUT_XN); bf16* CONTRIB = (bf16*)((unsigned char*)out + OUT_CONTRIB);

    for (int u = F.tid; u < (LDS_BYTES - LDSCTL_OFF) / 4; u += NWAVES * 64) ((LAS unsigned*)(F.lds + LDSCTL_OFF))[u] = 0u;
    __syncthreads();
    XcdBarrier bar; bar.bar = (unsigned*)(F.ctl + CW_BAR); bar.x = 0; bar.st = nullptr;
    if (N_LAUNCHES != PER_PHASE) bar = xcd_barrier_post((unsigned*)(F.ctl + CW_BAR), F.MISC + 8);
#define GRID_BAR(seam) do { if (N_LAUNCHES == PER_PHASE) { if (F.tid == 0) __hip_atomic_store(F.ctl + CW_TMO, 0xBADBA0u | (unsigned)(seam), RLX_AGENT); } \
    else { xcd_barrier(bar); } } while (0)
    const int lo = args.ph_lo, hi = args.ph_hi;
#if PROBE_T
#define TSTAMP(k) do { if (blockIdx.x == 0 && F.tid == 0) { const unsigned long long t_ = __builtin_amdgcn_s_memrealtime(); F.MISC[32 + 2 * (k)] = (unsigned)t_; F.MISC[33 + 2 * (k)] = (unsigned)(t_ >> 32); } } while (0)
#else
#define TSTAMP(k) do { } while (0)
#endif
    TSTAMP(0);
#define IN(k) (lo <= (k) && (k) < hi)
#define BOTH(k) (IN(k) && IN((k) + 1))
    const int gw = F.vcu * NWAVES + F.wave, NGW = F.G * NWAVES;

    constexpr int I_IN = (DM / 64) * (NIN / 32), I_O = (DM / 64) * (DM / 32), I_1 = (DM / 64) * (DFF / 32), I_2 = (DFF / 64) * (DM / 32), NCONV = I_O + I_1 + I_2;
#define CONV_PULL(k) do { if (conv_lo[(k) + 1] > conv_lo[(k)]) { LAS float* scr_ = (LAS float*)(F.lds + RING_OFF + F.wave * 16384); const int lo_ = conv_lo[(k)], n_ = conv_lo[(k) + 1] - lo_; \
        for (;;) { __syncthreads();                                     \
            if (F.tid == 0) { unsigned t_ = __hip_atomic_load(F.ctl + CW_CONV + 64 * (k), RLX_AGENT); if ((int)t_ < n_) t_ = __hip_atomic_fetch_add(F.ctl + CW_CONV + 64 * (k), (unsigned)(8 * CV_PW), RLX_AGENT); F.MISC[16] = t_; } \
            __syncthreads(); const int b_ = (int)F.MISC[16]; if (b_ >= n_) break; \
            const int i0_ = b_ + F.wave * CV_PW, ne_ = (n_ - i0_) < CV_PW ? (n_ - i0_) : CV_PW;       \
            if (ne_ > 0) { f32x4 va_[8], vb_[8]; cv_load(cvm, lo_ + i0_, va_, F.lane); \
                for (int j_ = 0; j_ < ne_; j_ += 2) { if (j_ + 1 < ne_) cv_load(cvm, lo_ + i0_ + j_ + 1, vb_, F.lane); cv_finish(cvm, lo_ + i0_ + j_, va_, scr_, F.lane); \
                    if (j_ + 2 < ne_) cv_load(cvm, lo_ + i0_ + j_ + 2, va_, F.lane); if (j_ + 1 < ne_) cv_finish(cvm, lo_ + i0_ + j_ + 1, vb_, scr_, F.lane); } } } } } while (0)
    constexpr int conv_lo[5] = {0, CONV_C1, CONV_C2, CONV_C3, NCONV};
    const CvMats cvm{w_out, w1, w2, WoT, W1T, W2T, g2};

    if (IN(0)) { REPS(0) {
        LAS float* scr = (LAS float*)(F.lds + RING_OFF + F.wave * 16384);
        {
            f32x4 va[8], vb[8]; int it = gw;
            if (it < I_IN) tr_load(w_in, NIN, it, va, F.lane);
            for (; it < I_IN; it += 2 * NGW) { const int it2 = it + NGW, it3 = it + 2 * NGW;
                if (it2 < I_IN) tr_load(w_in, NIN, it2, vb, F.lane);
                tr_finish<true>(WinT, DM, NIN, it, va, scr, F.lane);
                if (it3 < I_IN) tr_load(w_in, NIN, it3, va, F.lane);
                if (it2 < I_IN) tr_finish<true>(WinT, DM, NIN, it2, vb, scr, F.lane); }
        }
        {
            const GAS f32x4* gr = (const GAS f32x4*)g1 + F.lane;
            f32x4 va[8], vb[8]; int m = gw;
#define XN_LOAD(V, mm) do { const GAS f32x4* xr_ = (const GAS f32x4*)(x + (size_t)(mm) * DM) + F.lane; _Pragma("unroll") for (int j = 0; j < 8; ++j) V[j] = __builtin_nontemporal_load(&xr_[64 * j]); } while (0)
#define XN_FIN(V, mm) do { float s_ = 0.f; _Pragma("unroll") for (int j = 0; j < 8; ++j) s_ += (V[j].x * V[j].x + V[j].y * V[j].y) + (V[j].z * V[j].z + V[j].w * V[j].w); \
            const float rstd_ = 1.f / sqrtf(wave_sum(s_) * (1.f / DM) + EPS); GAS unsigned long long* o8_ = (GAS unsigned long long*)(XN + (size_t)(mm) * DM) + F.lane; \
            _Pragma("unroll") for (int j = 0; j < 8; ++j) { const f32x4 g_ = gr[64 * j]; const f32x4 y_ = V[j] * rstd_ * g_; \
                o8_[64 * j] = (unsigned long long)pk2(y_.x, y_.y) | ((unsigned long long)pk2(y_.z, y_.w) << 32); } } while (0)
            if (m < M) XN_LOAD(va, m);
            for (; m < M; m += 2 * NGW) { const int m2 = m + NGW, m3 = m + 2 * NGW;
                if (m2 < M) XN_LOAD(vb, m2);
                XN_FIN(va, m);
                if (m3 < M) XN_LOAD(va, m3);
                if (m2 < M) XN_FIN(vb, m2); }
#undef XN_LOAD
#undef XN_FIN
        }
        for (int i = (F.vcu * NWAVES * 64) + F.tid; i < (SEQ + 1) * 64; i += F.G * NWAVES * 64) {
            const int pos = (i >> 6) == SEQ ? 16 : (i >> 6), p = i & 63;
            const float invf = __builtin_amdgcn_exp2f(-(float)p * 0.20762050593046014f);
            const double rev = (double)pos * (double)invf * 0.15915494309189535;
            const float fr = (float)(rev - __builtin_floor(rev));
            float* dst = ((i >> 6) == SEQ) ? (float*)(ws + WS_CSSTEP) + 2 * p : CS + 2 * i;
            dst[0] = __builtin_amdgcn_cosf(fr); dst[1] = __builtin_amdgcn_sinf(fr);
        }
        }
        for (int eb = 0; eb < PROBE_EXTRA_BARS; ++eb) GRID_BAR(0);
        if (BOTH(0)) GRID_BAR(0);
        TSTAMP(1);
    }

    if (IN(1)) { REPS(1) {
        const int GG = (F.G > 64) ? F.G - CONV_WGS : F.G;
        if ((int)blockIdx.x < GG) {
        pg8::Gemm g{XN, WinT, M, NIN, DM}; pg8::StaticOrder S; S.init(M, NIN, GG, (int)blockIdx.x);
        pg8::EpiProj E{PROJ, CS, (const float*)(ws + WS_CSSTEP), qg, kg, (LAS float*)(F.lds + XCH_OFF), -1};
        pg8::gemm_phase<pg8::EpiProj, pg8::StaticOrder, true, true>(F.lds + RING_OFF, g, S, E);
        }
        CONV_PULL(0);
        }
        if (BOTH(1)) GRID_BAR(1);
        TSTAMP(2);
    }

    if (IN(2)) { REPS(2) {
        for (int u = F.vcu; u < BATCH * NH * (NCH / 4); u += F.G)
            att::attn_unit(u >> 7, (u >> 4) & 7, u & 15, PROJ, relb, MIX, (char*)lds + RING_OFF);
#if NAIVE_CONTRIB
        for (int unit = F.vcu; unit < BATCH * NH * NCH; unit += F.G) {
            const int n = unit & 63, h = (unit >> 6) & 7, b = unit >> 9;
            const int dv = F.tid >> 2, dk0 = (F.tid & 3) * 32;
            const float lgh = LGSEL(h);
            float acc[32];
#pragma unroll
            for (int q = 0; q < 32; ++q) acc[q] = 0.f;
            const bf16* base = PROJ + (size_t)(b * SEQ + n * CH) * NIN + h * HD;
            for (int j = 0; j < CH; ++j) {
                const float kd = __builtin_amdgcn_exp2f(lgh * LOG2E * (float)(CH - 1 - j));
                const float vv = bf_lo((unsigned)base[(size_t)j * NIN + SEC_RV + dv]) * kd;
                const GAS v4u* kr = (const GAS v4u*)(base + (size_t)j * NIN + SEC_RK + dk0);
#pragma unroll
                for (int c = 0; c < 4; ++c) { const v4u k4 = kr[c];
                    acc[8 * c + 0] += vv * bf_lo(k4.x); acc[8 * c + 1] += vv * bf_hi(k4.x); acc[8 * c + 2] += vv * bf_lo(k4.y); acc[8 * c + 3] += vv * bf_hi(k4.y);
                    acc[8 * c + 4] += vv * bf_lo(k4.z); acc[8 * c + 5] += vv * bf_hi(k4.z); acc[8 * c + 6] += vv * bf_lo(k4.w); acc[8 * c + 7] += vv * bf_hi(k4.w); }
            }
            GAS v4u* o = (GAS v4u*)(CONTRIB + (size_t)unit * (HD * HD) + dv * HD + dk0);
#pragma unroll
            for (int c = 0; c < 4; ++c) { v4u w; w.x = pk2(acc[8 * c], acc[8 * c + 1]); w.y = pk2(acc[8 * c + 2], acc[8 * c + 3]); w.z = pk2(acc[8 * c + 4], acc[8 * c + 5]); w.w = pk2(acc[8 * c + 6], acc[8 * c + 7]); o[c] = w; }
        }
#else
        for (int u = F.vcu; u < BATCH * NH * (NCH / 4); u += F.G) {
            const int h = (u >> 4) & 7;
            att::contrib_unit(u >> 7, h, u & 15, PROJ, CONTRIB, (char*)lds + RING_OFF, LGSEL(h) * LOG2E);
        }
#endif
        CONV_PULL(1);
        }
        if (BOTH(2)) GRID_BAR(2);
        TSTAMP(3);
    }

    if (IN(3)) { REPS(3) {
        for (int e2 = F.vcu * (NWAVES * 64) + F.tid; e2 < BATCH * NH * HD * HD / 2; e2 += F.G * NWAVES * 64) {
            const int bh = e2 >> 13, idx2 = e2 & 8191, h = bh & 7;
            const float dec = __builtin_amdgcn_exp2f(LGSEL(h) * LOG2E * (float)CH);
            const GAS unsigned* cin = (const GAS unsigned*)CONTRIB + (size_t)bh * NCH * (HD * HD / 2) + idx2;
            GAS unsigned* pout = (GAS unsigned*)PREV + (size_t)bh * NCH * (HD * HD / 2) + idx2;
            float s0 = 0.f, s1 = 0.f;
#pragma unroll 1
            for (int nb = 0; nb < NCH; nb += 16) {
                unsigned c[16];
#pragma unroll
                for (int k = 0; k < 16; ++k) c[k] = cin[(size_t)(nb + k) * (HD * HD / 2)];
#pragma unroll
                for (int k = 0; k < 16; ++k) { pout[(size_t)(nb + k) * (HD * HD / 2)] = pk2(s0, s1); s0 = dec * s0 + bf_lo(c[k]); s1 = dec * s1 + bf_hi(c[k]); }
            }
        }
        CONV_PULL(2);
        }
        if (BOTH(3)) GRID_BAR(3);
        TSTAMP(4);
    }

    if (IN(4)) { REPS(4) {
#if NAIVE_RETOUT
        LAS float* sl = (LAS float*)(F.lds + RING_OFF + F.wave * 4096);
        LAS float* ql = sl + 64;
        for (int t0 = gw * 32; t0 < M * NH; t0 += NGW * 32) {
            for (int tt = 0; tt < 32; ++tt) {
                const int t = t0 + tt;
                const int i = t & 63, n = (t >> 6) & 63, h = (t >> 12) & 7, b = t >> 15;
                const int r = b * SEQ + n * CH + i; const int unit = (b * NH + h) * NCH + n;
                const float lgh = LGSEL(h) * LOG2E;
                unsigned qp[64];
                { const GAS v4u* qrow = (const GAS v4u*)(PROJ + (size_t)r * NIN + SEC_RQ + h * HD);
#pragma unroll
                  for (int c = 0; c < 16; ++c) { const v4u q4 = qrow[c]; qp[4 * c] = q4.x; qp[4 * c + 1] = q4.y; qp[4 * c + 2] = q4.z; qp[4 * c + 3] = q4.w; } }
                { const unsigned q2 = *((const GAS unsigned*)(PROJ + (size_t)r * NIN + SEC_RQ + h * HD) + F.lane); ql[2 * F.lane] = bf_lo(q2); ql[2 * F.lane + 1] = bf_hi(q2); }
                {
                    const GAS v4u* krow = (const GAS v4u*)(PROJ + (size_t)(b * SEQ + n * CH + F.lane) * NIN + SEC_RK + h * HD);
                    float s = 0.f;
#pragma unroll
                    for (int c = 0; c < 16; ++c) { const v4u k4 = krow[c];
                        s += bf_lo(k4.x) * bf_lo(qp[4 * c]) + bf_hi(k4.x) * bf_hi(qp[4 * c]);
                        s += bf_lo(k4.y) * bf_lo(qp[4 * c + 1]) + bf_hi(k4.y) * bf_hi(qp[4 * c + 1]);
                        s += bf_lo(k4.z) * bf_lo(qp[4 * c + 2]) + bf_hi(k4.z) * bf_hi(qp[4 * c + 2]);
                        s += bf_lo(k4.w) * bf_lo(qp[4 * c + 3]) + bf_hi(k4.w) * bf_hi(qp[4 * c + 3]); }
                    const int dist = i > F.lane ? i - F.lane : F.lane - i;
                    sl[F.lane] = s * __builtin_amdgcn_exp2f(lgh * (float)dist);
                }
                LDS_WAIT(); asm volatile("" ::: "memory");
                float y0 = 0.f, y1 = 0.f;
                { const GAS unsigned* vb = (const GAS unsigned*)(PROJ + (size_t)(b * SEQ + n * CH) * NIN + SEC_RV + h * HD) + F.lane;
#pragma unroll 8
                  for (int j = 0; j < CH; ++j) { const float s = sl[j]; const unsigned v2 = vb[(size_t)j * (NIN / 2)]; y0 += s * bf_lo(v2); y1 += s * bf_hi(v2); } }
                {
                    const float qdec = __builtin_amdgcn_exp2f(lgh * (float)(i + 1));
                    const GAS v4u* pa = (const GAS v4u*)(PREV + (size_t)unit * (HD * HD) + (2 * F.lane) * HD);
                    float c0 = 0.f, c1 = 0.f;
#pragma unroll 4
                    for (int c = 0; c < 16; ++c) { const v4u a4 = pa[c], b4 = pa[16 + c]; const LAS float* q8 = ql + 8 * c;
                        c0 += bf_lo(a4.x) * q8[0] + bf_hi(a4.x) * q8[1] + bf_lo(a4.y) * q8[2] + bf_hi(a4.y) * q8[3] + bf_lo(a4.z) * q8[4] + bf_hi(a4.z) * q8[5] + bf_lo(a4.w) * q8[6] + bf_hi(a4.w) * q8[7];
                        c1 += bf_lo(b4.x) * q8[0] + bf_hi(b4.x) * q8[1] + bf_lo(b4.y) * q8[2] + bf_hi(b4.y) * q8[3] + bf_lo(b4.z) * q8[4] + bf_hi(b4.z) * q8[5] + bf_lo(b4.w) * q8[6] + bf_hi(b4.w) * q8[7]; }
                    y0 += qdec * c0; y1 += qdec * c1;
                }
                const float mu = wave_sum(y0 + y1) * (1.f / HD);
                const float d0 = y0 - mu, d1 = y1 - mu;
                const float var = wave_sum(d0 * d0 + d1 * d1) * (1.f / HD);
                const float rs = 1.f / sqrtf(var + GN_EPS);
                const float ga = gn[h * HD + 2 * F.lane], gb = gn[h * HD + 2 * F.lane + 1];
                const unsigned sg = *((const GAS unsigned*)(PROJ + (size_t)r * NIN + SEC_RG + h * HD) + F.lane);
                *((GAS unsigned*)(MIX + (size_t)r * DM + h * HD) + F.lane) = pk2(d0 * rs * ga * bf_lo(sg), d1 * rs * gb * bf_hi(sg));
                LDS_WAIT(); asm volatile("" ::: "memory");
            }
        }
#else
        for (int u = F.vcu; u < BATCH * NH * (NCH / 4); u += F.G) {
            const int h = (u >> 4) & 7;
            att::retout_unit(u >> 7, h, u & 15, PROJ, PREV, gn, MIX, (char*)lds + RING_OFF, (float*)((char*)lds + XCH_OFF), LGSEL(h) * LOG2E);
        }
#endif
        CONV_PULL(3);
        }
        if (BOTH(4)) GRID_BAR(4);
        TSTAMP(5);
    }

    if (IN(5)) { REPS(5) {
        pg8::Gemm g{MIX, WoT, M, DM, DM}; pg8::StaticOrder S; S.init(M, DM, F.G, (int)blockIdx.x);
        pg8::EpiOut E{x, X1B, ROWSS, DM};
        pg8::gemm_phase<pg8::EpiOut, pg8::StaticOrder, true, true>(F.lds + RING_OFF, g, S, E);
        }
        if (BOTH(5)) GRID_BAR(5);
        TSTAMP(6);
    }

    if (IN(6)) { REPS(6) {
        pg8::Gemm g{X1B, W1T, M, DFF, DM}; pg8::StaticOrder S; S.init(M, DFF, F.G, (int)blockIdx.x);
        pg8::EpiRelu2 E{U, DFF};
        pg8::gemm_phase<pg8::EpiRelu2, pg8::StaticOrder, true, true>(F.lds + RING_OFF, g, S, E);
        }
        if (BOTH(6)) GRID_BAR(6);
        TSTAMP(7);
    }

    if (IN(7)) {
        pg8::Gemm g{U, W2T, M, DM, DFF}; pg8::StaticOrder S; S.init(M, DM, F.G, (int)blockIdx.x);
        LAS float* r2l = (LAS float*)(F.lds + XCH_OFF);
        pg8::Unit u0; u0.pm = -1; u0.pn = 0;
        { if (S.next(0, u0) && F.tid < 256) { const GAS f32x4* rs = (const GAS f32x4*)(ROWSS + (size_t)(u0.pm * 256 + F.tid) * 32); f32x4 s4 = rs[0];
#pragma unroll
            for (int j = 1; j < 8; ++j) s4 += rs[j];
            r2l[F.tid] = 1.0f / (((s4[0] + s4[1]) + (s4[2] + s4[3])) * (1.0f / DM) + EPS); }
          __syncthreads(); }
        pg8::EpiFinal E{out, r2l, DM, ROWSS, u0.pm, X1B};
        pg8::gemm_phase<pg8::EpiFinal, pg8::StaticOrder, true, true, true>(F.lds + RING_OFF, g, S, E);
    }
#if PROBE_T
    if (IN(7)) { GRID_BAR(7); TSTAMP(8);
        if (blockIdx.x == 0 && F.tid == 0) {
            const unsigned long long ta = ((unsigned long long)F.MISC[33 + 2 * PROBE_TA] << 32) | F.MISC[32 + 2 * PROBE_TA], tb = ((unsigned long long)F.MISC[33 + 2 * PROBE_TB] << 32) | F.MISC[32 + 2 * PROBE_TB];
#if PROBE_TTHR
            out[0] += ((double)(tb - ta) * 0.01 > (double)PROBE_TTHR) ? 64.f : 32.f;
#else
            out[0] += (float)(PROBE_TQ * (int)((double)(tb - ta) * 0.01 / PROBE_TQ)) - (float)PROBE_TOFF;
#endif
        } }
#endif
#if PROBE_X
    if (IN(8)) {
#if PROBE_X == 1
        pg8::Gemm g{U, W2T, M, DM, DFF}; pg8::StaticOrder S; S.init(M, DM, F.G, (int)blockIdx.x);
        pg8::EpiNull E{ROWSS};
        pg8::gemm_phase<pg8::EpiNull, pg8::StaticOrder, true, true, true>(F.lds + RING_OFF, g, S, E);
#elif PROBE_X == 2
        pg8::Gemm g{U, W2T, M, DM, DFF}; pg8::StaticOrderA0 S; S.init(M, DM, F.G, (int)blockIdx.x);
        pg8::EpiNull E{ROWSS};
        pg8::gemm_phase<pg8::EpiNull, pg8::StaticOrderA0, true, true, true>(F.lds + RING_OFF, g, S, E);
#elif PROBE_X == 3
        pg8::Gemm g{X1B, W1T, M, DFF, DM}; pg8::StaticOrder S; S.init(M, DFF, F.G, (int)blockIdx.x);
        pg8::EpiNull E{ROWSS};
        pg8::gemm_phase<pg8::EpiNull, pg8::StaticOrder, true, true>(F.lds + RING_OFF, g, S, E);
#elif PROBE_X == 5
        pg8::Gemm g{U, W2T, M, DM, DFF}; pg8::StaticOrder S; S.init(M, DM, F.G, (int)blockIdx.x);
        LAS float* r2l = (LAS float*)(F.lds + XCH_OFF); pg8::Unit u0; u0.pm = -1; u0.pn = 0; S.next(0, u0);
        if (F.tid < 256) r2l[F.tid] = 0.f;
        __syncthreads();
        pg8::EpiFinal E{out, r2l, DM, ROWSS, u0.pm, X1B};
        pg8::gemm_phase<pg8::EpiFinal, pg8::StaticOrder, true, true, true>(F.lds + RING_OFF, g, S, E);
#elif PROBE_X == 6
        pg8::Gemm g{X1B, W1T, M, DFF, DM}; pg8::StaticOrder S; S.init(M, DFF, F.G, (int)blockIdx.x);
        pg8::EpiNull E{ROWSS};
        pg8::gemm_phase<pg8::EpiNull, pg8::StaticOrder, true, true, true>(F.lds + RING_OFF, g, S, E);
#elif PROBE_X == 7
        for (int u = F.vcu; u < BATCH * NH * (NCH / 4); u += F.G) att::attn_unit(u >> 7, (u >> 4) & 7, u & 15, PROJ, relb, MIX, (char*)lds + RING_OFF);
#elif PROBE_X == 8
        for (int u = F.vcu; u < BATCH * NH * (NCH / 4); u += F.G) { const int h = (u >> 4) & 7; att::contrib_unit(u >> 7, h, u & 15, PROJ, CONTRIB, (char*)lds + RING_OFF, LGSEL(h) * LOG2E); }
#elif PROBE_X >= 20 && PROBE_X <= 22
        for (int u = F.vcu; u < BATCH * NH * (NCH / 4); u += F.G) { const int h = (u >> 4) & 7; att::retout_unit<PROBE_X - 20>(u >> 7, h, u & 15, PROJ, PREV, gn, CONTRIB, (char*)lds + RING_OFF, (float*)((char*)lds + XCH_OFF), LGSEL(h) * LOG2E); }
#elif PROBE_X == 9
        for (int u = F.vcu; u < BATCH * NH * (NCH / 4); u += F.G) { const int h = (u >> 4) & 7; att::retout_unit(u >> 7, h, u & 15, PROJ, PREV, gn, MIX, (char*)lds + RING_OFF, (float*)((char*)lds + XCH_OFF), LGSEL(h) * LOG2E); }
#elif PROBE_X == 10
        if ((int)blockIdx.x < F.G - CONV_WGS) { pg8::Gemm g{XN, WinT, M, NIN, DM}; pg8::StaticOrder S; S.init(M, NIN, F.G - CONV_WGS, (int)blockIdx.x);
            pg8::EpiNull E{ROWSS};
            pg8::gemm_phase<pg8::EpiNull, pg8::StaticOrder, true, true>(F.lds + RING_OFF, g, S, E); }
#elif PROBE_X >= 11 && PROBE_X <= 14
        if ((int)blockIdx.x < F.G - CONV_WGS) { pg8::Gemm g{XN, WinT, M, NIN, DM}; pg8::StaticOrder S; S.init(M, NIN, F.G - CONV_WGS, (int)blockIdx.x);
            pg8::EpiProj E{PROJ, CS, (const float*)(ws + WS_CSSTEP), qg, kg, (LAS float*)(F.lds + XCH_OFF), PROBE_X == 11 ? -1 : PROBE_X == 12 ? 2 : PROBE_X == 13 ? 0 : 4};
            pg8::gemm_phase<pg8::EpiProj, pg8::StaticOrder, true, true>(F.lds + RING_OFF, g, S, E); }
#elif PROBE_X == 4
        pg8::Gemm g{U, W2T, M, DM, DFF}; pg8::StaticOrder S; S.init(M, DM, F.G, (int)blockIdx.x);
        pg8::EpiNull E{ROWSS};
        pg8::gemm_phase<pg8::EpiNull, pg8::StaticOrder, true, false, true>(F.lds + RING_OFF, g, S, E);
#endif
    }
#endif
#undef IN
#undef BOTH
}

extern "C" void kernel_launch(void* const* d_in, const int* in_sizes, int n_in, void* d_out, int out_size, void* d_ws, size_t ws_size, hipStream_t stream) {
    static int grid = 0;
    if (grid == 0) {
        if (n_in != 11 || in_sizes[0] != M * DM || out_size != M * DM || ws_size < WS_END) { fprintf(stderr, "kernel_launch: shape/workspace mismatch: n_in %d in0 %d out %d ws %zu (need %zu)\n", n_in, n_in > 0 ? in_sizes[0] : -1, out_size, ws_size, (size_t)WS_END); grid = -1; return; }
        int dev = 0, cus = 0, per_cu = 0;
        if (hipGetDevice(&dev) != hipSuccess || hipDeviceGetAttribute(&cus, hipDeviceAttributeMultiprocessorCount, dev) != hipSuccess) { fprintf(stderr, "kernel_launch: device query failed\n"); grid = -1; return; }
        if (hipFuncSetAttribute((const void*)hymba_fwd, hipFuncAttributeMaxDynamicSharedMemorySize, LDS_BYTES) != hipSuccess) { fprintf(stderr, "kernel_launch: hipFuncSetAttribute failed\n"); grid = -1; return; }
        if (hipOccupancyMaxActiveBlocksPerMultiprocessor(&per_cu, (const void*)hymba_fwd, NWAVES * 64, LDS_BYTES) != hipSuccess || per_cu < 1)
            fprintf(stderr, "kernel_launch: note: occupancy query reports %d workgroups per CU\n", per_cu);
        (void)hipGetLastError();
        grid = cus;
    }
    if (grid < 0) return;
    if (hipMemsetAsync((char*)d_ws + WS_CTL, 0, CTL_ZERO_BYTES, stream) != hipSuccess) { fprintf(stderr, "kernel_launch: hipMemsetAsync failed\n"); return; }
    Args a{};
    for (int i = 0; i < 11; ++i) a.in[i] = (const float*)d_in[i];
    a.out = (float*)d_out; a.ws = (unsigned char*)d_ws;
    for (int h = 0; h < 8; ++h) a.lg[h] = (float)log1p(-exp2(-(5.0 + (double)h)));
    for (int li = 0; li < N_LAUNCHES; ++li) {
        a.ph_lo = (N_LAUNCHES == PER_PHASE) ? li : 0; a.ph_hi = (N_LAUNCHES == PER_PHASE) ? li + 1 : PER_PHASE; a.li = li;
        const int nrep = (N_LAUNCHES == PER_PHASE && ((PROBE_REPEAT_MASK >> li) & 1)) ? 2 : 1;
        for (int rep = 0; rep < nrep; ++rep) hipLaunchKernelGGL(hymba_fwd, dim3(grid), dim3(NWAVES * 64), LDS_BYTES, stream, a);
#if PROBE_X
        if (N_LAUNCHES == PER_PHASE && li == ((PROBE_X == 5 || (PROBE_X >= 11 && PROBE_X <= 14)) ? 7 : (PROBE_X == 7 || PROBE_X == 8) ? 2 : (PROBE_X == 9 || (PROBE_X >= 20 && PROBE_X <= 22)) ? 4 : PROBE_X == 10 ? 1 : 6)) { Args ax = a; ax.ph_lo = 8; ax.ph_hi = 9; for (int rep = 0; rep < PROBE_XN; ++rep) hipLaunchKernelGGL(hymba_fwd, dim3(grid), dim3(NWAVES * 64), LDS_BYTES, stream, ax); }
#endif
        const hipError_t le = hipPeekAtLastError();
        if (le != hipSuccess) { fprintf(stderr, "kernel_launch: launch %d failed: %s\n", li, hipGetErrorName(le)); break; }
    }
}
```

```cpp
#include <hip/hip_runtime.h>
#include <cstdio>
#include <cstdint>
#include <cmath>
namespace pg8 {
#define PG8_LAS __attribute__((address_space(3)))
typedef unsigned short bf16_t;
typedef short bf16x8 __attribute__((ext_vector_type(8)));
typedef float f32x4 __attribute__((ext_vector_type(4)));
typedef unsigned u32x4 __attribute__((ext_vector_type(4)));
constexpr int BM = 256, BK = 64, HALF = 128, HTB = HALF * BK * 2  , STAGE_BYTES = 8 * HTB, NXCD = 8, WGM = 8;

__host__ __device__ __forceinline__ int lds_byte(int r, int c) { const int st = (r >> 4) * 2 + (c >> 5), rr = r & 15, cc = c & 31, ob = rr * 64 + cc * 2; return st * 1024 + (ob ^ (((ob >> 9) & 1) << 5)); }
__host__ __device__ __forceinline__ void stage_rc(int b, int& R, int& C) { const int st = b / 1024, sb = b % 1024, swz = sb ^ (((sb >> 9) & 1) << 5); R = (st >> 1) * 16 + swz / 64; C = (st & 1) * 32 + (swz % 64) / 2; }
__host__ __device__ __forceinline__ int perm32(int rho) { const int n = rho >> 4, i = rho & 15; return 8 * (i >> 2) + 4 * n + (i & 3); }

struct Unit { int pm, pn; };
struct Gemm { const bf16_t* A; const bf16_t* Bt; int M, N, K; };

struct StaticOrder {
    int nM, nN, nwg, G, c, wgm;
    __host__ __device__ void init(int M, int N, int G_, int c_, int wgm_ = WGM) { nM = M / BM; nN = N / BM; nwg = nM * nN; G = G_; c = c_; wgm = wgm_; }
    __host__ __device__ bool next(int i, Unit& u) const {
        const long L = (long)i * G + c; if (L >= nwg) return false;
        int wgid = (int)L; { const int q = nwg / NXCD, r = nwg % NXCD, xcd = wgid % NXCD, off = wgid / NXCD; wgid = (xcd < r ? xcd * (q + 1) : r * (q + 1) + (xcd - r) * q) + off; }
        const int nig = wgm * nN, gid = wgid / nig, fm = gid * wgm, gsz = (nM - fm) < wgm ? (nM - fm) : wgm;
        u.pm = fm + ((wgid % nig) % gsz); u.pn = (wgid % nig) / gsz; return true;
    }
    __device__ __forceinline__ void a_ready(const Unit&) const {}
    __device__ __forceinline__ void done(const Unit&) const {}
};

typedef float f32x2c_t __attribute__((ext_vector_type(2))); typedef __bf16 bf16x2c_t __attribute__((ext_vector_type(2)));
__device__ __forceinline__ unsigned cvt_pk_bf16(float lo, float hi) { f32x2c_t v = {lo, hi}; bf16x2c_t b = __builtin_convertvector(v, bf16x2c_t); return __builtin_bit_cast(unsigned, b); }
typedef float f32x2 __attribute__((ext_vector_type(2)));
typedef unsigned u32x2 __attribute__((ext_vector_type(2)));
constexpr int PROJ_LD = 7168;
struct EpiProj {
    static constexpr bool PERM = true, AFTER_DRAIN = false, WIDE = true;
    bf16_t* P; const float* cs; const float* csstep; const float* qg; const float* kg; PG8_LAS float* xch; int force_sec;
    __device__ __forceinline__ void operator()(const f32x4 (&acc)[2][2][4][2], const Unit& u, int wr, int wc, int fr, int fq) const {
        const int sec = force_sec >= 0 ? force_sec : (u.pn >> 2);
        const int row0 = u.pm * BM + wr * 64 + fr;
        const int tc0 = wc * 64 + 8 * fq, ch0 = tc0 & 127;
        bf16_t* base = P + (size_t)row0 * PROJ_LD + u.pn * BM;
        if (sec <= 1) {
            const float ksc = (sec == 1) ? 0.08838834764831845f : 1.0f;
            const int p0 = ch0 >> 1;
            f32x4 cb_[2][2][2], st_[2][2];
#pragma unroll
            for (int bj = 0; bj < 2; ++bj) { const float* sp = csstep + (p0 + 16 * bj) * 2; st_[bj][0] = *(const f32x4*)sp; st_[bj][1] = *(const f32x4*)(sp + 4);
#pragma unroll
                for (int ai = 0; ai < 2; ++ai) { const int pos = (row0 + ai * HALF) & 4095; const float* cp = cs + ((size_t)pos * 64 + p0 + 16 * bj) * 2;
                    cb_[ai][bj][0] = *(const f32x4*)cp; cb_[ai][bj][1] = *(const f32x4*)(cp + 4); } }
            asm volatile("" ::: "memory");
#pragma unroll
            for (int ai = 0; ai < 2; ++ai)
#pragma unroll
                for (int m = 0; m < 4; ++m) {
                    bf16_t* rp = base + (size_t)(ai * HALF + m * 16) * PROJ_LD + tc0;
#pragma unroll
                    for (int bj = 0; bj < 2; ++bj) {
                        const f32x4 ca = cb_[ai][bj][0], cb = cb_[ai][bj][1];
                        const f32x4 v0 = acc[ai][bj][m][0] * ksc, v1 = acc[ai][bj][m][1] * ksc;
                        const float a0 = v0[0] * ca[0] - v0[1] * ca[1], b0 = v0[0] * ca[1] + v0[1] * ca[0];
                        const float a1 = v0[2] * ca[2] - v0[3] * ca[3], b1 = v0[2] * ca[3] + v0[3] * ca[2];
                        const float a2 = v1[0] * cb[0] - v1[1] * cb[1], b2 = v1[0] * cb[1] + v1[1] * cb[0];
                        const float a3 = v1[2] * cb[2] - v1[3] * cb[3], b3 = v1[2] * cb[3] + v1[3] * cb[2];
                        u32x4 w; w.x = cvt_pk_bf16(a0, b0); w.y = cvt_pk_bf16(a1, b1); w.z = cvt_pk_bf16(a2, b2); w.w = cvt_pk_bf16(a3, b3);
                        *(u32x4*)(rp + 32 * bj) = w;
                        if (m < 3) {
#pragma unroll
                            for (int q = 0; q < 2; ++q) { const f32x4 c = cb_[ai][bj][q], t = st_[bj][q];
                                cb_[ai][bj][q] = (f32x4){c[0] * t[0] - c[1] * t[1], c[1] * t[0] + c[0] * t[1], c[2] * t[2] - c[3] * t[3], c[3] * t[2] + c[2] * t[3]}; }
                        }
                    }
                }
        } else if (sec == 4 || sec == 5) {
            const float* g = (sec == 4) ? qg : kg;
            const float osc = (sec == 4) ? (0.08838834764831845f * 1.4426950408889634f) : 1.0f;
            f32x4 gv[2][2];
#pragma unroll
            for (int bj = 0; bj < 2; ++bj) { gv[bj][0] = *(const f32x4*)(g + ch0 + 32 * bj) * osc; gv[bj][1] = *(const f32x4*)(g + ch0 + 32 * bj + 4) * osc; }
#pragma unroll
            for (int ai = 0; ai < 2; ++ai)
#pragma unroll
                for (int m = 0; m < 4; ++m) {
                    float s = 0.f;
#pragma unroll
                    for (int bj = 0; bj < 2; ++bj) { const f32x4 v0 = acc[ai][bj][m][0], v1 = acc[ai][bj][m][1];
                        s += (v0[0] * v0[0] + v0[1] * v0[1]) + (v0[2] * v0[2] + v0[3] * v0[3]) + (v1[0] * v1[0] + v1[1] * v1[1]) + (v1[2] * v1[2] + v1[3] * v1[3]); }
                    s += __shfl_xor(s, 16); s += __shfl_xor(s, 32);
                    if (fq == 0) xch[(ai * HALF + wr * 64 + m * 16 + fr) * 4 + wc] = s;
                }
            asm volatile("s_waitcnt lgkmcnt(0)" ::: "memory"); __builtin_amdgcn_s_barrier(); asm volatile("" ::: "memory");
#pragma unroll
            for (int ai = 0; ai < 2; ++ai)
#pragma unroll
                for (int m = 0; m < 4; ++m) {
                    bf16_t* rp = base + (size_t)(ai * HALF + m * 16) * PROJ_LD + tc0;
                    const PG8_LAS float* xp = xch + (ai * HALF + wr * 64 + m * 16 + fr) * 4 + (wc & 2);
                    const float rstd = 1.0f / sqrtf((xp[0] + xp[1]) * (1.0f / 128.0f) + 1e-6f);
#pragma unroll
                    for (int bj = 0; bj < 2; ++bj) {
                        const f32x4 v0 = acc[ai][bj][m][0] * rstd * gv[bj][0], v1 = acc[ai][bj][m][1] * rstd * gv[bj][1];
                        u32x4 w; w.x = cvt_pk_bf16(v0[0], v0[1]); w.y = cvt_pk_bf16(v0[2], v0[3]); w.z = cvt_pk_bf16(v1[0], v1[1]); w.w = cvt_pk_bf16(v1[2], v1[3]);
                        *(u32x4*)(rp + 32 * bj) = w;
                    }
                }
        } else {
#pragma unroll
            for (int ai = 0; ai < 2; ++ai)
#pragma unroll
                for (int m = 0; m < 4; ++m) {
                    bf16_t* rp = base + (size_t)(ai * HALF + m * 16) * PROJ_LD + tc0;
#pragma unroll
                    for (int bj = 0; bj < 2; ++bj) {
                        f32x4 v0 = acc[ai][bj][m][0], v1 = acc[ai][bj][m][1];
                        if (sec == 3) {
#pragma unroll
                            for (int j = 0; j < 4; ++j) { v0[j] = v0[j] * __builtin_amdgcn_rcpf(1.0f + __builtin_amdgcn_exp2f(-1.4426950408889634f * v0[j]));
                                                          v1[j] = v1[j] * __builtin_amdgcn_rcpf(1.0f + __builtin_amdgcn_exp2f(-1.4426950408889634f * v1[j])); }
                        }
                        u32x4 w; w.x = cvt_pk_bf16(v0[0], v0[1]); w.y = cvt_pk_bf16(v0[2], v0[3]); w.z = cvt_pk_bf16(v1[0], v1[1]); w.w = cvt_pk_bf16(v1[2], v1[3]);
                        *(u32x4*)(rp + 32 * bj) = w;
                    }
                }
        }
    }
};
struct EpiOut {
    static constexpr bool PERM = true, AFTER_DRAIN = false, WIDE = true;
    const float* x; bf16_t* X1B; float* rowss; int ldc;
    __device__ __forceinline__ void operator()(const f32x4 (&acc)[2][2][4][2], const Unit& u, int wr, int wc, int fr, int fq) const {
        const int row0 = u.pm * BM + wr * 64 + fr, col0 = u.pn * BM + wc * 64 + 8 * fq;
#pragma unroll
        for (int ai = 0; ai < 2; ++ai) {
            f32x4 xv[4][2][2];
#pragma unroll
            for (int m = 0; m < 4; ++m)
#pragma unroll
                for (int bj = 0; bj < 2; ++bj) { const size_t off = (size_t)(row0 + ai * HALF + m * 16) * ldc + col0 + bj * 32;
                    xv[m][bj][0] = __builtin_nontemporal_load((const f32x4*)(x + off)); xv[m][bj][1] = __builtin_nontemporal_load((const f32x4*)(x + off + 4)); }
            asm volatile("" ::: "memory");
#pragma unroll
            for (int m = 0; m < 4; ++m) {
                const int r = row0 + ai * HALF + m * 16; float ss = 0.f;
#pragma unroll
                for (int bj = 0; bj < 2; ++bj) {
                    const size_t off = (size_t)r * ldc + col0 + bj * 32;
                    const f32x4 y0 = xv[m][bj][0] + acc[ai][bj][m][0], y1 = xv[m][bj][1] + acc[ai][bj][m][1];
                    u32x4 w1; w1.x = cvt_pk_bf16(y0[0], y0[1]); w1.y = cvt_pk_bf16(y0[2], y0[3]); w1.z = cvt_pk_bf16(y1[0], y1[1]); w1.w = cvt_pk_bf16(y1[2], y1[3]); *(u32x4*)(X1B + off) = w1;
                    ss += (y0[0] * y0[0] + y0[1] * y0[1]) + (y0[2] * y0[2] + y0[3] * y0[3]) + (y1[0] * y1[0] + y1[1] * y1[1]) + (y1[2] * y1[2] + y1[3] * y1[3]);
                }
                ss += __shfl_xor(ss, 16); ss += __shfl_xor(ss, 32);
                if (fq == 0) rowss[(size_t)r * 32 + u.pn * 4 + wc] = ss;
            }
            asm volatile("" ::: "memory");
        }
    }
};
struct EpiRelu2 {
    static constexpr bool PERM = true, AFTER_DRAIN = false, WIDE = true;
    bf16_t* O; int ldc;
    __device__ __forceinline__ void operator()(const f32x4 (&acc)[2][2][4][2], const Unit& u, int wr, int wc, int fr, int fq) const {
        char* tb = (char*)O + ((size_t)u.pm * (ldc / 64) + u.pn * 4 + wc) * 32768 + (wr * 64 + fr) * 128 + (8 * fq) * 2;
#pragma unroll
        for (int ai = 0; ai < 2; ++ai)
#pragma unroll
            for (int m = 0; m < 4; ++m) {
#pragma unroll
                for (int bj = 0; bj < 2; ++bj) {
                    f32x4 v0 = acc[ai][bj][m][0], v1 = acc[ai][bj][m][1];
#pragma unroll
                    for (int j = 0; j < 4; ++j) { const float a = fmaxf(v0[j], 0.f), b = fmaxf(v1[j], 0.f); v0[j] = a * a; v1[j] = b * b; }
                    u32x4 w; w.x = cvt_pk_bf16(v0[0], v0[1]); w.y = cvt_pk_bf16(v0[2], v0[3]); w.z = cvt_pk_bf16(v1[0], v1[1]); w.w = cvt_pk_bf16(v1[2], v1[3]);
                    *(u32x4*)(tb + bj * 64 + (ai * HALF + m * 16) * 128) = w;
                }
            }
    }
};
struct EpiFinal {
    static constexpr bool PERM = true, AFTER_DRAIN = false, WIDE = true;
    float* out; const PG8_LAS float* r2l; int ldc; const float* rowss; int pm0; const bf16_t* X1B;
    __device__ __forceinline__ void operator()(const f32x4 (&acc)[2][2][4][2], const Unit& u, int wr, int wc, int fr, int fq) const {
        const int rl0 = wr * 64 + fr, col0 = u.pn * BM + wc * 64 + 8 * fq;
        const size_t boff = (size_t)(u.pm * BM + rl0) * ldc + col0;
#pragma unroll
        for (int ai = 0; ai < 2; ++ai) {
            u32x4 xv[4][2]; float r2[4];
#pragma unroll
            for (int m = 0; m < 4; ++m) {
                if (u.pm == pm0) r2[m] = r2l[rl0 + ai * HALF + m * 16];
                else { const f32x4* rs = (const f32x4*)(rowss + (size_t)(u.pm * BM + rl0 + ai * HALF + m * 16) * 32); f32x4 s4 = rs[0];
#pragma unroll
                    for (int j = 1; j < 8; ++j) s4 += rs[j];
                    r2[m] = 1.0f / (((s4[0] + s4[1]) + (s4[2] + s4[3])) * (1.0f / 2048.0f) + 1e-6f); }
#pragma unroll
                for (int bj = 0; bj < 2; ++bj) xv[m][bj] = *(const u32x4*)(X1B + boff + (size_t)(ai * HALF + m * 16) * ldc + bj * 32); }
            asm volatile("" ::: "memory");
#pragma unroll
            for (int m = 0; m < 4; ++m)
#pragma unroll
                for (int bj = 0; bj < 2; ++bj) { const u32x4 w = xv[m][bj]; float* p = out + boff + (size_t)(ai * HALF + m * 16) * ldc + bj * 32;
                    const f32x4 x0 = {__uint_as_float(w.x << 16), __uint_as_float(w.x & 0xffff0000u), __uint_as_float(w.y << 16), __uint_as_float(w.y & 0xffff0000u)};
                    const f32x4 x1 = {__uint_as_float(w.z << 16), __uint_as_float(w.z & 0xffff0000u), __uint_as_float(w.w << 16), __uint_as_float(w.w & 0xffff0000u)};
                    *(f32x4*)p = x0 + acc[ai][bj][m][0] * r2[m]; *(f32x4*)(p + 4) = x1 + acc[ai][bj][m][1] * r2[m]; }
            asm volatile("" ::: "memory");
        }
    }
};
struct EpiNull {
    static constexpr bool PERM = false, AFTER_DRAIN = false, WIDE = false;
    float* sink;
    __device__ __forceinline__ void operator()(const f32x4 (&acc)[2][2][4][2], const Unit& u, int wr, int wc, int fr, int fq) const {
        float s = 0.f;
#pragma unroll
        for (int ai = 0; ai < 2; ++ai)
#pragma unroll
            for (int bj = 0; bj < 2; ++bj)
#pragma unroll
                for (int m = 0; m < 4; ++m)
#pragma unroll
                    for (int n = 0; n < 2; ++n) s += (acc[ai][bj][m][n][0] + acc[ai][bj][m][n][1]) + (acc[ai][bj][m][n][2] + acc[ai][bj][m][n][3]);
        if (s == 123456.789f) sink[u.pm * 8 + u.pn] = s;
    }
};
struct StaticOrderA0 : StaticOrder {
    __host__ __device__ bool next(int i, Unit& u) const { const bool r = StaticOrder::next(i, u); u.pm = 0; return r; }
};
template <class Epi, class Sched, bool ALIGN_EPI = false, bool SP2 = false, bool BLK = false>
__device__ __forceinline__ void gemm_phase(PG8_LAS unsigned char* lds, const Gemm g, const Sched& S, const Epi& E) {
    const int tid = threadIdx.x, wid = __builtin_amdgcn_readfirstlane(tid >> 6), lane = tid & 63, wr = wid >> 2, wc = wid & 3, fr = lane & 15, fq = lane >> 4;
    const int K = g.K, nt = K / BK;
    constexpr bool WIDE = Epi::PERM && Epi::WIDE;
    unsigned voffA[2], voffB[2];
#pragma unroll
    for (int i = 0; i < 2; ++i) { int R, C; stage_rc(tid * 16 + i * 8192, R, C); const int Rb = Epi::PERM ? ((WIDE ? 64 * (R >> 5) : (R & ~31)) + perm32(R & 31)) : R;
        voffA[i] = BLK ? (unsigned)(R * 128 + C * 2) : (unsigned)(R * K + C) * 2u; voffB[i] = BLK ? (unsigned)(Rb * 128 + C * 2) : (unsigned)(Rb * K + C) * 2u; }
    const size_t kstep = BLK ? (size_t)32768 : (size_t)(BK * 2);
    const size_t hstep = BLK ? (size_t)(HALF * 128) : (size_t)HALF * K * 2;
    const size_t hstepB = WIDE ? hstep / 4 : hstep;
    const size_t tstep = BLK ? (size_t)(K / BK) * 32768 : 2 * hstep;
    const unsigned ldsw = (unsigned)wid * 1024u;
    const int aoff = lds_byte(wr * 64 + fr, fq * 8), boff = lds_byte(wc * 32 + fr, fq * 8);
#define PG8_SA(b, h) (((b) * 2 + (h)) * HTB)
#define PG8_SB(b, h) ((4 + (b) * 2 + (h)) * HTB)
#define PG8_STAGE(bufoff, gbase, voff) do { _Pragma("unroll") for (int _i = 0; _i < 2; ++_i) \
        __builtin_amdgcn_global_load_lds((const unsigned*)((const char*)(gbase) + (voff)[_i]), (PG8_LAS unsigned*)(lds + (bufoff) + ldsw + _i * 8192), 16, 0, 0); } while (0)
#define PG8_LDA(dst, b, h) do { _Pragma("unroll") for (int m = 0; m < 4; ++m) _Pragma("unroll") for (int k = 0; k < 2; ++k) dst[m][k] = *(const PG8_LAS bf16x8*)(lds + PG8_SA(b, h) + aoff + m * 2048 + k * 1024); } while (0)
#define PG8_LDB(dst, b, h) do { _Pragma("unroll") for (int n = 0; n < 2; ++n) _Pragma("unroll") for (int k = 0; k < 2; ++k) dst[n][k] = *(const PG8_LAS bf16x8*)(lds + PG8_SB(b, h) + boff + n * 2048 + k * 1024); } while (0)
#define PG8_MMA(ai, bj, At, Bt) do { __builtin_amdgcn_s_setprio(1); _Pragma("unroll") for (int m = 0; m < 4; ++m) _Pragma("unroll") for (int n = 0; n < 2; ++n) _Pragma("unroll") for (int k = 0; k < 2; ++k) \
        acc[ai][bj][m][n] = __builtin_amdgcn_mfma_f32_16x16x32_bf16(Bt[n][k], At[m][k], acc[ai][bj][m][n], 0, 0, 0); __builtin_amdgcn_s_setprio(0); } while (0)
#define PG8_WAIT_V(n) asm volatile("s_waitcnt vmcnt(" #n ")" ::: "memory")
#define PG8_WAIT_L(n) asm volatile("s_waitcnt lgkmcnt(" #n ")" ::: "memory")
#define PG8_BAR __builtin_amdgcn_s_barrier()
#define PG8_SCHED __builtin_amdgcn_sched_barrier(0)
    Unit cur, nxt; int ui = 0;
    if (!S.next(0, cur)) return;
    f32x4 acc[2][2][4][2];
#pragma unroll
    for (int a = 0; a < 2; ++a)
#pragma unroll
        for (int b = 0; b < 2; ++b)
#pragma unroll
            for (int m = 0; m < 4; ++m)
#pragma unroll
                for (int n = 0; n < 2; ++n) acc[a][b][m][n] = (f32x4){0.f, 0.f, 0.f, 0.f};
    bf16x8 At[4][2], B0[2][2], B1[2][2];
    const char* cA = (const char*)g.A + (size_t)cur.pm * tstep; const char* cB = (const char*)g.Bt + (size_t)cur.pn * tstep;
    S.a_ready(cur);
    if constexpr (SP2) {
        PG8_STAGE(PG8_SB(0, 0), cB, voffB); PG8_STAGE(PG8_SB(0, 1), cB + hstepB, voffB); PG8_STAGE(PG8_SA(0, 0), cA, voffA); PG8_STAGE(PG8_SA(0, 1), cA + hstep, voffA);
        if (wr == 1) PG8_BAR;
        PG8_WAIT_V(2); PG8_BAR;
        PG8_STAGE(PG8_SB(1, 0), cB + kstep, voffB); PG8_STAGE(PG8_SA(1, 0), cA + kstep, voffA); PG8_STAGE(PG8_SB(1, 1), cB + hstepB + kstep, voffB);
        PG8_WAIT_V(6); PG8_BAR;
    } else {
        PG8_STAGE(PG8_SB(0, 0), cB, voffB); PG8_STAGE(PG8_SA(0, 0), cA, voffA); PG8_STAGE(PG8_SB(0, 1), cB + hstepB, voffB); PG8_STAGE(PG8_SA(0, 1), cA + hstep, voffA);
        if (wr == 1) PG8_BAR;
        PG8_WAIT_V(4); PG8_BAR;
        PG8_STAGE(PG8_SB(1, 0), cB + kstep, voffB); PG8_STAGE(PG8_SA(1, 0), cA + kstep, voffA); PG8_STAGE(PG8_SB(1, 1), cB + hstepB + kstep, voffB);
        PG8_WAIT_V(6); PG8_BAR;
    }
    for (;;) {
        const bool has_next = S.next(ui + 1, nxt);
        const char* nA = has_next ? (const char*)g.A + (size_t)nxt.pm * tstep : cA; const char* nB = has_next ? (const char*)g.Bt + (size_t)nxt.pn * tstep : cB;
        for (int t = 0; t < nt; t += 2) {
            const bool last = (t == nt - 2);
            const char* a1 = cA + (size_t)(t + 1) * kstep;
            const char* a2 = last ? nA : cA + (size_t)(t + 2) * kstep; const char* b2 = last ? nB : cB + (size_t)(t + 2) * kstep;
            const char* a3 = a2 + kstep; const char* b3 = b2 + kstep;
            if (last && has_next) S.a_ready(nxt);
            if constexpr (SP2) {
            PG8_LDB(B0, 0, 0); PG8_LDB(B1, 0, 1); PG8_SCHED; PG8_LDA(At, 0, 0); PG8_STAGE(PG8_SA(1, 1), a1 + hstep, voffA);
            PG8_WAIT_V(8); PG8_WAIT_L(0); PG8_BAR; PG8_MMA(0, 0, At, B0); PG8_MMA(0, 1, At, B1); PG8_BAR; PG8_SCHED;
            PG8_LDA(At, 0, 1); PG8_STAGE(PG8_SB(0, 0), b2, voffB); PG8_STAGE(PG8_SB(0, 1), b2 + hstepB, voffB); PG8_STAGE(PG8_SA(0, 0), a2, voffA);
            PG8_WAIT_V(8); PG8_WAIT_L(0); PG8_BAR; PG8_MMA(1, 0, At, B0); PG8_MMA(1, 1, At, B1); PG8_BAR; PG8_SCHED;
            PG8_LDB(B0, 1, 0); PG8_LDB(B1, 1, 1); PG8_SCHED; PG8_LDA(At, 1, 0); PG8_STAGE(PG8_SA(0, 1), a2 + hstep, voffA);
            PG8_WAIT_V(8); PG8_WAIT_L(0); PG8_BAR; PG8_MMA(0, 0, At, B0); PG8_MMA(0, 1, At, B1); PG8_BAR; PG8_SCHED;
            PG8_LDA(At, 1, 1); PG8_STAGE(PG8_SB(1, 0), b3, voffB); PG8_STAGE(PG8_SB(1, 1), b3 + hstepB, voffB); PG8_STAGE(PG8_SA(1, 0), a3, voffA);
            PG8_WAIT_V(8); PG8_WAIT_L(0); PG8_BAR; PG8_MMA(1, 0, At, B0); PG8_MMA(1, 1, At, B1); PG8_BAR; PG8_SCHED;
            } else {
            PG8_LDB(B0, 0, 0); PG8_SCHED; PG8_LDA(At, 0, 0); PG8_STAGE(PG8_SA(1, 1), a1 + hstep, voffA);
            PG8_WAIT_L(8); PG8_BAR; PG8_WAIT_L(0); PG8_MMA(0, 0, At, B0); PG8_BAR; PG8_SCHED;
            PG8_LDB(B1, 0, 1); PG8_STAGE(PG8_SB(0, 0), b2, voffB);
            PG8_BAR; PG8_WAIT_L(0); PG8_MMA(0, 1, At, B1); PG8_BAR;
            PG8_LDA(At, 0, 1); PG8_STAGE(PG8_SA(0, 0), a2, voffA);
            PG8_BAR; PG8_WAIT_L(0); PG8_MMA(1, 0, At, B0); PG8_BAR; PG8_SCHED;
            PG8_STAGE(PG8_SB(0, 1), b2 + hstepB, voffB);
            PG8_WAIT_V(6); PG8_BAR; PG8_MMA(1, 1, At, B1); PG8_BAR;
            PG8_LDB(B0, 1, 0); PG8_SCHED; PG8_LDA(At, 1, 0); PG8_STAGE(PG8_SA(0, 1), a2 + hstep, voffA);
            PG8_WAIT_L(8); PG8_BAR; PG8_WAIT_L(0); PG8_MMA(0, 0, At, B0); PG8_BAR; PG8_SCHED;
            PG8_LDB(B1, 1, 1); PG8_STAGE(PG8_SB(1, 0), b3, voffB);
            PG8_BAR; PG8_WAIT_L(0); PG8_MMA(0, 1, At, B1); PG8_BAR;
            PG8_LDA(At, 1, 1); PG8_STAGE(PG8_SA(1, 0), a3, voffA);
            PG8_BAR; PG8_WAIT_L(0); PG8_MMA(1, 0, At, B0); PG8_BAR; PG8_SCHED;
            PG8_STAGE(PG8_SB(1, 1), b3 + hstepB, voffB);
            PG8_WAIT_V(6); PG8_BAR; PG8_MMA(1, 1, At, B1); PG8_BAR;
            }
        }
        if constexpr (ALIGN_EPI) { if (wr == 0) PG8_BAR; }
        if constexpr (!Epi::AFTER_DRAIN) { E(acc, cur, wr, wc, fr, fq); S.done(cur); }
        if (!has_next) break;
#pragma unroll
        for (int a = 0; a < 2; ++a)
#pragma unroll
            for (int b = 0; b < 2; ++b)
#pragma unroll
                for (int m = 0; m < 4; ++m)
#pragma unroll
                    for (int n = 0; n < 2; ++n) acc[a][b][m][n] = (f32x4){0.f, 0.f, 0.f, 0.f};
        cur = nxt; cA = nA; cB = nB; ++ui;
        if constexpr (ALIGN_EPI) { if (wr == 1) PG8_BAR; }
    }
    PG8_WAIT_V(0);
    if constexpr (!ALIGN_EPI) { if (wr == 0) PG8_BAR; }
    PG8_BAR;
    if constexpr (Epi::AFTER_DRAIN) { E.fused(acc, cur, wr, wc, fr, fq, lds, wid, lane); S.done(cur); }
#undef PG8_SA
#undef PG8_SB
#undef PG8_STAGE
#undef PG8_LDA
#undef PG8_LDB
#undef PG8_MMA
#undef PG8_WAIT_V
#undef PG8_WAIT_L
#undef PG8_BAR
#undef PG8_SCHED
}
}
#define GAS __attribute__((address_space(1)))
#define LAS __attribute__((address_space(3)))
typedef unsigned short bf16;
typedef unsigned v4u __attribute__((ext_vector_type(4)));
typedef float f32x4 __attribute__((ext_vector_type(4)));
typedef short bf16x8 __attribute__((ext_vector_type(8)));
typedef GAS unsigned gu32;
typedef GAS unsigned long long gu64;
#define RLX_AGENT __ATOMIC_RELAXED, __HIP_MEMORY_SCOPE_AGENT
#define LDS_WAIT() asm volatile("s_waitcnt lgkmcnt(0)" ::: "memory")
#define VM_WAIT() asm volatile("s_waitcnt vmcnt(0)" ::: "memory")
__device__ __forceinline__ unsigned long long rt() { return __builtin_amdgcn_s_memrealtime(); }
__device__ __forceinline__ unsigned f2bf(float f) { unsigned u = __builtin_bit_cast(unsigned, f); return (u + 0x7fffu + ((u >> 16) & 1u)) >> 16; }
__device__ __forceinline__ unsigned pk2(float lo, float hi) { return f2bf(lo) | (f2bf(hi) << 16); }

#define XB_TMO      128
#define XB_XCNT(j)  (256  + 64 * (j))
#define XB_XSUB(j)  (1280 + 64 * (j))
#define XB_XGEN(j)  (2304 + 64 * (j))
#define XB_TOP      3328
#define XB_TOPGEN   3392
#define XCD_BAR_WORDS 3456
#define XB_SPIN_CAP (1u << 18)

__device__ __forceinline__ unsigned xb_ld(unsigned* p)              { return __hip_atomic_load(p, __ATOMIC_RELAXED, __HIP_MEMORY_SCOPE_AGENT); }
__device__ __forceinline__ unsigned xb_add(unsigned* p, unsigned v) { return __hip_atomic_fetch_add(p, v, __ATOMIC_RELAXED, __HIP_MEMORY_SCOPE_AGENT); }
__device__ __forceinline__ unsigned xb_xcc_id() { return (unsigned)__builtin_amdgcn_s_getreg((3 << 11) | 20) & 0xFu; }
#define XB_SPIN(cond, bar) do { unsigned _sp = 0; while (cond) { __builtin_amdgcn_s_sleep(1); \
    if ((++_sp & 255u) == 0u) { if (xb_ld(&(bar)[XB_TMO])) break; if (_sp > XB_SPIN_CAP) { atomicAdd(&(bar)[XB_TMO], 1u); break; } } } } while (0)

struct XcdBarrier {
    unsigned* bar; unsigned x;
    volatile LAS unsigned* st;
};

__device__ __forceinline__ XcdBarrier xcd_barrier_post(unsigned* bar, volatile LAS unsigned* st) {
    XcdBarrier b; b.bar = bar; b.x = xb_xcc_id(); b.st = st;
    if (threadIdx.x == 0) (void)xb_add(&bar[XB_XCNT(b.x)], 1u);
    return b;
}
__device__ __forceinline__ void xcd_barrier_complete(unsigned* bar, unsigned x, unsigned& nloc, unsigned& nx) {
    const unsigned G = gridDim.x * gridDim.y * gridDim.z;
    unsigned sum, cnt, mine, sp = 0u;
    for (;;) {
        sum = 0u; cnt = 0u; mine = 0u;
#pragma unroll
        for (unsigned j = 0; j < 16; ++j) { const unsigned c = xb_ld(&bar[XB_XCNT(j)]); sum += c; cnt += (c > 0u) ? 1u : 0u; mine = (j == x) ? c : mine; }
        if (sum == G) break;
        __builtin_amdgcn_s_sleep(1);
        if ((++sp & 255u) == 0u) { if (xb_ld(&bar[XB_TMO])) break; if (sp > XB_SPIN_CAP) { atomicAdd(&bar[XB_TMO], 1u); break; } }
    }
    nloc = mine > 0u ? mine : 1u; nx = cnt > 0u ? cnt : 1u;
}

__device__ __forceinline__ void xcd_barrier(const XcdBarrier& b) {
    asm volatile("s_waitcnt vmcnt(0)" ::: "memory");
    __syncthreads();
    if (threadIdx.x == 0) {
        unsigned* bar = b.bar;
        __builtin_amdgcn_s_waitcnt(0);
        unsigned nloc = b.st[0], nx = b.st[1];
        if (nloc == 0u) { xcd_barrier_complete(bar, b.x, nloc, nx); b.st[0] = nloc; b.st[1] = nx; }
        const unsigned old = xb_add(&bar[XB_XSUB(b.x)], 1u);
        const unsigned gen = old / nloc;
        if (old + 1u == (gen + 1u) * nloc) {
            __builtin_amdgcn_fence(__ATOMIC_RELEASE, "agent");
            asm volatile("s_waitcnt vmcnt(0)" ::: "memory");
            const unsigned og = xb_add(&bar[XB_TOP], 1u);
            const unsigned tg = og / nx;
            if (og + 1u == (tg + 1u) * nx) xb_add(&bar[XB_TOPGEN], 1u);
            else XB_SPIN(xb_ld(&bar[XB_TOPGEN]) == tg, bar);
            __builtin_amdgcn_fence(__ATOMIC_ACQUIRE, "agent");
            xb_add(&bar[XB_XGEN(b.x)], 1u);
            asm volatile("s_waitcnt vmcnt(0)" ::: "memory");
        } else {
            XB_SPIN(xb_ld(&bar[XB_XGEN(b.x)]) == gen, bar);
            __builtin_amdgcn_fence(__ATOMIC_ACQUIRE, "agent");
            asm volatile("s_waitcnt vmcnt(0)" ::: "memory");
        }
    }
    __syncthreads();
}
namespace att {
using bf16x8 = __attribute__((ext_vector_type(8))) short;
using s16x4  = __attribute__((ext_vector_type(4))) short;
using f32x16 = __attribute__((ext_vector_type(16))) float;
using u32x4  = __attribute__((ext_vector_type(4))) unsigned;
using u32x2  = __attribute__((ext_vector_type(2))) unsigned;
using f32x4  = __attribute__((ext_vector_type(4))) float;
typedef unsigned short bf16;
constexpr int LD = 7168;
constexpr int TILE_B = 64 * 128 * 2;
#define KSWZ(row, colB) ((row) * 256 + ((colB) ^ (((row) & 7) << 4)))
#define SBAR() __builtin_amdgcn_sched_barrier(0)
__device__ __forceinline__ int crow(int r, int hi) { return (r & 3) + 8 * (r >> 2) + 4 * hi; }
typedef float f32x2_t __attribute__((ext_vector_type(2))); typedef __bf16 bf16x2_t __attribute__((ext_vector_type(2)));
__device__ __forceinline__ unsigned cvtpk(float lo, float hi) { f32x2_t v = {lo, hi}; bf16x2_t b = __builtin_convertvector(v, bf16x2_t); return __builtin_bit_cast(unsigned, b); }
__device__ __forceinline__ bf16x8 ld8(const bf16* p) { return *reinterpret_cast<const bf16x8*>(p); }

constexpr float THR2 = 8.0f;
__device__ __forceinline__ void partialSM(f32x16& p0, f32x16& p1, float& m_reg, float& mn, float& alpha) {
  float pmax = p0[0];
#pragma unroll
  for (int r = 1; r < 16; ++r) pmax = fmaxf(pmax, p0[r]);
#pragma unroll
  for (int r = 0; r < 16; ++r) pmax = fmaxf(pmax, p1[r]);
  { auto rr = __builtin_amdgcn_permlane32_swap(__float_as_uint(pmax), __float_as_uint(pmax), false, false);
    pmax = fmaxf(__uint_as_float(rr[0]), __uint_as_float(rr[1])); }
  if (__builtin_expect(__all(pmax - m_reg <= THR2), 1)) { mn = m_reg; alpha = 1.f; }
  else { mn = fmaxf(m_reg, pmax); alpha = __builtin_amdgcn_exp2f(m_reg - mn); m_reg = mn; }
#pragma unroll
  for (int r = 0; r < 16; ++r) p0[r] = __builtin_amdgcn_exp2f(p0[r] - mn);
#pragma unroll
  for (int r = 0; r < 16; ++r) p1[r] -= mn;
}
#define ATT_PK4(P, BASE, OUT) do { unsigned a0 = cvtpk(P[BASE + 0], P[BASE + 1]), a1 = cvtpk(P[BASE + 2], P[BASE + 3]);   \
    unsigned b0 = cvtpk(P[BASE + 4], P[BASE + 5]), b1 = cvtpk(P[BASE + 6], P[BASE + 7]);                              \
    auto r0 = __builtin_amdgcn_permlane32_swap(a0, b0, false, false); auto r1 = __builtin_amdgcn_permlane32_swap(a1, b1, false, false); \
    u32x4 w = {r0[0], r1[0], r0[1], r1[1]}; OUT = *reinterpret_cast<bf16x8*>(&w); } while (0)
__device__ __forceinline__ void finishSM(f32x16& p0, f32x16& p1, float alpha, float& l_reg, bf16x8& pa0, bf16x8& pa1, bf16x8& pa2, bf16x8& pa3) {
#pragma unroll
  for (int r = 0; r < 16; ++r) p1[r] = __builtin_amdgcn_exp2f(p1[r]);
  float ps = 0;
#pragma unroll
  for (int r = 0; r < 16; ++r) ps += p0[r];
#pragma unroll
  for (int r = 0; r < 16; ++r) ps += p1[r];
  { auto rr = __builtin_amdgcn_permlane32_swap(__float_as_uint(ps), __float_as_uint(ps), false, false);
    ps = __uint_as_float(rr[0]) + __uint_as_float(rr[1]); }
  l_reg = l_reg * alpha + ps;
  ATT_PK4(p0, 0, pa0); ATT_PK4(p0, 8, pa1); ATT_PK4(p1, 0, pa2); ATT_PK4(p1, 8, pa3);
}
template <bool BATCH> __device__ __forceinline__ void qkt(f32x16& p0, f32x16& p1, const char* Ks, const bf16x8* qr, int r32, int hi) {
  if (BATCH) {
    bf16x8 b0[8], b1[8];
#pragma unroll
    for (int d0 = 0; d0 < 8; ++d0) { const int cb = (d0 * 16 + hi * 8) * 2;
      b0[d0] = *reinterpret_cast<const bf16x8*>(Ks + KSWZ(r32, cb)); b1[d0] = *reinterpret_cast<const bf16x8*>(Ks + KSWZ(32 + r32, cb)); }
#pragma unroll
    for (int d0 = 0; d0 < 8; ++d0) {
      p0 = __builtin_amdgcn_mfma_f32_32x32x16_bf16(b0[d0], qr[d0], p0, 0, 0, 0);
      p1 = __builtin_amdgcn_mfma_f32_32x32x16_bf16(b1[d0], qr[d0], p1, 0, 0, 0); }
  } else {
#pragma unroll
    for (int d0 = 0; d0 < 8; ++d0) { const int cb = (d0 * 16 + hi * 8) * 2;
      const bf16x8 b0 = *reinterpret_cast<const bf16x8*>(Ks + KSWZ(r32, cb));
      const bf16x8 b1 = *reinterpret_cast<const bf16x8*>(Ks + KSWZ(32 + r32, cb));
      p0 = __builtin_amdgcn_mfma_f32_32x32x16_bf16(b0, qr[d0], p0, 0, 0, 0);
      p1 = __builtin_amdgcn_mfma_f32_32x32x16_bf16(b1, qr[d0], p1, 0, 0, 0); }
  }
}
__device__ __forceinline__ int v_st(int k, int c) { const int kk = (k & ~0xC) | ((k & 4) << 1) | ((k & 8) >> 1); return ((kk >> 3) * 4 + (c >> 5)) * 512 + ((kk & 7) * 32 + (c & 31)) * 2; }
__device__ __forceinline__ int v_rd_base(int lane) { return ((lane & 3) << 3) | (((lane >> 2) & 3) << 6) | (((lane >> 4) & 1) << 5) | (((lane >> 5) & 1) << 8); }
constexpr int v_rd_off(int d0, int ks, int half) { return d0 * 512 + ks * 4096 + half * 2048; }
template <int OFF> __device__ __forceinline__ s16x4 tr_read(int vb) {
  s16x4 r; asm volatile("ds_read_b64_tr_b16 %0, %1 offset:%2" : "=&v"(r) : "v"(vb), "i"(OFF) : "memory"); return r;
}
#define ATT_PK(L, H) (bf16x8){L[0], L[1], L[2], L[3], H[0], H[1], H[2], H[3]}
template <int D0, bool TRANS> __device__ __forceinline__ void pv_one(f32x16& od, int vb, bf16x8 pa0, bf16x8 pa1, bf16x8 pa2, bf16x8 pa3) {
  const s16x4 l0 = tr_read<v_rd_off(D0, 0, 0)>(vb), h0 = tr_read<v_rd_off(D0, 0, 1)>(vb), l1 = tr_read<v_rd_off(D0, 1, 0)>(vb), h1 = tr_read<v_rd_off(D0, 1, 1)>(vb);
  const s16x4 l2 = tr_read<v_rd_off(D0, 2, 0)>(vb), h2 = tr_read<v_rd_off(D0, 2, 1)>(vb), l3 = tr_read<v_rd_off(D0, 3, 0)>(vb), h3 = tr_read<v_rd_off(D0, 3, 1)>(vb);
  asm volatile("s_waitcnt lgkmcnt(0)" ::: "memory"); SBAR();
  if (TRANS) {
    od = __builtin_amdgcn_mfma_f32_32x32x16_bf16(ATT_PK(l0, h0), pa0, od, 0, 0, 0);
    od = __builtin_amdgcn_mfma_f32_32x32x16_bf16(ATT_PK(l1, h1), pa1, od, 0, 0, 0);
    od = __builtin_amdgcn_mfma_f32_32x32x16_bf16(ATT_PK(l2, h2), pa2, od, 0, 0, 0);
    od = __builtin_amdgcn_mfma_f32_32x32x16_bf16(ATT_PK(l3, h3), pa3, od, 0, 0, 0);
  } else {
    od = __builtin_amdgcn_mfma_f32_32x32x16_bf16(pa0, ATT_PK(l0, h0), od, 0, 0, 0);
    od = __builtin_amdgcn_mfma_f32_32x32x16_bf16(pa1, ATT_PK(l1, h1), od, 0, 0, 0);
    od = __builtin_amdgcn_mfma_f32_32x32x16_bf16(pa2, ATT_PK(l2, h2), od, 0, 0, 0);
    od = __builtin_amdgcn_mfma_f32_32x32x16_bf16(pa3, ATT_PK(l3, h3), od, 0, 0, 0);
  }
}
template <int DA, bool TRANS> __device__ __forceinline__ void pv_two(f32x16& oa, f32x16& ob, int vb, bf16x8 pa0, bf16x8 pa1, bf16x8 pa2, bf16x8 pa3) {
  constexpr int DB = DA + 1;
  const s16x4 al0 = tr_read<v_rd_off(DA, 0, 0)>(vb), ah0 = tr_read<v_rd_off(DA, 0, 1)>(vb), al1 = tr_read<v_rd_off(DA, 1, 0)>(vb), ah1 = tr_read<v_rd_off(DA, 1, 1)>(vb);
  const s16x4 al2 = tr_read<v_rd_off(DA, 2, 0)>(vb), ah2 = tr_read<v_rd_off(DA, 2, 1)>(vb), al3 = tr_read<v_rd_off(DA, 3, 0)>(vb), ah3 = tr_read<v_rd_off(DA, 3, 1)>(vb);
  const s16x4 bl0 = tr_read<v_rd_off(DB, 0, 0)>(vb), bh0 = tr_read<v_rd_off(DB, 0, 1)>(vb), bl1 = tr_read<v_rd_off(DB, 1, 0)>(vb), bh1 = tr_read<v_rd_off(DB, 1, 1)>(vb);
  const s16x4 bl2 = tr_read<v_rd_off(DB, 2, 0)>(vb), bh2 = tr_read<v_rd_off(DB, 2, 1)>(vb), bl3 = tr_read<v_rd_off(DB, 3, 0)>(vb), bh3 = tr_read<v_rd_off(DB, 3, 1)>(vb);
  asm volatile("s_waitcnt lgkmcnt(0)" ::: "memory"); SBAR();
  if (TRANS) {
    oa = __builtin_amdgcn_mfma_f32_32x32x16_bf16(ATT_PK(al0, ah0), pa0, oa, 0, 0, 0); ob = __builtin_amdgcn_mfma_f32_32x32x16_bf16(ATT_PK(bl0, bh0), pa0, ob, 0, 0, 0);
    oa = __builtin_amdgcn_mfma_f32_32x32x16_bf16(ATT_PK(al1, ah1), pa1, oa, 0, 0, 0); ob = __builtin_amdgcn_mfma_f32_32x32x16_bf16(ATT_PK(bl1, bh1), pa1, ob, 0, 0, 0);
    oa = __builtin_amdgcn_mfma_f32_32x32x16_bf16(ATT_PK(al2, ah2), pa2, oa, 0, 0, 0); ob = __builtin_amdgcn_mfma_f32_32x32x16_bf16(ATT_PK(bl2, bh2), pa2, ob, 0, 0, 0);
    oa = __builtin_amdgcn_mfma_f32_32x32x16_bf16(ATT_PK(al3, ah3), pa3, oa, 0, 0, 0); ob = __builtin_amdgcn_mfma_f32_32x32x16_bf16(ATT_PK(bl3, bh3), pa3, ob, 0, 0, 0);
  } else {
    oa = __builtin_amdgcn_mfma_f32_32x32x16_bf16(pa0, ATT_PK(al0, ah0), oa, 0, 0, 0); ob = __builtin_amdgcn_mfma_f32_32x32x16_bf16(pa0, ATT_PK(bl0, bh0), ob, 0, 0, 0);
    oa = __builtin_amdgcn_mfma_f32_32x32x16_bf16(pa1, ATT_PK(al1, ah1), oa, 0, 0, 0); ob = __builtin_amdgcn_mfma_f32_32x32x16_bf16(pa1, ATT_PK(bl1, bh1), ob, 0, 0, 0);
    oa = __builtin_amdgcn_mfma_f32_32x32x16_bf16(pa2, ATT_PK(al2, ah2), oa, 0, 0, 0); ob = __builtin_amdgcn_mfma_f32_32x32x16_bf16(pa2, ATT_PK(bl2, bh2), ob, 0, 0, 0);
    oa = __builtin_amdgcn_mfma_f32_32x32x16_bf16(pa3, ATT_PK(al3, ah3), oa, 0, 0, 0); ob = __builtin_amdgcn_mfma_f32_32x32x16_bf16(pa3, ATT_PK(bl3, bh3), ob, 0, 0, 0);
  }
}
template <bool TRANS> __device__ __forceinline__ void pv_d0(f32x16* o, int vb, bf16x8 pa0, bf16x8 pa1, bf16x8 pa2, bf16x8 pa3) {
  if (TRANS) {
    pv_one<0, TRANS>(o[0], vb, pa0, pa1, pa2, pa3); pv_one<1, TRANS>(o[1], vb, pa0, pa1, pa2, pa3); pv_one<2, TRANS>(o[2], vb, pa0, pa1, pa2, pa3); pv_one<3, TRANS>(o[3], vb, pa0, pa1, pa2, pa3);
  } else { pv_two<0, TRANS>(o[0], o[1], vb, pa0, pa1, pa2, pa3); pv_two<2, TRANS>(o[2], o[3], vb, pa0, pa1, pa2, pa3); }
}

constexpr int A_V = 0, A_K = 2 * TILE_B, A_WS = 4 * TILE_B, A_BT = A_WS + 8 * 256, A_BYTES = A_BT + 768;
__device__ __forceinline__ void attn_unit(int b, int h, int g, const bf16* __restrict__ PROJ, const float* __restrict__ relb, bf16* __restrict__ MIX, char* lds) {
  const int tid = threadIdx.x, wid = __builtin_amdgcn_readfirstlane(tid >> 6), lane = tid & 63, r32 = lane & 31, hi = lane >> 5;
  char* V_lds = lds + A_V; char* K_lds = lds + A_K;
  float* ws = (float*)(lds + A_WS) + wid * 64; float* li_l = ws; float* al_l = ws + 32;
  float* btab = (float*)(lds + A_BT);
  if (tid < 192) btab[tid] = relb[h * 192 + tid] * 1.4426950408889634f;
  const int n = 4 * g + (wid >> 1), qi = (wid & 1) * 32 + r32;
  const long rowq = (long)b * 4096 + n * 64 + qi;
  float m_reg = -1e30f, l_reg = 0; f32x16 o[4] = {}; bf16x8 qr[8];
  { const bf16* Qw = PROJ + rowq * LD + 4096 + h * 128 + hi * 8;
#pragma unroll
    for (int d0 = 0; d0 < 8; ++d0) qr[d0] = ld8(Qw + d0 * 16); }
  const bf16* Kh = PROJ + (long)b * 4096 * LD + 5120 + h * 128; const bf16* Vh = Kh + 1024;
  const int sr = tid >> 4, sc = (tid & 15) * 8, vst0 = v_st(sr, sc), vst1 = v_st(32 + sr, sc);
  const int vb0 = (int)(uintptr_t)V_lds + v_rd_base(lane);
  bf16x8 vsA0, vsA1, ksA0, ksA1;
#define A_SLOAD(S, k0) do { vs##S##0 = ld8(&Vh[(long)((k0) + sr) * LD + sc]); vs##S##1 = ld8(&Vh[(long)((k0) + 32 + sr) * LD + sc]); \
    ks##S##0 = ld8(&Kh[(long)((k0) + sr) * LD + sc]); ks##S##1 = ld8(&Kh[(long)((k0) + 32 + sr) * LD + sc]); } while (0)
#define A_SWRITE(S, bb) do { *(bf16x8*)(V_lds + (bb) * TILE_B + vst0) = vs##S##0; *(bf16x8*)(V_lds + (bb) * TILE_B + vst1) = vs##S##1; \
    *(bf16x8*)(K_lds + (bb) * TILE_B + KSWZ(sr, sc * 2)) = ks##S##0; *(bf16x8*)(K_lds + (bb) * TILE_B + KSWZ(32 + sr, sc * 2)) = ks##S##1; } while (0)
  const int kc0 = (4 * g - 8) > 0 ? (4 * g - 8) : 0, NT = 4 * g + 4 - kc0;
  A_SLOAD(A, kc0 * 64); A_SWRITE(A, 0); __syncthreads();
#define A_COMPUTE(j, bb) do { const int kc = kc0 + (j); const int delta = n - kc;                                            \
    if (delta >= 0 && delta <= 8) { \
      f32x16 p0, p1; \
      if (delta >= 3) { const float bc = btab[191]; \
        _Pragma("unroll") for (int r = 0; r < 16; ++r) { p0[r] = bc; p1[r] = bc; } } \
      else { const int base = 64 * delta + qi + 63;                     \
        _Pragma("unroll") for (int r = 0; r < 16; ++r) { const int kl = crow(r, hi); int i0 = base - kl, i1 = base - kl - 32; i0 = i0 > 191 ? 191 : i0; i1 = i1 > 191 ? 191 : i1; p0[r] = btab[i0]; p1[r] = btab[i1]; } } \
      qkt<true>(p0, p1, K_lds + (bb) * TILE_B, qr, r32, hi); \
      float mn, alpha; bf16x8 pa0, pa1, pa2, pa3; \
      partialSM(p0, p1, m_reg, mn, alpha); \
      if (__any(alpha < 1.f)) { if (hi == 0) al_l[r32] = alpha; asm volatile("s_waitcnt lgkmcnt(0)" ::: "memory"); \
        _Pragma("unroll") for (int d = 0; d < 4; ++d) _Pragma("unroll") for (int r = 0; r < 16; ++r) o[d][r] *= al_l[crow(r, hi)]; } \
      finishSM(p0, p1, alpha, l_reg, pa0, pa1, pa2, pa3); SBAR(); \
      pv_d0<false>(o, vb0 + (bb) * TILE_B, pa0, pa1, pa2, pa3); \
    } } while (0)
  for (int j = 0; j < NT; j += 2) {
    A_SLOAD(A, (kc0 + j + 1) * 64);
    A_COMPUTE(j, 0);
    A_SWRITE(A, 1);
    __syncthreads();
    if (j + 2 < NT) A_SLOAD(A, (kc0 + j + 2) * 64);
    A_COMPUTE(j + 1, 1);
    if (j + 2 < NT) A_SWRITE(A, 0);
    __syncthreads();
  }
#undef A_COMPUTE
  if (hi == 0) li_l[r32] = l_reg; asm volatile("s_waitcnt lgkmcnt(0)" ::: "memory");
  { bf16* stg = (bf16*)(lds + wid * 8192);
#pragma unroll
    for (int r = 0; r < 16; ++r) { const int orow = crow(r, hi); const float rl = __builtin_amdgcn_rcpf(li_l[orow]);
#pragma unroll
      for (int d0 = 0; d0 < 4; ++d0) { const unsigned w = cvtpk(o[d0][r] * rl, 0.f); stg[orow * 128 + d0 * 32 + r32] = (bf16)(w & 0xffffu); } }
    asm volatile("s_waitcnt lgkmcnt(0)" ::: "memory");
    bf16* Ow = MIX + ((long)b * 4096 + n * 64 + (wid & 1) * 32) * 2048 + 1024 + h * 128;
#pragma unroll
    for (int i = 0; i < 8; ++i) { const int row = i * 4 + (lane >> 4), ch = lane & 15; const u32x4 v = *(const u32x4*)(stg + row * 128 + ch * 8); *(u32x4*)(Ow + (long)row * 2048 + ch * 8) = v; } }
  __syncthreads();
#undef A_SLOAD
#undef A_SWRITE
}

constexpr int R_K = 0, R_V = 4 * TILE_B;
__device__ __forceinline__ bf16x8 scale8(bf16x8 x, float s) {
  const u32x4 w = *reinterpret_cast<const u32x4*>(&x); u32x4 o;
#pragma unroll
  for (int i = 0; i < 4; ++i) o[i] = cvtpk(__uint_as_float(w[i] << 16) * s, __uint_as_float(w[i] & 0xffff0000u) * s);
  return *reinterpret_cast<bf16x8*>(&o);
}
template <bool KIMG> __device__ __forceinline__ void ret_stage(int b, int h, int g, const bf16* __restrict__ PROJ, char* lds, float lg2h) {
  const int tid = threadIdx.x, c = __builtin_amdgcn_readfirstlane(tid >> 7), t2 = tid & 127, sr = t2 >> 4, sc = (t2 & 15) * 8;
  const bf16* Kc = PROJ + ((long)b * 4096 + (4 * g + c) * 64) * LD + 1024 + h * 128; const bf16* Vc = Kc + 1024;
  char* Kt = lds + R_K + c * TILE_B; char* Vt = lds + R_V + c * TILE_B;
  constexpr int NB = 2, PB = 8 / NB;
#pragma unroll
  for (int hb = 0; hb < NB; ++hb) {
    bf16x8 kv[PB], vv[PB];
#pragma unroll
    for (int i = 0; i < PB; ++i) { const int row = sr + 8 * (PB * hb + i); kv[i] = ld8(Kc + (long)row * LD + sc); vv[i] = ld8(Vc + (long)row * LD + sc); }
#pragma unroll
    for (int i = 0; i < PB; ++i) { const int row = sr + 8 * (PB * hb + i);
      if (KIMG) *(bf16x8*)(Kt + v_st(row, sc)) = scale8(kv[i], __builtin_amdgcn_exp2f(lg2h * (float)(63 - row)));
      else *(bf16x8*)(Kt + KSWZ(row, sc * 2)) = kv[i];
      *(bf16x8*)(Vt + v_st(row, sc)) = vv[i]; }
  }
  __syncthreads();
}
template <int D0, int KS> __device__ __forceinline__ bf16x8 img_frag(int vb) {
  const s16x4 l = tr_read<v_rd_off(D0, KS, 0)>(vb), hh = tr_read<v_rd_off(D0, KS, 1)>(vb);
  asm volatile("s_waitcnt lgkmcnt(0)" ::: "memory"); SBAR();
  return ATT_PK(l, hh);
}
__device__ __forceinline__ void contrib_unit(int b, int h, int g, const bf16* __restrict__ PROJ, bf16* __restrict__ CONTRIB, char* lds, float lg2h) {
  ret_stage<true>(b, h, g, PROJ, lds, lg2h);
  const int tid = threadIdx.x, wid = __builtin_amdgcn_readfirstlane(tid >> 6), lane = tid & 63, r32 = lane & 31, hi = lane >> 5, c = wid >> 1, dvh = wid & 1;
  const int kb = (int)(uintptr_t)(lds + R_K + c * TILE_B) + v_rd_base(lane), vb = (int)(uintptr_t)(lds + R_V + c * TILE_B) + v_rd_base(lane);
  f32x16 acc[4][2] = {};
#define C_RD(D0, KS, B, L, H) const s16x4 L = tr_read<v_rd_off(D0, KS, 0)>(B), H = tr_read<v_rd_off(D0, KS, 1)>(B)
#define C_STEP(KS) do { bf16x8 v0, v1; { s16x4 v0l, v0h, v1l, v1h; if (dvh) { v0l = tr_read<v_rd_off(2, KS, 0)>(vb); v0h = tr_read<v_rd_off(2, KS, 1)>(vb); v1l = tr_read<v_rd_off(3, KS, 0)>(vb); v1h = tr_read<v_rd_off(3, KS, 1)>(vb); } \
      else { v0l = tr_read<v_rd_off(0, KS, 0)>(vb); v0h = tr_read<v_rd_off(0, KS, 1)>(vb); v1l = tr_read<v_rd_off(1, KS, 0)>(vb); v1h = tr_read<v_rd_off(1, KS, 1)>(vb); } \
      asm volatile("s_waitcnt lgkmcnt(0)" ::: "memory"); SBAR(); v0 = ATT_PK(v0l, v0h); v1 = ATT_PK(v1l, v1h); } \
    C_RD(0, KS, kb, k0l, k0h); C_RD(1, KS, kb, k1l, k1h); C_RD(2, KS, kb, k2l, k2h); C_RD(3, KS, kb, k3l, k3h); \
    asm volatile("s_waitcnt lgkmcnt(0)" ::: "memory"); SBAR();        \
    const bf16x8 ka0 = ATT_PK(k0l, k0h), ka1 = ATT_PK(k1l, k1h), ka2 = ATT_PK(k2l, k2h), ka3 = ATT_PK(k3l, k3h); \
    acc[0][0] = __builtin_amdgcn_mfma_f32_32x32x16_bf16(ka0, v0, acc[0][0], 0, 0, 0); acc[0][1] = __builtin_amdgcn_mfma_f32_32x32x16_bf16(ka0, v1, acc[0][1], 0, 0, 0); \
    acc[1][0] = __builtin_amdgcn_mfma_f32_32x32x16_bf16(ka1, v0, acc[1][0], 0, 0, 0); acc[1][1] = __builtin_amdgcn_mfma_f32_32x32x16_bf16(ka1, v1, acc[1][1], 0, 0, 0); \
    acc[2][0] = __builtin_amdgcn_mfma_f32_32x32x16_bf16(ka2, v0, acc[2][0], 0, 0, 0); acc[2][1] = __builtin_amdgcn_mfma_f32_32x32x16_bf16(ka2, v1, acc[2][1], 0, 0, 0); \
    acc[3][0] = __builtin_amdgcn_mfma_f32_32x32x16_bf16(ka3, v0, acc[3][0], 0, 0, 0); acc[3][1] = __builtin_amdgcn_mfma_f32_32x32x16_bf16(ka3, v1, acc[3][1], 0, 0, 0); } while (0)
  C_STEP(0); C_STEP(1); C_STEP(2); C_STEP(3);
#undef C_STEP
#undef C_RD
  const int unit = (b * 8 + h) * 64 + 4 * g + c;
  bf16* Cb = CONTRIB + (long)unit * 16384 + dvh * 64 * 128;
  __syncthreads();
  { char* stg = lds + wid * 16384;
#pragma unroll
    for (int dkb = 0; dkb < 4; ++dkb)
#pragma unroll
      for (int dvb = 0; dvb < 2; ++dvb) { const int row = 32 * dvb + r32;
#pragma unroll
        for (int rq = 0; rq < 4; ++rq) { const int dk = 32 * dkb + 8 * rq + 4 * hi; const f32x16& a = acc[dkb][dvb];
          u32x2 w; w.x = cvtpk(a[4 * rq], a[4 * rq + 1]); w.y = cvtpk(a[4 * rq + 2], a[4 * rq + 3]);
          *(u32x2*)(stg + row * 256 + ((((dk >> 3) ^ (row & 15)) << 4) | ((dk & 4) << 1))) = w; } }
    asm volatile("s_waitcnt lgkmcnt(0)" ::: "memory");
#pragma unroll
    for (int i = 0; i < 16; ++i) { const int row = i * 4 + (lane >> 4), ch = lane & 15; const u32x4 v = *(const u32x4*)(stg + row * 256 + ((ch ^ (row & 15)) << 4)); *(u32x4*)(Cb + row * 128 + ch * 8) = v; } }
  __syncthreads();
}
template <int RT_EXP = 0> __device__ __forceinline__ void retout_unit(int b, int h, int g, const bf16* __restrict__ PROJ, const bf16* __restrict__ PREV, const float* __restrict__ gn, bf16* __restrict__ MIX, char* lds, float* dtab, float lg2h) {
  const int tid = threadIdx.x, wid = __builtin_amdgcn_readfirstlane(tid >> 6), lane = tid & 63, r32 = lane & 31, hi = lane >> 5, c = wid >> 1;
  if (tid < 64) dtab[tid] = __builtin_amdgcn_exp2f(lg2h * (float)tid);
  const int n = 4 * g + c, qi = (wid & 1) * 32 + r32;
  const long rowq = (long)b * 4096 + n * 64 + qi;
  bf16x8 qr[8];
  { const bf16* Qw = PROJ + rowq * LD + h * 128 + hi * 8;
#pragma unroll
    for (int d0 = 0; d0 < 8; ++d0) qr[d0] = ld8(Qw + d0 * 16); }
  ret_stage<false>(b, h, g, PROJ, lds, lg2h);
  f32x16 p0 = {}, p1 = {};
  if (RT_EXP != 2) qkt<false>(p0, p1, lds + R_K + c * TILE_B, qr, r32, hi);
  { const float iq = __builtin_amdgcn_exp2f(-lg2h * (float)(qi + 1));
#pragma unroll
    for (int r = 0; r < 16; ++r) { const int kl = crow(r, hi); const int d0 = qi > kl ? qi - kl : kl - qi; const int d1 = qi > kl + 32 ? qi - kl - 32 : kl + 32 - qi;
      p0[r] *= dtab[d0] * iq; p1[r] *= dtab[d1] * iq; } }
  bf16x8 pa0, pa1, pa2, pa3;
  ATT_PK4(p0, 0, pa0); ATT_PK4(p0, 8, pa1); ATT_PK4(p1, 0, pa2); ATT_PK4(p1, 8, pa3);
  f32x16 o[4] = {};
  if (RT_EXP != 2) pv_d0<true>(o, (int)(uintptr_t)(lds + R_V + c * TILE_B) + v_rd_base(lane), pa0, pa1, pa2, pa3);
  if (RT_EXP != 1) { const int unit = (b * 8 + h) * 64 + n; const bf16* Pb = PREV + (long)unit * 16384 + hi * 8;
#pragma unroll
    for (int d0 = 0; d0 < 4; ++d0) { bf16x8 a[8]; asm volatile("" ::: "memory");
#pragma unroll
      for (int s = 0; s < 8; ++s) a[s] = ld8(Pb + (32 * d0 + r32) * 128 + 16 * s);
#pragma unroll
      for (int s = 0; s < 8; ++s) o[d0] = __builtin_amdgcn_mfma_f32_32x32x16_bf16(a[s], qr[s], o[d0], 0, 0, 0); } }
  float s1 = 0.f;
#pragma unroll
  for (int d0 = 0; d0 < 4; ++d0)
#pragma unroll
    for (int r = 0; r < 16; ++r) s1 += o[d0][r];
  { auto rr = __builtin_amdgcn_permlane32_swap(__float_as_uint(s1), __float_as_uint(s1), false, false); s1 = __uint_as_float(rr[0]) + __uint_as_float(rr[1]); }
  const float mu = s1 * (1.f / 128.f); float s2 = 0.f;
#pragma unroll
  for (int d0 = 0; d0 < 4; ++d0)
#pragma unroll
    for (int r = 0; r < 16; ++r) { o[d0][r] -= mu; s2 += o[d0][r] * o[d0][r]; }
  { auto rr = __builtin_amdgcn_permlane32_swap(__float_as_uint(s2), __float_as_uint(s2), false, false); s2 = __uint_as_float(rr[0]) + __uint_as_float(rr[1]); }
  const float qd = __builtin_amdgcn_exp2f(lg2h * (float)(qi + 1));
  const float sc = qd / sqrtf(qd * qd * s2 * (1.f / 128.f) + 1e-5f);
  const bf16* Gq = PROJ + rowq * LD + 3072 + h * 128; const float* gnh = gn + h * 128;
  __syncthreads();
  { char* stg = lds + wid * 8192;
#pragma unroll
    for (int d0 = 0; d0 < 4; ++d0) { asm volatile("" ::: "memory");
#pragma unroll
      for (int rq = 0; rq < 4; ++rq) { const int dv = 32 * d0 + 8 * rq + 4 * hi;
        const u32x2 gt = *(const u32x2*)(Gq + dv); const f32x4 gg = *(const f32x4*)(gnh + dv);
        const float y0 = o[d0][4 * rq] * sc * gg[0] * __uint_as_float(gt.x << 16), y1 = o[d0][4 * rq + 1] * sc * gg[1] * __uint_as_float(gt.x & 0xffff0000u);
        const float y2 = o[d0][4 * rq + 2] * sc * gg[2] * __uint_as_float(gt.y << 16), y3 = o[d0][4 * rq + 3] * sc * gg[3] * __uint_as_float(gt.y & 0xffff0000u);
        u32x2 w; w.x = cvtpk(y0, y1); w.y = cvtpk(y2, y3);
        *(u32x2*)(stg + r32 * 256 + ((((dv >> 3) ^ (r32 & 15)) << 4) | ((dv & 4) << 1))) = w; } }
    asm volatile("s_waitcnt lgkmcnt(0)" ::: "memory");
    bf16* Ow = MIX + ((long)b * 4096 + n * 64 + (wid & 1) * 32) * 2048 + h * 128;
#pragma unroll
    for (int i = 0; i < 8; ++i) { const int row = i * 4 + (lane >> 4), ch = lane & 15; const u32x4 v = *(const u32x4*)(stg + row * 256 + ((ch ^ (row & 15)) << 4)); *(u32x4*)(Ow + (long)row * 2048 + ch * 8) = v; } }
  __syncthreads();
}
}
#ifndef NAIVE_CONTRIB
#define NAIVE_CONTRIB 0
#endif
#ifndef NAIVE_RETOUT
#define NAIVE_RETOUT 0
#endif
#ifndef PROBE_REPEAT_MASK
#define PROBE_REPEAT_MASK 0
#endif
#ifndef PROBE_EXTRA_BARS
#define PROBE_EXTRA_BARS 0
#endif
#define REPS(k)
#ifndef CONV_C1
#define CONV_C1 18432
#endif
#ifndef CONV_C2
#define CONV_C2 18432
#endif
#ifndef CONV_C3
#define CONV_C3 18432
#endif
#ifndef CONV_WGS
#define CONV_WGS 32
#endif
#ifndef CV_PW
#define CV_PW 4
#endif
#ifndef PROBE_X
#define PROBE_X 0
#endif
#ifndef PROBE_XN
#define PROBE_XN 1
#endif
#ifndef PROBE_T
#define PROBE_T 0
#endif
#ifndef PROBE_TA
#define PROBE_TA 0
#endif
#ifndef PROBE_TB
#define PROBE_TB 8
#endif
#ifndef PROBE_TOFF
#define PROBE_TOFF 0
#endif
#ifndef PROBE_TQ
#define PROBE_TQ 1
#endif
#ifndef PROBE_TTHR
#define PROBE_TTHR 0
#endif
#ifndef WGM_P1
#define WGM_P1 8
#endif
#ifndef WGM_P5
#define WGM_P5 4
#endif
#ifndef WGM_P6
#define WGM_P6 2
#endif
#ifndef WGM_P7
#define WGM_P7 4
#endif
constexpr int NWAVES = 8;
#ifndef MK_N_LAUNCHES
#define MK_N_LAUNCHES 1
#endif
constexpr int PER_PHASE = 8;
constexpr int N_LAUNCHES = MK_N_LAUNCHES;

constexpr int BATCH = 2, SEQ = 4096, DM = 2048, M = BATCH * SEQ, NIN = 7168, DFF = 8192;
constexpr int CH = 64, NCH = SEQ / CH, NH = 8, HD = 128, LEFT = 8, RELSZ = 192;
constexpr float EPS = 1e-6f, GN_EPS = 1e-5f, LOG2E = 1.4426950408889634f;
constexpr int SEC_RQ = 0, SEC_RK = 1024, SEC_RV = 2048, SEC_RG = 3072, SEC_AQ = 4096, SEC_AK = 5120, SEC_AV = 6144;

constexpr size_t MiB = 1u << 20;
constexpr size_t WS_CTL = 0, CTL_ZERO_BYTES = 32768;
constexpr size_t WS_WOT = 1 * MiB, WS_W1T = 9 * MiB, WS_W2T = 41 * MiB, WS_WINT = 73 * MiB;
constexpr size_t WS_MIX = 73 * MiB;
constexpr size_t WS_PROJ = 105 * MiB;
constexpr size_t WS_PREV = 217 * MiB;
constexpr size_t WS_X1B = 217 * MiB;
constexpr size_t WS_CS = 249 * MiB;
constexpr size_t WS_ROWSS = 251 * MiB;
constexpr size_t WS_U = 73 * MiB;
constexpr size_t WS_CSSTEP = 252 * MiB;
constexpr size_t WS_END = 252 * MiB + 4096;
constexpr size_t OUT_XN = 0, OUT_CONTRIB = 32 * MiB;
static_assert(WS_U + (size_t)M * DFF * 2 <= WS_X1B && WS_WINT + (size_t)NIN * DM * 2 <= WS_PROJ && WS_PROJ + (size_t)M * NIN * 2 <= WS_PREV, "d_ws map");
constexpr int CW_TMO = 0, CW_CODE = 1;
constexpr int CW_BAR = 4096;
constexpr int CW_CONV = 1024;

constexpr int RING_OFF = 0, RING_BYTES = 131072;
constexpr int XCH_OFF = RING_BYTES, XCH_BYTES = 8192;
constexpr int LDSCTL_OFF = XCH_OFF + XCH_BYTES, MISC_OFF = LDSCTL_OFF + 320;
constexpr int LDS_BYTES = 147456;
static_assert(MISC_OFF + 128 <= LDS_BYTES, "LDS map");

struct Frame {
    LAS unsigned char* lds;
    volatile LAS unsigned* MISC;
    gu32* ctl;
    int tid, lane, wave;
    int vcu, G;
};
__device__ __forceinline__ float wave_sum(float v) {
#pragma unroll
    for (int o = 1; o < 64; o <<= 1) v += __shfl_xor(v, o);
    return v;
}
__device__ __forceinline__ float wave_max(float v) {
#pragma unroll
    for (int o = 1; o < 64; o <<= 1) v = fmaxf(v, __shfl_xor(v, o));
    return v;
}
__device__ __forceinline__ float bf_lo(unsigned u) { return __uint_as_float(u << 16); }
__device__ __forceinline__ float bf_hi(unsigned u) { return __uint_as_float(u & 0xffff0000u); }

template <bool ROT, bool BLKOUT = false>
__device__ __forceinline__ void p0_transpose_item(const float* W, int K, int N, bf16* WT, LAS float* scr, int item, int lane) {
    const int nblk = N / 32, kb = item / nblk, nb = item % nblk, k0 = 64 * kb, n0 = 32 * nb;
    f32x4 v[8];
    { const float* p = W + (size_t)(k0 + (lane >> 3)) * N + n0 + 4 * (lane & 7);
#pragma unroll
      for (int i = 0; i < 8; ++i) v[i] = __builtin_nontemporal_load((const GAS f32x4*)(p + (size_t)(8 * i) * N)); }
#pragma unroll
    for (int i = 0; i < 8; ++i) { LAS float* d = scr + (8 * i + (lane >> 3)) * 33 + 4 * (lane & 7); d[0] = v[i].x; d[1] = v[i].y; d[2] = v[i].z; d[3] = v[i].w; }
    LDS_WAIT(); asm volatile("" ::: "memory");
    const int c = lane & 7;
#pragma unroll
    for (int j = 0; j < 4; ++j) { const int n = (lane >> 3) + 8 * j; const LAS float* s = scr + (8 * c) * 33 + n;
        v4u o; o.x = pk2(s[0 * 33], s[1 * 33]); o.y = pk2(s[2 * 33], s[3 * 33]); o.z = pk2(s[4 * 33], s[5 * 33]); o.w = pk2(s[6 * 33], s[7 * 33]);
        int row = n0 + n;
        if (ROT && row < 2048) { const int d = row & 127; row = (row & ~127) + 2 * (d & 63) + (d >> 6); }
        if (BLKOUT) *(GAS v4u*)((GAS char*)WT + ((size_t)(row >> 8) * (K / 64) + kb) * 32768 + (row & 255) * 128 + 16 * c) = o;
        else *(GAS v4u*)(WT + (size_t)row * K + k0 + 8 * c) = o; }
    LDS_WAIT(); asm volatile("" ::: "memory");
}

__device__ __forceinline__ void tr_load(const float* W, int N, int item, f32x4 (&v)[8], int lane) {
    const int nblk = N / 32, kb = item / nblk, nb = item % nblk;
    const float* p = W + (size_t)(64 * kb + (lane >> 3)) * N + 32 * nb + 4 * (lane & 7);
#pragma unroll
    for (int i = 0; i < 8; ++i) v[i] = __builtin_nontemporal_load((const GAS f32x4*)(p + (size_t)(8 * i) * N));
}
template <bool ROT>
__device__ __forceinline__ void tr_finish(bf16* WT, int K, int N, int item, const f32x4 (&v)[8], LAS float* scr, int lane) {
    const int nblk = N / 32, kb = item / nblk, nb = item % nblk, k0 = 64 * kb, n0 = 32 * nb;
#pragma unroll
    for (int i = 0; i < 8; ++i) { LAS float* d = scr + (8 * i + (lane >> 3)) * 33 + 4 * (lane & 7); d[0] = v[i].x; d[1] = v[i].y; d[2] = v[i].z; d[3] = v[i].w; }
    LDS_WAIT(); asm volatile("" ::: "memory");
    const int c = lane & 7;
#pragma unroll
    for (int j = 0; j < 4; ++j) { const int n = (lane >> 3) + 8 * j; const LAS float* s = scr + (8 * c) * 33 + n;
        v4u o; o.x = pk2(s[0 * 33], s[1 * 33]); o.y = pk2(s[2 * 33], s[3 * 33]); o.z = pk2(s[4 * 33], s[5 * 33]); o.w = pk2(s[6 * 33], s[7 * 33]);
        int row = n0 + n;
        if (ROT && row < 2048) { const int d = row & 127; row = (row & ~127) + 2 * (d & 63) + (d >> 6); }
        *(GAS v4u*)(WT + (size_t)row * K + k0 + 8 * c) = o; }
    LDS_WAIT(); asm volatile("" ::: "memory");
}
struct CvMats { const float* w_out; const float* w1; const float* w2; bf16* WoT; bf16* W1T; bf16* W2T; const float* g2; };
constexpr int CV_I_O = (DM / 64) * (DM / 32), CV_I_1 = (DM / 64) * (DFF / 32), CV_I_2 = (DFF / 64) * (DM / 32);
__device__ __forceinline__ void cv_load(const CvMats& m, int r, f32x4 (&v)[8], int lane) {
    const float* W; int N, item;
    if (r < CV_I_O) { W = m.w_out; N = DM; item = r; } else if (r < CV_I_O + CV_I_1) { W = m.w1; N = DFF; item = r - CV_I_O; } else { W = m.w2; N = DM; item = r - CV_I_O - CV_I_1; }
    const int nblk = N / 32, kb = item / nblk, nb = item % nblk;
    const float* p = W + (size_t)(64 * kb + (lane >> 3)) * N + 32 * nb + 4 * (lane & 7);
#pragma unroll
    for (int i = 0; i < 8; ++i) v[i] = __builtin_nontemporal_load((const GAS f32x4*)(p + (size_t)(8 * i) * N));
    if (r >= CV_I_O && r < CV_I_O + CV_I_1) {
#pragma unroll
        for (int i = 0; i < 8; ++i) v[i] *= m.g2[64 * kb + 8 * i + (lane >> 3)];
    }
}
__device__ __forceinline__ void cv_finish(const CvMats& m, int r, const f32x4 (&v)[8], LAS float* scr, int lane) {
    bf16* WT; int K, N, item; bool blk = false;
    if (r < CV_I_O) { WT = m.WoT; K = DM; N = DM; item = r; } else if (r < CV_I_O + CV_I_1) { WT = m.W1T; K = DM; N = DFF; item = r - CV_I_O; } else { WT = m.W2T; K = DFF; N = DM; item = r - CV_I_O - CV_I_1; blk = true; }
    const int nblk = N / 32, kb = item / nblk, nb = item % nblk, k0 = 64 * kb, n0 = 32 * nb;
#pragma unroll
    for (int i = 0; i < 8; ++i) { LAS float* d = scr + (8 * i + (lane >> 3)) * 33 + 4 * (lane & 7); d[0] = v[i].x; d[1] = v[i].y; d[2] = v[i].z; d[3] = v[i].w; }
    LDS_WAIT(); asm volatile("" ::: "memory");
    const int c = lane & 7;
#pragma unroll
    for (int j = 0; j < 4; ++j) { const int n = (lane >> 3) + 8 * j; const LAS float* s = scr + (8 * c) * 33 + n;
        v4u o; o.x = pk2(s[0 * 33], s[1 * 33]); o.y = pk2(s[2 * 33], s[3 * 33]); o.z = pk2(s[4 * 33], s[5 * 33]); o.w = pk2(s[6 * 33], s[7 * 33]);
        const int row = n0 + n;
        if (blk) __builtin_nontemporal_store(o, (GAS v4u*)((GAS char*)WT + ((size_t)(row >> 8) * (K / 64) + kb) * 32768 + (row & 255) * 128 + 16 * c));
        else __builtin_nontemporal_store(o, (GAS v4u*)(WT + (size_t)row * K + k0 + 8 * c)); }
    LDS_WAIT(); asm volatile("" ::: "memory");
}
struct Args { const float* in[11]; float* out; unsigned char* ws; float lg[8]; int ph_lo, ph_hi, li, pad; };
#define LGSEL(h) ((h) == 0 ? args.lg[0] : (h) == 1 ? args.lg[1] : (h) == 2 ? args.lg[2] : (h) == 3 ? args.lg[3] : (h) == 4 ? args.lg[4] : (h) == 5 ? args.lg[5] : (h) == 6 ? args.lg[6] : args.lg[7])

__global__ void __launch_bounds__(NWAVES * 64, 2) hymba_fwd(Args args) {
    extern __shared__ __attribute__((aligned(16))) unsigned char lds[];
    Frame F;
    F.lds = (LAS unsigned char*)lds;
    F.MISC = (volatile LAS unsigned*)(F.lds + MISC_OFF);
    F.tid = threadIdx.x; F.lane = F.tid & 63; F.wave = __builtin_amdgcn_readfirstlane(F.tid >> 6);
    F.G = gridDim.x; { const int bx = blockIdx.x; F.vcu = (F.G % 8 == 0) ? (bx % 8) * (F.G / 8) + bx / 8 : bx; }
    unsigned char* ws = args.ws;
    F.ctl = (gu32*)(ws + WS_CTL);
    const float* x = args.in[0]; const float* g1 = args.in[1]; const float* w_in = args.in[2]; const float* gn = args.in[3];
    const float* qg = args.in[4]; const float* kg = args.in[5]; const float* relb = args.in[6]; const float* w_out = args.in[7];
    const float* g2 = args.in[8]; const float* w1 = args.in[9]; const float* w2 = args.in[10];
    float* out = args.out;
    bf16* WinT = (bf16*)(ws + WS_WINT); bf16* WoT = (bf16*)(ws + WS_WOT); bf16* W1T = (bf16*)(ws + WS_W1T); bf16* W2T = (bf16*)(ws + WS_W2T);
    bf16* MIX = (bf16*)(ws + WS_MIX); bf16* PROJ = (bf16*)(ws + WS_PROJ); bf16* PREV = (bf16*)(ws + WS_PREV); bf16* X1B = (bf16*)(ws + WS_X1B);
    float* CS = (float*)(ws + WS_CS); float* ROWSS = (float*)(ws + WS_ROWSS); bf16* U = (bf16*)(ws + WS_U);
    bf16* XN = (bf16*)((unsigned char*)out + OUT_XN); bf16* CONTRIB = (bf16*)((unsigned char*)out + OUT_CONTRIB);

    for (int u = F.tid; u < (LDS_BYTES - LDSCTL_OFF) / 4; u += NWAVES * 64) ((LAS unsigned*)(F.lds + LDSCTL_OFF))[u] = 0u;
    __syncthreads();
    XcdBarrier bar; bar.bar = (unsigned*)(F.ctl + CW_BAR); bar.x = 0; bar.st = nullptr;
    if (N_LAUNCHES != PER_PHASE) bar = xcd_barrier_post((unsigned*)(F.ctl + CW_BAR), F.MISC + 8);
#define GRID_BAR(seam) do { if (N_LAUNCHES == PER_PHASE) { if (F.tid == 0) __hip_atomic_store(F.ctl + CW_TMO, 0xBADBA0u | (unsigned)(seam), RLX_AGENT); } \
    else { xcd_barrier(bar); } } while (0)
    const int lo = args.ph_lo, hi = args.ph_hi;
#if PROBE_T
#define TSTAMP(k) do { if (blockIdx.x == 0 && F.tid == 0) { const unsigned long long t_ = __builtin_amdgcn_s_memrealtime(); F.MISC[32 + 2 * (k)] = (unsigned)t_; F.MISC[33 + 2 * (k)] = (unsigned)(t_ >> 32); } } while (0)
#else
#define TSTAMP(k) do { } while (0)
#endif
    TSTAMP(0);
#define IN(k) (lo <= (k) && (k) < hi)
#define BOTH(k) (IN(k) && IN((k) + 1))
    const int gw = F.vcu * NWAVES + F.wave, NGW = F.G * NWAVES;

    constexpr int I_IN = (DM / 64) * (NIN / 32), I_O = (DM / 64) * (DM / 32), I_1 = (DM / 64) * (DFF / 32), I_2 = (DFF / 64) * (DM / 32), NCONV = I_O + I_1 + I_2;
#define CONV_PULL(k) do { if (conv_lo[(k) + 1] > conv_lo[(k)]) { LAS float* scr_ = (LAS float*)(F.lds + RING_OFF + F.wave * 16384); const int lo_ = conv_lo[(k)], n_ = conv_lo[(k) + 1] - lo_; \
        for (;;) { __syncthreads();                                     \
            if (F.tid == 0) { unsigned t_ = __hip_atomic_load(F.ctl + CW_CONV + 64 * (k), RLX_AGENT); if ((int)t_ < n_) t_ = __hip_atomic_fetch_add(F.ctl + CW_CONV + 64 * (k), (unsigned)(8 * CV_PW), RLX_AGENT); F.MISC[16] = t_; } \
            __syncthreads(); const int b_ = (int)F.MISC[16]; if (b_ >= n_) break; \
            const int i0_ = b_ + F.wave * CV_PW, ne_ = (n_ - i0_) < CV_PW ? (n_ - i0_) : CV_PW;       \
            if (ne_ > 0) { f32x4 va_[8], vb_[8]; cv_load(cvm, lo_ + i0_, va_, F.lane); \
                for (int j_ = 0; j_ < ne_; j_ += 2) { if (j_ + 1 < ne_) cv_load(cvm, lo_ + i0_ + j_ + 1, vb_, F.lane); cv_finish(cvm, lo_ + i0_ + j_, va_, scr_, F.lane); \
                    if (j_ + 2 < ne_) cv_load(cvm, lo_ + i0_ + j_ + 2, va_, F.lane); if (j_ + 1 < ne_) cv_finish(cvm, lo_ + i0_ + j_ + 1, vb_, scr_, F.lane); } } } } } while (0)
    constexpr int conv_lo[5] = {0, CONV_C1, CONV_C2, CONV_C3, NCONV};
    const CvMats cvm{w_out, w1, w2, WoT, W1T, W2T, g2};

    if (IN(0)) { REPS(0) {
        LAS float* scr = (LAS float*)(F.lds + RING_OFF + F.wave * 16384);
        {
            f32x4 va[8], vb[8]; int it = gw;
            if (it < I_IN) tr_load(w_in, NIN, it, va, F.lane);
            for (; it < I_IN; it += 2 * NGW) { const int it2 = it + NGW, it3 = it + 2 * NGW;
                if (it2 < I_IN) tr_load(w_in, NIN, it2, vb, F.lane);
                tr_finish<true>(WinT, DM, NIN, it, va, scr, F.lane);
                if (it3 < I_IN) tr_load(w_in, NIN, it3, va, F.lane);
                if (it2 < I_IN) tr_finish<true>(WinT, DM, NIN, it2, vb, scr, F.lane); }
        }
        {
            const GAS f32x4* gr = (const GAS f32x4*)g1 + F.lane;
            f32x4 va[8], vb[8]; int m = gw;
#define XN_LOAD(V, mm) do { const GAS f32x4* xr_ = (const GAS f32x4*)(x + (size_t)(mm) * DM) + F.lane; _Pragma("unroll") for (int j = 0; j < 8; ++j) V[j] = __builtin_nontemporal_load(&xr_[64 * j]); } while (0)
#define XN_FIN(V, mm) do { float s_ = 0.f; _Pragma("unroll") for (int j = 0; j < 8; ++j) s_ += (V[j].x * V[j].x + V[j].y * V[j].y) + (V[j].z * V[j].z + V[j].w * V[j].w); \
            const float rstd_ = 1.f / sqrtf(wave_sum(s_) * (1.f / DM) + EPS); GAS unsigned long long* o8_ = (GAS unsigned long long*)(XN + (size_t)(mm) * DM) + F.lane; \
            _Pragma("unroll") for (int j = 0; j < 8; ++j) { const f32x4 g_ = gr[64 * j]; const f32x4 y_ = V[j] * rstd_ * g_; \
                o8_[64 * j] = (unsigned long long)pk2(y_.x, y_.y) | ((unsigned long long)pk2(y_.z, y_.w) << 32); } } while (0)
            if (m < M) XN_LOAD(va, m);
            for (; m < M; m += 2 * NGW) { const int m2 = m + NGW, m3 = m + 2 * NGW;
                if (m2 < M) XN_LOAD(vb, m2);
                XN_FIN(va, m);
                if (m3 < M) XN_LOAD(va, m3);
                if (m2 < M) XN_FIN(vb, m2); }
#undef XN_LOAD
#undef XN_FIN
        }
        for (int i = (F.vcu * NWAVES * 64) + F.tid; i < (SEQ + 1) * 64; i += F.G * NWAVES * 64) {
            const int pos = (i >> 6) == SEQ ? 16 : (i >> 6), p = i & 63;
            const float invf = __builtin_amdgcn_exp2f(-(float)p * 0.20762050593046014f);
            const double rev = (double)pos * (double)invf * 0.15915494309189535;
            const float fr = (float)(rev - __builtin_floor(rev));
            float* dst = ((i >> 6) == SEQ) ? (float*)(ws + WS_CSSTEP) + 2 * p : CS + 2 * i;
            dst[0] = __builtin_amdgcn_cosf(fr); dst[1] = __builtin_amdgcn_sinf(fr);
        }
        }
        for (int eb = 0; eb < PROBE_EXTRA_BARS; ++eb) GRID_BAR(0);
        if (BOTH(0)) GRID_BAR(0);
        TSTAMP(1);
    }

    if (IN(1)) { REPS(1) {
        const int GG = (F.G > 64) ? F.G - CONV_WGS : F.G;
        if ((int)blockIdx.x < GG) {
        pg8::Gemm g{XN, WinT, M, NIN, DM}; pg8::StaticOrder S; S.init(M, NIN, GG, (int)blockIdx.x, WGM_P1);
        pg8::EpiProj E{PROJ, CS, (const float*)(ws + WS_CSSTEP), qg, kg, (LAS float*)(F.lds + XCH_OFF), -1};
        pg8::gemm_phase<pg8::EpiProj, pg8::StaticOrder, true, true>(F.lds + RING_OFF, g, S, E);
        }
        CONV_PULL(0);
        }
        if (BOTH(1)) GRID_BAR(1);
        TSTAMP(2);
    }

    if (IN(2)) { REPS(2) {
        for (int u = F.vcu; u < BATCH * NH * (NCH / 4); u += F.G)
            att::attn_unit(u >> 7, (u >> 4) & 7, u & 15, PROJ, relb, MIX, (char*)lds + RING_OFF);
#if NAIVE_CONTRIB
        for (int unit = F.vcu; unit < BATCH * NH * NCH; unit += F.G) {
            const int n = unit & 63, h = (unit >> 6) & 7, b = unit >> 9;
            const int dv = F.tid >> 2, dk0 = (F.tid & 3) * 32;
            const float lgh = LGSEL(h);
            float acc[32];
#pragma unroll
            for (int q = 0; q < 32; ++q) acc[q] = 0.f;
            const bf16* base = PROJ + (size_t)(b * SEQ + n * CH) * NIN + h * HD;
            for (int j = 0; j < CH; ++j) {
                const float kd = __builtin_amdgcn_exp2f(lgh * LOG2E * (float)(CH - 1 - j));
                const float vv = bf_lo((unsigned)base[(size_t)j * NIN + SEC_RV + dv]) * kd;
                const GAS v4u* kr = (const GAS v4u*)(base + (size_t)j * NIN + SEC_RK + dk0);
#pragma unroll
                for (int c = 0; c < 4; ++c) { const v4u k4 = kr[c];
                    acc[8 * c + 0] += vv * bf_lo(k4.x); acc[8 * c + 1] += vv * bf_hi(k4.x); acc[8 * c + 2] += vv * bf_lo(k4.y); acc[8 * c + 3] += vv * bf_hi(k4.y);
                    acc[8 * c + 4] += vv * bf_lo(k4.z); acc[8 * c + 5] += vv * bf_hi(k4.z); acc[8 * c + 6] += vv * bf_lo(k4.w); acc[8 * c + 7] += vv * bf_hi(k4.w); }
            }
            GAS v4u* o = (GAS v4u*)(CONTRIB + (size_t)unit * (HD * HD) + dv * HD + dk0);
#pragma unroll
            for (int c = 0; c < 4; ++c) { v4u w; w.x = pk2(acc[8 * c], acc[8 * c + 1]); w.y = pk2(acc[8 * c + 2], acc[8 * c + 3]); w.z = pk2(acc[8 * c + 4], acc[8 * c + 5]); w.w = pk2(acc[8 * c + 6], acc[8 * c + 7]); o[c] = w; }
        }
#else
        for (int u = F.vcu; u < BATCH * NH * (NCH / 4); u += F.G) {
            const int h = (u >> 4) & 7;
            att::contrib_unit(u >> 7, h, u & 15, PROJ, CONTRIB, (char*)lds + RING_OFF, LGSEL(h) * LOG2E);
        }
#endif
        CONV_PULL(1);
        }
        if (BOTH(2)) GRID_BAR(2);
        TSTAMP(3);
    }

    if (IN(3)) { REPS(3) {
        for (int e2 = F.vcu * (NWAVES * 64) + F.tid; e2 < BATCH * NH * HD * HD / 2; e2 += F.G * NWAVES * 64) {
            const int bh = e2 >> 13, idx2 = e2 & 8191, h = bh & 7;
            const float dec = __builtin_amdgcn_exp2f(LGSEL(h) * LOG2E * (float)CH);
            const GAS unsigned* cin = (const GAS unsigned*)CONTRIB + (size_t)bh * NCH * (HD * HD / 2) + idx2;
            GAS unsigned* pout = (GAS unsigned*)PREV + (size_t)bh * NCH * (HD * HD / 2) + idx2;
            float s0 = 0.f, s1 = 0.f;
#pragma unroll 1
            for (int nb = 0; nb < NCH; nb += 16) {
                unsigned c[16];
#pragma unroll
                for (int k = 0; k < 16; ++k) c[k] = cin[(size_t)(nb + k) * (HD * HD / 2)];
#pragma unroll
                for (int k = 0; k < 16; ++k) { pout[(size_t)(nb + k) * (HD * HD / 2)] = pk2(s0, s1); s0 = dec * s0 + bf_lo(c[k]); s1 = dec * s1 + bf_hi(c[k]); }
            }
        }
        CONV_PULL(2);
        }
        if (BOTH(3)) GRID_BAR(3);
        TSTAMP(4);
    }

    if (IN(4)) { REPS(4) {
#if NAIVE_RETOUT
        LAS float* sl = (LAS float*)(F.lds + RING_OFF + F.wave * 4096);
        LAS float* ql = sl + 64;
        for (int t0 = gw * 32; t0 < M * NH; t0 += NGW * 32) {
            for (int tt = 0; tt < 32; ++tt) {
                const int t = t0 + tt;
                const int i = t & 63, n = (t >> 6) & 63, h = (t >> 12) & 7, b = t >> 15;
                const int r = b * SEQ + n * CH + i; const int unit = (b * NH + h) * NCH + n;
                const float lgh = LGSEL(h) * LOG2E;
                unsigned qp[64];
                { const GAS v4u* qrow = (const GAS v4u*)(PROJ + (size_t)r * NIN + SEC_RQ + h * HD);
#pragma unroll
                  for (int c = 0; c < 16; ++c) { const v4u q4 = qrow[c]; qp[4 * c] = q4.x; qp[4 * c + 1] = q4.y; qp[4 * c + 2] = q4.z; qp[4 * c + 3] = q4.w; } }
                { const unsigned q2 = *((const GAS unsigned*)(PROJ + (size_t)r * NIN + SEC_RQ + h * HD) + F.lane); ql[2 * F.lane] = bf_lo(q2); ql[2 * F.lane + 1] = bf_hi(q2); }
                {
                    const GAS v4u* krow = (const GAS v4u*)(PROJ + (size_t)(b * SEQ + n * CH + F.lane) * NIN + SEC_RK + h * HD);
                    float s = 0.f;
#pragma unroll
                    for (int c = 0; c < 16; ++c) { const v4u k4 = krow[c];
                        s += bf_lo(k4.x) * bf_lo(qp[4 * c]) + bf_hi(k4.x) * bf_hi(qp[4 * c]);
                        s += bf_lo(k4.y) * bf_lo(qp[4 * c + 1]) + bf_hi(k4.y) * bf_hi(qp[4 * c + 1]);
                        s += bf_lo(k4.z) * bf_lo(qp[4 * c + 2]) + bf_hi(k4.z) * bf_hi(qp[4 * c + 2]);
                        s += bf_lo(k4.w) * bf_lo(qp[4 * c + 3]) + bf_hi(k4.w) * bf_hi(qp[4 * c + 3]); }
                    const int dist = i > F.lane ? i - F.lane : F.lane - i;
                    sl[F.lane] = s * __builtin_amdgcn_exp2f(lgh * (float)dist);
                }
                LDS_WAIT(); asm volatile("" ::: "memory");
                float y0 = 0.f, y1 = 0.f;
                { const GAS unsigned* vb = (const GAS unsigned*)(PROJ + (size_t)(b * SEQ + n * CH) * NIN + SEC_RV + h * HD) + F.lane;
#pragma unroll 8
                  for (int j = 0; j < CH; ++j) { const float s = sl[j]; const unsigned v2 = vb[(size_t)j * (NIN / 2)]; y0 += s * bf_lo(v2); y1 += s * bf_hi(v2); } }
                {
                    const float qdec = __builtin_amdgcn_exp2f(lgh * (float)(i + 1));
                    const GAS v4u* pa = (const GAS v4u*)(PREV + (size_t)unit * (HD * HD) + (2 * F.lane) * HD);
                    float c0 = 0.f, c1 = 0.f;
#pragma unroll 4
                    for (int c = 0; c < 16; ++c) { const v4u a4 = pa[c], b4 = pa[16 + c]; const LAS float* q8 = ql + 8 * c;
                        c0 += bf_lo(a4.x) * q8[0] + bf_hi(a4.x) * q8[1] + bf_lo(a4.y) * q8[2] + bf_hi(a4.y) * q8[3] + bf_lo(a4.z) * q8[4] + bf_hi(a4.z) * q8[5] + bf_lo(a4.w) * q8[6] + bf_hi(a4.w) * q8[7];
                        c1 += bf_lo(b4.x) * q8[0] + bf_hi(b4.x) * q8[1] + bf_lo(b4.y) * q8[2] + bf_hi(b4.y) * q8[3] + bf_lo(b4.z) * q8[4] + bf_hi(b4.z) * q8[5] + bf_lo(b4.w) * q8[6] + bf_hi(b4.w) * q8[7]; }
                    y0 += qdec * c0; y1 += qdec * c1;
                }
                const float mu = wave_sum(y0 + y1) * (1.f / HD);
                const float d0 = y0 - mu, d1 = y1 - mu;
                const float var = wave_sum(d0 * d0 + d1 * d1) * (1.f / HD);
                const float rs = 1.f / sqrtf(var + GN_EPS);
                const float ga = gn[h * HD + 2 * F.lane], gb = gn[h * HD + 2 * F.lane + 1];
                const unsigned sg = *((const GAS unsigned*)(PROJ + (size_t)r * NIN + SEC_RG + h * HD) + F.lane);
                *((GAS unsigned*)(MIX + (size_t)r * DM + h * HD) + F.lane) = pk2(d0 * rs * ga * bf_lo(sg), d1 * rs * gb * bf_hi(sg));
                LDS_WAIT(); asm volatile("" ::: "memory");
            }
        }
#else
        for (int u = F.vcu; u < BATCH * NH * (NCH / 4); u += F.G) {
            const int h = (u >> 4) & 7;
            att::retout_unit(u >> 7, h, u & 15, PROJ, PREV, gn, MIX, (char*)lds + RING_OFF, (float*)((char*)lds + XCH_OFF), LGSEL(h) * LOG2E);
        }
#endif
        CONV_PULL(3);
        }
        if (BOTH(4)) GRID_BAR(4);
        TSTAMP(5);
    }

    if (IN(5)) { REPS(5) {
        pg8::Gemm g{MIX, WoT, M, DM, DM}; pg8::StaticOrder S; S.init(M, DM, F.G, (int)blockIdx.x, WGM_P5);
        pg8::EpiOut E{x, X1B, ROWSS, DM};
        pg8::gemm_phase<pg8::EpiOut, pg8::StaticOrder, true, true>(F.lds + RING_OFF, g, S, E);
        }
        if (BOTH(5)) GRID_BAR(5);
        TSTAMP(6);
    }

    if (IN(6)) { REPS(6) {
        pg8::Gemm g{X1B, W1T, M, DFF, DM}; pg8::StaticOrder S; S.init(M, DFF, F.G, (int)blockIdx.x, WGM_P6);
        pg8::EpiRelu2 E{U, DFF};
        pg8::gemm_phase<pg8::EpiRelu2, pg8::StaticOrder, true, true>(F.lds + RING_OFF, g, S, E);
        }
        if (BOTH(6)) GRID_BAR(6);
        TSTAMP(7);
    }

    if (IN(7)) {
        pg8::Gemm g{U, W2T, M, DM, DFF}; pg8::StaticOrder S; S.init(M, DM, F.G, (int)blockIdx.x, WGM_P7);
        LAS float* r2l = (LAS float*)(F.lds + XCH_OFF);
        pg8::Unit u0; u0.pm = -1; u0.pn = 0;
        { if (S.next(0, u0) && F.tid < 256) { const GAS f32x4* rs = (const GAS f32x4*)(ROWSS + (size_t)(u0.pm * 256 + F.tid) * 32); f32x4 s4 = rs[0];
#pragma unroll
            for (int j = 1; j < 8; ++j) s4 += rs[j];
            r2l[F.tid] = 1.0f / (((s4[0] + s4[1]) + (s4[2] + s4[3])) * (1.0f / DM) + EPS); }
          __syncthreads(); }
        pg8::EpiFinal E{out, r2l, DM, ROWSS, u0.pm, X1B};
        pg8::gemm_phase<pg8::EpiFinal, pg8::StaticOrder, true, true, true>(F.lds + RING_OFF, g, S, E);
    }
#if PROBE_T
    if (IN(7)) { GRID_BAR(7); TSTAMP(8);
        if (blockIdx.x == 0 && F.tid == 0) {
            const unsigned long long ta = ((unsigned long long)F.MISC[33 + 2 * PROBE_TA] << 32) | F.MISC[32 + 2 * PROBE_TA], tb = ((unsigned long long)F.MISC[33 + 2 * PROBE_TB] << 32) | F.MISC[32 + 2 * PROBE_TB];
#if PROBE_TTHR
            out[0] += ((double)(tb - ta) * 0.01 > (double)PROBE_TTHR) ? 64.f : 32.f;
#else
            out[0] += (float)(PROBE_TQ * (int)((double)(tb - ta) * 0.01 / PROBE_TQ)) - (float)PROBE_TOFF;
#endif
        } }
#endif
#if PROBE_X
    if (IN(8)) {
#if PROBE_X == 1
        pg8::Gemm g{U, W2T, M, DM, DFF}; pg8::StaticOrder S; S.init(M, DM, F.G, (int)blockIdx.x);
        pg8::EpiNull E{ROWSS};
        pg8::gemm_phase<pg8::EpiNull, pg8::StaticOrder, true, true, true>(F.lds + RING_OFF, g, S, E);
#elif PROBE_X == 2
        pg8::Gemm g{U, W2T, M, DM, DFF}; pg8::StaticOrderA0 S; S.init(M, DM, F.G, (int)blockIdx.x);
        pg8::EpiNull E{ROWSS};
        pg8::gemm_phase<pg8::EpiNull, pg8::StaticOrderA0, true, true, true>(F.lds + RING_OFF, g, S, E);
#elif PROBE_X == 3
        pg8::Gemm g{X1B, W1T, M, DFF, DM}; pg8::StaticOrder S; S.init(M, DFF, F.G, (int)blockIdx.x);
        pg8::EpiNull E{ROWSS};
        pg8::gemm_phase<pg8::EpiNull, pg8::StaticOrder, true, true>(F.lds + RING_OFF, g, S, E);
#elif PROBE_X == 5
        pg8::Gemm g{U, W2T, M, DM, DFF}; pg8::StaticOrder S; S.init(M, DM, F.G, (int)blockIdx.x);
        LAS float* r2l = (LAS float*)(F.lds + XCH_OFF); pg8::Unit u0; u0.pm = -1; u0.pn = 0; S.next(0, u0);
        if (F.tid < 256) r2l[F.tid] = 0.f;
        __syncthreads();
        pg8::EpiFinal E{out, r2l, DM, ROWSS, u0.pm, X1B};
        pg8::gemm_phase<pg8::EpiFinal, pg8::StaticOrder, true, true, true>(F.lds + RING_OFF, g, S, E);
#elif PROBE_X == 6
        pg8::Gemm g{X1B, W1T, M, DFF, DM}; pg8::StaticOrder S; S.init(M, DFF, F.G, (int)blockIdx.x);
        pg8::EpiNull E{ROWSS};
        pg8::gemm_phase<pg8::EpiNull, pg8::StaticOrder, true, true, true>(F.lds + RING_OFF, g, S, E);
#elif PROBE_X == 7
        for (int u = F.vcu; u < BATCH * NH * (NCH / 4); u += F.G) att::attn_unit(u >> 7, (u >> 4) & 7, u & 15, PROJ, relb, MIX, (char*)lds + RING_OFF);
#elif PROBE_X == 8
        for (int u = F.vcu; u < BATCH * NH * (NCH / 4); u += F.G) { const int h = (u >> 4) & 7; att::contrib_unit(u >> 7, h, u & 15, PROJ, CONTRIB, (char*)lds + RING_OFF, LGSEL(h) * LOG2E); }
#elif PROBE_X >= 20 && PROBE_X <= 22
        for (int u = F.vcu; u < BATCH * NH * (NCH / 4); u += F.G) { const int h = (u >> 4) & 7; att::retout_unit<PROBE_X - 20>(u >> 7, h, u & 15, PROJ, PREV, gn, CONTRIB, (char*)lds + RING_OFF, (float*)((char*)lds + XCH_OFF), LGSEL(h) * LOG2E); }
#elif PROBE_X == 9
        for (int u = F.vcu; u < BATCH * NH * (NCH / 4); u += F.G) { const int h = (u >> 4) & 7; att::retout_unit(u >> 7, h, u & 15, PROJ, PREV, gn, MIX, (char*)lds + RING_OFF, (float*)((char*)lds + XCH_OFF), LGSEL(h) * LOG2E); }
#elif PROBE_X == 10
        if ((int)blockIdx.x < F.G - CONV_WGS) { pg8::Gemm g{XN, WinT, M, NIN, DM}; pg8::StaticOrder S; S.init(M, NIN, F.G - CONV_WGS, (int)blockIdx.x);
            pg8::EpiNull E{ROWSS};
            pg8::gemm_phase<pg8::EpiNull, pg8::StaticOrder, true, true>(F.lds + RING_OFF, g, S, E); }
#elif PROBE_X >= 11 && PROBE_X <= 14
        if ((int)blockIdx.x < F.G - CONV_WGS) { pg8::Gemm g{XN, WinT, M, NIN, DM}; pg8::StaticOrder S; S.init(M, NIN, F.G - CONV_WGS, (int)blockIdx.x);
            pg8::EpiProj E{PROJ, CS, (const float*)(ws + WS_CSSTEP), qg, kg, (LAS float*)(F.lds + XCH_OFF), PROBE_X == 11 ? -1 : PROBE_X == 12 ? 2 : PROBE_X == 13 ? 0 : 4};
            pg8::gemm_phase<pg8::EpiProj, pg8::StaticOrder, true, true>(F.lds + RING_OFF, g, S, E); }
#elif PROBE_X == 4
        pg8::Gemm g{U, W2T, M, DM, DFF}; pg8::StaticOrder S; S.init(M, DM, F.G, (int)blockIdx.x);
        pg8::EpiNull E{ROWSS};
        pg8::gemm_phase<pg8::EpiNull, pg8::StaticOrder, true, false, true>(F.lds + RING_OFF, g, S, E);
#endif
    }
#endif
#undef IN
#undef BOTH
}

extern "C" void kernel_launch(void* const* d_in, const int* in_sizes, int n_in, void* d_out, int out_size, void* d_ws, size_t ws_size, hipStream_t stream) {
    static int grid = 0;
    if (grid == 0) {
        if (n_in != 11 || in_sizes[0] != M * DM || out_size != M * DM || ws_size < WS_END) { fprintf(stderr, "kernel_launch: shape/workspace mismatch: n_in %d in0 %d out %d ws %zu (need %zu)\n", n_in, n_in > 0 ? in_sizes[0] : -1, out_size, ws_size, (size_t)WS_END); grid = -1; return; }
        int dev = 0, cus = 0, per_cu = 0;
        if (hipGetDevice(&dev) != hipSuccess || hipDeviceGetAttribute(&cus, hipDeviceAttributeMultiprocessorCount, dev) != hipSuccess) { fprintf(stderr, "kernel_launch: device query failed\n"); grid = -1; return; }
        if (hipFuncSetAttribute((const void*)hymba_fwd, hipFuncAttributeMaxDynamicSharedMemorySize, LDS_BYTES) != hipSuccess) { fprintf(stderr, "kernel_launch: hipFuncSetAttribute failed\n"); grid = -1; return; }
        if (hipOccupancyMaxActiveBlocksPerMultiprocessor(&per_cu, (const void*)hymba_fwd, NWAVES * 64, LDS_BYTES) != hipSuccess || per_cu < 1)
            fprintf(stderr, "kernel_launch: note: occupancy query reports %d workgroups per CU\n", per_cu);
        (void)hipGetLastError();
        grid = cus;
    }
    if (grid < 0) return;
    if (hipMemsetAsync((char*)d_ws + WS_CTL, 0, CTL_ZERO_BYTES, stream) != hipSuccess) { fprintf(stderr, "kernel_launch: hipMemsetAsync failed\n"); return; }
    Args a{};
    for (int i = 0; i < 11; ++i) a.in[i] = (const float*)d_in[i];
    a.out = (float*)d_out; a.ws = (unsigned char*)d_ws;
    for (int h = 0; h < 8; ++h) a.lg[h] = (float)log1p(-exp2(-(5.0 + (double)h)));
    for (int li = 0; li < N_LAUNCHES; ++li) {
        a.ph_lo = (N_LAUNCHES == PER_PHASE) ? li : 0; a.ph_hi = (N_LAUNCHES == PER_PHASE) ? li + 1 : PER_PHASE; a.li = li;
        const int nrep = (N_LAUNCHES == PER_PHASE && ((PROBE_REPEAT_MASK >> li) & 1)) ? 2 : 1;
        for (int rep = 0; rep < nrep; ++rep) hipLaunchKernelGGL(hymba_fwd, dim3(grid), dim3(NWAVES * 64), LDS_BYTES, stream, a);
#if PROBE_X
        if (N_LAUNCHES == PER_PHASE && li == ((PROBE_X == 5 || (PROBE_X >= 11 && PROBE_X <= 14)) ? 7 : (PROBE_X == 7 || PROBE_X == 8) ? 2 : (PROBE_X == 9 || (PROBE_X >= 20 && PROBE_X <= 22)) ? 4 : PROBE_X == 10 ? 1 : 6)) { Args ax = a; ax.ph_lo = 8; ax.ph_hi = 9; for (int rep = 0; rep < PROBE_XN; ++rep) hipLaunchKernelGGL(hymba_fwd, dim3(grid), dim3(NWAVES * 64), LDS_BYTES, stream, ax); }
#endif
        const hipError_t le = hipPeekAtLastError();
        if (le != hipSuccess) { fprintf(stderr, "kernel_launch: launch %d failed: %s\n", li, hipGetErrorName(le)); break; }
    }
}
```

```cpp
#include <hip/hip_runtime.h>
#include <cstdio>
#include <cstdint>
#include <cmath>
namespace pg8 {
#define PG8_LAS __attribute__((address_space(3)))
typedef unsigned short bf16_t;
typedef short bf16x8 __attribute__((ext_vector_type(8)));
typedef float f32x4 __attribute__((ext_vector_type(4)));
typedef unsigned u32x4 __attribute__((ext_vector_type(4)));
constexpr int BM = 256, BK = 64, HALF = 128, HTB = HALF * BK * 2  , STAGE_BYTES = 8 * HTB, NXCD = 8, WGM = 8;

__host__ __device__ __forceinline__ int lds_byte(int r, int c) { const int st = (r >> 4) * 2 + (c >> 5), rr = r & 15, cc = c & 31, ob = rr * 64 + cc * 2; return st * 1024 + (ob ^ (((ob >> 9) & 1) << 5)); }
__host__ __device__ __forceinline__ void stage_rc(int b, int& R, int& C) { const int st = b / 1024, sb = b % 1024, swz = sb ^ (((sb >> 9) & 1) << 5); R = (st >> 1) * 16 + swz / 64; C = (st & 1) * 32 + (swz % 64) / 2; }
__host__ __device__ __forceinline__ int perm32(int rho) { const int n = rho >> 4, i = rho & 15; return 8 * (i >> 2) + 4 * n + (i & 3); }

struct Unit { int pm, pn; };
struct Gemm { const bf16_t* A; const bf16_t* Bt; int M, N, K; };

struct StaticOrder {
    int nM, nN, nwg, G, c, wgm;
    __host__ __device__ void init(int M, int N, int G_, int c_, int wgm_ = WGM) { nM = M / BM; nN = N / BM; nwg = nM * nN; G = G_; c = c_; wgm = wgm_; }
    __host__ __device__ bool next(int i, Unit& u) const {
        const long L = (long)i * G + c; if (L >= nwg) return false;
        int wgid = (int)L; { const int q = nwg / NXCD, r = nwg % NXCD, xcd = wgid % NXCD, off = wgid / NXCD; wgid = (xcd < r ? xcd * (q + 1) : r * (q + 1) + (xcd - r) * q) + off; }
        const int nig = wgm * nN, gid = wgid / nig, fm = gid * wgm, gsz = (nM - fm) < wgm ? (nM - fm) : wgm;
        u.pm = fm + ((wgid % nig) % gsz); u.pn = (wgid % nig) / gsz; return true;
    }
    __device__ __forceinline__ void a_ready(const Unit&) const {}
    __device__ __forceinline__ void done(const Unit&) const {}
};

typedef float f32x2c_t __attribute__((ext_vector_type(2))); typedef __bf16 bf16x2c_t __attribute__((ext_vector_type(2)));
__device__ __forceinline__ unsigned cvt_pk_bf16(float lo, float hi) { f32x2c_t v = {lo, hi}; bf16x2c_t b = __builtin_convertvector(v, bf16x2c_t); return __builtin_bit_cast(unsigned, b); }
typedef float f32x2 __attribute__((ext_vector_type(2)));
#ifndef SC1_PROJ
#define SC1_PROJ 0
#endif
#ifndef SC1_X1B
#define SC1_X1B 0
#endif
#ifndef SC1_U
#define SC1_U 0
#endif
#ifndef SC1_OUT
#define SC1_OUT 0
#endif
template <int SC1, class V> __device__ __forceinline__ void st16(void* p, V w) {
    if constexpr (SC1 == 2) __builtin_nontemporal_store(w, (V*)p);
    else if constexpr (SC1 == 1) asm volatile("global_store_dwordx4 %0, %1, off sc1\n\ts_nop 1" :: "v"(p), "v"(w) : "memory");
    else *(V*)p = w;
}
typedef unsigned u32x2 __attribute__((ext_vector_type(2)));
constexpr int PROJ_LD = 7168;
struct EpiProj {
    static constexpr bool PERM = true, AFTER_DRAIN = false, WIDE = true, PRE = false;
    bf16_t* P; const float* cs; const float* csstep; const float* qg; const float* kg; PG8_LAS float* xch; int force_sec; const float* rstd1;
    __device__ __forceinline__ void operator()(const f32x4 (&acc)[2][2][4][2], const Unit& u, int wr, int wc, int fr, int fq) const {
        const int sec = force_sec >= 0 ? force_sec : (u.pn >> 2);
        const int row0 = u.pm * BM + wr * 64 + fr;
        const int tc0 = wc * 64 + 8 * fq, ch0 = tc0 & 127;
        bf16_t* base = P + (size_t)row0 * PROJ_LD + u.pn * BM;
        float rs[2][4];
#pragma unroll
        for (int ai = 0; ai < 2; ++ai)
#pragma unroll
            for (int m = 0; m < 4; ++m) rs[ai][m] = rstd1[row0 + ai * HALF + m * 16];
        if (sec <= 1) {
            const float ksc = (sec == 1) ? 0.08838834764831845f : 1.0f;
            const int p0 = ch0 >> 1;
            f32x4 cb_[2][2][2], st_[2][2];
#pragma unroll
            for (int bj = 0; bj < 2; ++bj) { const float* sp = csstep + (p0 + 16 * bj) * 2; st_[bj][0] = *(const f32x4*)sp; st_[bj][1] = *(const f32x4*)(sp + 4);
#pragma unroll
                for (int ai = 0; ai < 2; ++ai) { const int pos = (row0 + ai * HALF) & 4095; const float* cp = cs + ((size_t)pos * 64 + p0 + 16 * bj) * 2;
                    cb_[ai][bj][0] = *(const f32x4*)cp; cb_[ai][bj][1] = *(const f32x4*)(cp + 4); } }
            asm volatile("" ::: "memory");
#pragma unroll
            for (int ai = 0; ai < 2; ++ai)
#pragma unroll
                for (int m = 0; m < 4; ++m) {
                    bf16_t* rp = base + (size_t)(ai * HALF + m * 16) * PROJ_LD + tc0;
#pragma unroll
                    for (int bj = 0; bj < 2; ++bj) {
                        const f32x4 ca = cb_[ai][bj][0], cb = cb_[ai][bj][1];
                        const float ks_ = ksc * rs[ai][m]; const f32x4 v0 = acc[ai][bj][m][0] * ks_, v1 = acc[ai][bj][m][1] * ks_;
                        const float a0 = v0[0] * ca[0] - v0[1] * ca[1], b0 = v0[0] * ca[1] + v0[1] * ca[0];
                        const float a1 = v0[2] * ca[2] - v0[3] * ca[3], b1 = v0[2] * ca[3] + v0[3] * ca[2];
                        const float a2 = v1[0] * cb[0] - v1[1] * cb[1], b2 = v1[0] * cb[1] + v1[1] * cb[0];
                        const float a3 = v1[2] * cb[2] - v1[3] * cb[3], b3 = v1[2] * cb[3] + v1[3] * cb[2];
                        u32x4 w; w.x = cvt_pk_bf16(a0, b0); w.y = cvt_pk_bf16(a1, b1); w.z = cvt_pk_bf16(a2, b2); w.w = cvt_pk_bf16(a3, b3);
                        st16<SC1_PROJ>(rp + 32 * bj, w);
                        if (m < 3) {
#pragma unroll
                            for (int q = 0; q < 2; ++q) { const f32x4 c = cb_[ai][bj][q], t = st_[bj][q];
                                cb_[ai][bj][q] = (f32x4){c[0] * t[0] - c[1] * t[1], c[1] * t[0] + c[0] * t[1], c[2] * t[2] - c[3] * t[3], c[3] * t[2] + c[2] * t[3]}; }
                        }
                    }
                }
        } else if (sec == 4 || sec == 5) {
            const float* g = (sec == 4) ? qg : kg;
            const float osc = (sec == 4) ? (0.08838834764831845f * 1.4426950408889634f) : 1.0f;
            f32x4 gv[2][2];
#pragma unroll
            for (int bj = 0; bj < 2; ++bj) { gv[bj][0] = *(const f32x4*)(g + ch0 + 32 * bj) * osc; gv[bj][1] = *(const f32x4*)(g + ch0 + 32 * bj + 4) * osc; }
#pragma unroll
            for (int ai = 0; ai < 2; ++ai)
#pragma unroll
                for (int m = 0; m < 4; ++m) {
                    float s = 0.f;
#pragma unroll
                    for (int bj = 0; bj < 2; ++bj) { const f32x4 v0 = acc[ai][bj][m][0], v1 = acc[ai][bj][m][1];
                        s += (v0[0] * v0[0] + v0[1] * v0[1]) + (v0[2] * v0[2] + v0[3] * v0[3]) + (v1[0] * v1[0] + v1[1] * v1[1]) + (v1[2] * v1[2] + v1[3] * v1[3]); }
                    s *= rs[ai][m] * rs[ai][m];
                    s += __shfl_xor(s, 16); s += __shfl_xor(s, 32);
                    if (fq == 0) xch[(ai * HALF + wr * 64 + m * 16 + fr) * 4 + wc] = s;
                }
            asm volatile("s_waitcnt lgkmcnt(0)" ::: "memory"); __builtin_amdgcn_s_barrier(); asm volatile("" ::: "memory");
#pragma unroll
            for (int ai = 0; ai < 2; ++ai)
#pragma unroll
                for (int m = 0; m < 4; ++m) {
                    bf16_t* rp = base + (size_t)(ai * HALF + m * 16) * PROJ_LD + tc0;
                    const PG8_LAS float* xp = xch + (ai * HALF + wr * 64 + m * 16 + fr) * 4 + (wc & 2);
                    const float rstd = rs[ai][m] / sqrtf((xp[0] + xp[1]) * (1.0f / 128.0f) + 1e-6f);
#pragma unroll
                    for (int bj = 0; bj < 2; ++bj) {
                        const f32x4 v0 = acc[ai][bj][m][0] * rstd * gv[bj][0], v1 = acc[ai][bj][m][1] * rstd * gv[bj][1];
                        u32x4 w; w.x = cvt_pk_bf16(v0[0], v0[1]); w.y = cvt_pk_bf16(v0[2], v0[3]); w.z = cvt_pk_bf16(v1[0], v1[1]); w.w = cvt_pk_bf16(v1[2], v1[3]);
                        st16<SC1_PROJ>(rp + 32 * bj, w);
                    }
                }
        } else {
#pragma unroll
            for (int ai = 0; ai < 2; ++ai)
#pragma unroll
                for (int m = 0; m < 4; ++m) {
                    bf16_t* rp = base + (size_t)(ai * HALF + m * 16) * PROJ_LD + tc0;
#pragma unroll
                    for (int bj = 0; bj < 2; ++bj) {
                        f32x4 v0 = acc[ai][bj][m][0] * rs[ai][m], v1 = acc[ai][bj][m][1] * rs[ai][m];
                        if (sec == 3) {
#pragma unroll
                            for (int j = 0; j < 4; ++j) { v0[j] = v0[j] * __builtin_amdgcn_rcpf(1.0f + __builtin_amdgcn_exp2f(-1.4426950408889634f * v0[j]));
                                                          v1[j] = v1[j] * __builtin_amdgcn_rcpf(1.0f + __builtin_amdgcn_exp2f(-1.4426950408889634f * v1[j])); }
                        }
                        u32x4 w; w.x = cvt_pk_bf16(v0[0], v0[1]); w.y = cvt_pk_bf16(v0[2], v0[3]); w.z = cvt_pk_bf16(v1[0], v1[1]); w.w = cvt_pk_bf16(v1[2], v1[3]);
                        st16<SC1_PROJ>(rp + 32 * bj, w);
                    }
                }
        }
    }
};
struct EpiOut {
    static constexpr bool PERM = true, AFTER_DRAIN = false, WIDE = true, PRE = false;
    const bf16_t* xb; bf16_t* X1B; float* rowss; int ldc;
    __device__ __forceinline__ void operator()(const f32x4 (&acc)[2][2][4][2], const Unit& u, int wr, int wc, int fr, int fq) const {
        const int row0 = u.pm * BM + wr * 64 + fr, col0 = u.pn * BM + wc * 64 + 8 * fq;
        u32x4 xv[2][4][2];
#pragma unroll
        for (int ai = 0; ai < 2; ++ai)
#pragma unroll
            for (int m = 0; m < 4; ++m)
#pragma unroll
                for (int bj = 0; bj < 2; ++bj) xv[ai][m][bj] = __builtin_nontemporal_load((const u32x4*)(xb + (size_t)(row0 + ai * HALF + m * 16) * ldc + col0 + bj * 32));
        asm volatile("" ::: "memory");
#pragma unroll
        for (int ai = 0; ai < 2; ++ai) {
#pragma unroll
            for (int m = 0; m < 4; ++m) {
                const int r = row0 + ai * HALF + m * 16; float ss = 0.f;
#pragma unroll
                for (int bj = 0; bj < 2; ++bj) {
                    const size_t off = (size_t)r * ldc + col0 + bj * 32; const u32x4 w = xv[ai][m][bj];
                    const f32x4 x0 = {__uint_as_float(w.x << 16), __uint_as_float(w.x & 0xffff0000u), __uint_as_float(w.y << 16), __uint_as_float(w.y & 0xffff0000u)};
                    const f32x4 x1 = {__uint_as_float(w.z << 16), __uint_as_float(w.z & 0xffff0000u), __uint_as_float(w.w << 16), __uint_as_float(w.w & 0xffff0000u)};
                    const f32x4 y0 = x0 + acc[ai][bj][m][0], y1 = x1 + acc[ai][bj][m][1];
                    u32x4 w1; w1.x = cvt_pk_bf16(y0[0], y0[1]); w1.y = cvt_pk_bf16(y0[2], y0[3]); w1.z = cvt_pk_bf16(y1[0], y1[1]); w1.w = cvt_pk_bf16(y1[2], y1[3]); st16<SC1_X1B>(X1B + off, w1);
                    ss += (y0[0] * y0[0] + y0[1] * y0[1]) + (y0[2] * y0[2] + y0[3] * y0[3]) + (y1[0] * y1[0] + y1[1] * y1[1]) + (y1[2] * y1[2] + y1[3] * y1[3]);
                }
                ss += __shfl_xor(ss, 16); ss += __shfl_xor(ss, 32);
                if (fq == 0) rowss[(size_t)r * 32 + u.pn * 4 + wc] = ss;
            }
        }
        asm volatile("" ::: "memory");
    }
};
struct EpiRelu2 {
    static constexpr bool PERM = true, AFTER_DRAIN = false, WIDE = true, PRE = false;
    bf16_t* O; int ldc;
    __device__ __forceinline__ void operator()(const f32x4 (&acc)[2][2][4][2], const Unit& u, int wr, int wc, int fr, int fq) const {
        char* tb = (char*)O + ((size_t)u.pm * (ldc / 64) + u.pn * 4 + wc) * 32768 + (wr * 64 + fr) * 128 + (8 * fq) * 2;
#pragma unroll
        for (int ai = 0; ai < 2; ++ai)
#pragma unroll
            for (int m = 0; m < 4; ++m) {
#pragma unroll
                for (int bj = 0; bj < 2; ++bj) {
                    f32x4 v0 = acc[ai][bj][m][0], v1 = acc[ai][bj][m][1];
#pragma unroll
                    for (int j = 0; j < 4; ++j) { const float a = fmaxf(v0[j], 0.f), b = fmaxf(v1[j], 0.f); v0[j] = a * a; v1[j] = b * b; }
                    u32x4 w; w.x = cvt_pk_bf16(v0[0], v0[1]); w.y = cvt_pk_bf16(v0[2], v0[3]); w.z = cvt_pk_bf16(v1[0], v1[1]); w.w = cvt_pk_bf16(v1[2], v1[3]);
                    st16<SC1_U>(tb + bj * 64 + (ai * HALF + m * 16) * 128, w);
                }
            }
    }
};
struct EpiFinal {
    static constexpr bool PERM = true, AFTER_DRAIN = false, WIDE = true, PRE = true;
    float* out; const PG8_LAS float* r2l; int ldc; const float* rowss; int pm0; const bf16_t* X1B;
    __device__ __forceinline__ void pre_load(f32x4 (&pre)[8]) const {
        if ((int)threadIdx.x < 256 && pm0 >= 0) { const f32x4* rs = (const f32x4*)(rowss + (size_t)(pm0 * 256 + (int)threadIdx.x) * 32);
#pragma unroll
            for (int j = 0; j < 8; ++j) pre[j] = rs[j]; }
    }
    __device__ __forceinline__ void pre_apply(const f32x4 (&pre)[8]) const {
        if ((int)threadIdx.x < 256 && pm0 >= 0) { f32x4 s4 = pre[0];
#pragma unroll
            for (int j = 1; j < 8; ++j) s4 += pre[j];
            ((PG8_LAS float*)r2l)[threadIdx.x] = 1.0f / (((s4[0] + s4[1]) + (s4[2] + s4[3])) * (1.0f / 2048.0f) + 1e-6f); }
    }
    __device__ __forceinline__ void operator()(const f32x4 (&acc)[2][2][4][2], const Unit& u, int wr, int wc, int fr, int fq) const {
        const int rl0 = wr * 64 + fr, col0 = u.pn * BM + wc * 64 + 8 * fq;
        const size_t boff = (size_t)(u.pm * BM + rl0) * ldc + col0;
#pragma unroll
        for (int ai = 0; ai < 2; ++ai) {
            u32x4 xv[4][2]; float r2[4];
#pragma unroll
            for (int m = 0; m < 4; ++m) {
                if (u.pm == pm0) r2[m] = r2l[rl0 + ai * HALF + m * 16];
                else { const f32x4* rs = (const f32x4*)(rowss + (size_t)(u.pm * BM + rl0 + ai * HALF + m * 16) * 32); f32x4 s4 = rs[0];
#pragma unroll
                    for (int j = 1; j < 8; ++j) s4 += rs[j];
                    r2[m] = 1.0f / (((s4[0] + s4[1]) + (s4[2] + s4[3])) * (1.0f / 2048.0f) + 1e-6f); }
#pragma unroll
                for (int bj = 0; bj < 2; ++bj) xv[m][bj] = *(const u32x4*)(X1B + boff + (size_t)(ai * HALF + m * 16) * ldc + bj * 32); }
            asm volatile("" ::: "memory");
#pragma unroll
            for (int m = 0; m < 4; ++m)
#pragma unroll
                for (int bj = 0; bj < 2; ++bj) { const u32x4 w = xv[m][bj]; float* p = out + boff + (size_t)(ai * HALF + m * 16) * ldc + bj * 32;
                    const f32x4 x0 = {__uint_as_float(w.x << 16), __uint_as_float(w.x & 0xffff0000u), __uint_as_float(w.y << 16), __uint_as_float(w.y & 0xffff0000u)};
                    const f32x4 x1 = {__uint_as_float(w.z << 16), __uint_as_float(w.z & 0xffff0000u), __uint_as_float(w.w << 16), __uint_as_float(w.w & 0xffff0000u)};
                    st16<SC1_OUT>(p, (f32x4)(x0 + acc[ai][bj][m][0] * r2[m])); st16<SC1_OUT>(p + 4, (f32x4)(x1 + acc[ai][bj][m][1] * r2[m])); }
            asm volatile("" ::: "memory");
        }
    }
};
struct EpiNull {
    static constexpr bool PERM = false, AFTER_DRAIN = false, WIDE = false, PRE = false;
    float* sink;
    __device__ __forceinline__ void operator()(const f32x4 (&acc)[2][2][4][2], const Unit& u, int wr, int wc, int fr, int fq) const {
        float s = 0.f;
#pragma unroll
        for (int ai = 0; ai < 2; ++ai)
#pragma unroll
            for (int bj = 0; bj < 2; ++bj)
#pragma unroll
                for (int m = 0; m < 4; ++m)
#pragma unroll
                    for (int n = 0; n < 2; ++n) s += (acc[ai][bj][m][n][0] + acc[ai][bj][m][n][1]) + (acc[ai][bj][m][n][2] + acc[ai][bj][m][n][3]);
        if (s == 123456.789f) sink[u.pm * 8 + u.pn] = s;
    }
};
struct OrderP1Local : StaticOrder {
    int loc, x, j;
    __host__ __device__ bool next(int i, Unit& u) const {
        if (!loc) return StaticOrder::next(i, u);
        if (i >= 4) return false;
        u.pm = 16 * (x >> 2) + 4 * i + j / 7; u.pn = 4 * ((j % 7 + i) % 7) + (x & 3); return true; }
};
struct StaticOrderA0 : StaticOrder {
    __host__ __device__ bool next(int i, Unit& u) const { const bool r = StaticOrder::next(i, u); u.pm = 0; return r; }
};
template <class Epi, class Sched, bool ALIGN_EPI = false, bool SP2 = false, bool BLK = false>
__device__ __forceinline__ void gemm_phase(PG8_LAS unsigned char* lds, const Gemm g, const Sched& S, const Epi& E) {
    const int tid = threadIdx.x, wid = __builtin_amdgcn_readfirstlane(tid >> 6), lane = tid & 63, wr = wid >> 2, wc = wid & 3, fr = lane & 15, fq = lane >> 4;
    const int K = g.K, nt = K / BK;
    constexpr bool WIDE = Epi::PERM && Epi::WIDE;
    unsigned voffA[2], voffB[2];
#pragma unroll
    for (int i = 0; i < 2; ++i) { int R, C; stage_rc(tid * 16 + i * 8192, R, C); const int Rb = Epi::PERM ? ((WIDE ? 64 * (R >> 5) : (R & ~31)) + perm32(R & 31)) : R;
        voffA[i] = BLK ? (unsigned)(R * 128 + C * 2) : (unsigned)(R * K + C) * 2u; voffB[i] = BLK ? (unsigned)(Rb * 128 + C * 2) : (unsigned)(Rb * K + C) * 2u; }
    const size_t kstep = BLK ? (size_t)32768 : (size_t)(BK * 2);
    const size_t hstep = BLK ? (size_t)(HALF * 128) : (size_t)HALF * K * 2;
    const size_t hstepB = WIDE ? hstep / 4 : hstep;
    const size_t tstep = BLK ? (size_t)(K / BK) * 32768 : 2 * hstep;
    const unsigned ldsw = (unsigned)wid * 1024u;
    const int aoff = lds_byte(wr * 64 + fr, fq * 8), boff = lds_byte(wc * 32 + fr, fq * 8);
#define PG8_SA(b, h) (((b) * 2 + (h)) * HTB)
#define PG8_SB(b, h) ((4 + (b) * 2 + (h)) * HTB)
#define PG8_STAGE(bufoff, gbase, voff) do { _Pragma("unroll") for (int _i = 0; _i < 2; ++_i) \
        __builtin_amdgcn_global_load_lds((const unsigned*)((const char*)(gbase) + (voff)[_i]), (PG8_LAS unsigned*)(lds + (bufoff) + ldsw + _i * 8192), 16, 0, 0); } while (0)
#define PG8_LDA(dst, b, h) do { _Pragma("unroll") for (int m = 0; m < 4; ++m) _Pragma("unroll") for (int k = 0; k < 2; ++k) dst[m][k] = *(const PG8_LAS bf16x8*)(lds + PG8_SA(b, h) + aoff + m * 2048 + k * 1024); } while (0)
#define PG8_LDB(dst, b, h) do { _Pragma("unroll") for (int n = 0; n < 2; ++n) _Pragma("unroll") for (int k = 0; k < 2; ++k) dst[n][k] = *(const PG8_LAS bf16x8*)(lds + PG8_SB(b, h) + boff + n * 2048 + k * 1024); } while (0)
#define PG8_MMA(ai, bj, At, Bt) do { __builtin_amdgcn_s_setprio(1); _Pragma("unroll") for (int m = 0; m < 4; ++m) _Pragma("unroll") for (int n = 0; n < 2; ++n) _Pragma("unroll") for (int k = 0; k < 2; ++k) \
        acc[ai][bj][m][n] = __builtin_amdgcn_mfma_f32_16x16x32_bf16(Bt[n][k], At[m][k], acc[ai][bj][m][n], 0, 0, 0); __builtin_amdgcn_s_setprio(0); } while (0)
#define PG8_WAIT_V(n) asm volatile("s_waitcnt vmcnt(" #n ")" ::: "memory")
#define PG8_WAIT_L(n) asm volatile("s_waitcnt lgkmcnt(" #n ")" ::: "memory")
#define PG8_BAR __builtin_amdgcn_s_barrier()
#define PG8_SCHED __builtin_amdgcn_sched_barrier(0)
    Unit cur, nxt; int ui = 0;
    if (!S.next(0, cur)) return;
    f32x4 acc[2][2][4][2];
#pragma unroll
    for (int a = 0; a < 2; ++a)
#pragma unroll
        for (int b = 0; b < 2; ++b)
#pragma unroll
            for (int m = 0; m < 4; ++m)
#pragma unroll
                for (int n = 0; n < 2; ++n) acc[a][b][m][n] = (f32x4){0.f, 0.f, 0.f, 0.f};
    bf16x8 At[4][2], B0[2][2], B1[2][2];
    const char* cA = (const char*)g.A + (size_t)cur.pm * tstep; const char* cB = (const char*)g.Bt + (size_t)cur.pn * tstep;
    S.a_ready(cur);
    f32x4 pre_[8];
    if constexpr (Epi::PRE) E.pre_load(pre_);
    if constexpr (SP2) {
        PG8_STAGE(PG8_SB(0, 0), cB, voffB); PG8_STAGE(PG8_SB(0, 1), cB + hstepB, voffB); PG8_STAGE(PG8_SA(0, 0), cA, voffA); PG8_STAGE(PG8_SA(0, 1), cA + hstep, voffA);
        if (wr == 1) PG8_BAR;
        PG8_WAIT_V(2); PG8_BAR;
        PG8_STAGE(PG8_SB(1, 0), cB + kstep, voffB); PG8_STAGE(PG8_SA(1, 0), cA + kstep, voffA); PG8_STAGE(PG8_SB(1, 1), cB + hstepB + kstep, voffB);
        PG8_WAIT_V(6); PG8_BAR;
    } else {
        PG8_STAGE(PG8_SB(0, 0), cB, voffB); PG8_STAGE(PG8_SA(0, 0), cA, voffA); PG8_STAGE(PG8_SB(0, 1), cB + hstepB, voffB); PG8_STAGE(PG8_SA(0, 1), cA + hstep, voffA);
        if (wr == 1) PG8_BAR;
        PG8_WAIT_V(4); PG8_BAR;
        PG8_STAGE(PG8_SB(1, 0), cB + kstep, voffB); PG8_STAGE(PG8_SA(1, 0), cA + kstep, voffA); PG8_STAGE(PG8_SB(1, 1), cB + hstepB + kstep, voffB);
        PG8_WAIT_V(6); PG8_BAR;
    }
    if constexpr (Epi::PRE) E.pre_apply(pre_);
    for (;;) {
        const bool has_next = S.next(ui + 1, nxt);
        const char* nA = has_next ? (const char*)g.A + (size_t)nxt.pm * tstep : cA; const char* nB = has_next ? (const char*)g.Bt + (size_t)nxt.pn * tstep : cB;
        for (int t = 0; t < nt; t += 2) {
            const bool last = (t == nt - 2);
            const char* a1 = cA + (size_t)(t + 1) * kstep;
            const char* a2 = last ? nA : cA + (size_t)(t + 2) * kstep; const char* b2 = last ? nB : cB + (size_t)(t + 2) * kstep;
            const char* a3 = a2 + kstep; const char* b3 = b2 + kstep;
            if (last && has_next) S.a_ready(nxt);
            if constexpr (SP2) {
            PG8_LDB(B0, 0, 0); PG8_LDB(B1, 0, 1); PG8_SCHED; PG8_LDA(At, 0, 0); PG8_STAGE(PG8_SA(1, 1), a1 + hstep, voffA);
            PG8_WAIT_V(8); PG8_WAIT_L(0); PG8_BAR; PG8_MMA(0, 0, At, B0); PG8_MMA(0, 1, At, B1); PG8_BAR; PG8_SCHED;
            PG8_LDA(At, 0, 1); PG8_STAGE(PG8_SB(0, 0), b2, voffB); PG8_STAGE(PG8_SB(0, 1), b2 + hstepB, voffB); PG8_STAGE(PG8_SA(0, 0), a2, voffA);
            PG8_WAIT_V(8); PG8_WAIT_L(0); PG8_BAR; PG8_MMA(1, 0, At, B0); PG8_MMA(1, 1, At, B1); PG8_BAR; PG8_SCHED;
            PG8_LDB(B0, 1, 0); PG8_LDB(B1, 1, 1); PG8_SCHED; PG8_LDA(At, 1, 0); PG8_STAGE(PG8_SA(0, 1), a2 + hstep, voffA);
            PG8_WAIT_V(8); PG8_WAIT_L(0); PG8_BAR; PG8_MMA(0, 0, At, B0); PG8_MMA(0, 1, At, B1); PG8_BAR; PG8_SCHED;
            PG8_LDA(At, 1, 1); PG8_STAGE(PG8_SB(1, 0), b3, voffB); PG8_STAGE(PG8_SB(1, 1), b3 + hstepB, voffB); PG8_STAGE(PG8_SA(1, 0), a3, voffA);
            PG8_WAIT_V(8); PG8_WAIT_L(0); PG8_BAR; PG8_MMA(1, 0, At, B0); PG8_MMA(1, 1, At, B1); PG8_BAR; PG8_SCHED;
            } else {
            PG8_LDB(B0, 0, 0); PG8_SCHED; PG8_LDA(At, 0, 0); PG8_STAGE(PG8_SA(1, 1), a1 + hstep, voffA);
            PG8_WAIT_L(8); PG8_BAR; PG8_WAIT_L(0); PG8_MMA(0, 0, At, B0); PG8_BAR; PG8_SCHED;
            PG8_LDB(B1, 0, 1); PG8_STAGE(PG8_SB(0, 0), b2, voffB);
            PG8_BAR; PG8_WAIT_L(0); PG8_MMA(0, 1, At, B1); PG8_BAR;
            PG8_LDA(At, 0, 1); PG8_STAGE(PG8_SA(0, 0), a2, voffA);
            PG8_BAR; PG8_WAIT_L(0); PG8_MMA(1, 0, At, B0); PG8_BAR; PG8_SCHED;
            PG8_STAGE(PG8_SB(0, 1), b2 + hstepB, voffB);
            PG8_WAIT_V(6); PG8_BAR; PG8_MMA(1, 1, At, B1); PG8_BAR;
            PG8_LDB(B0, 1, 0); PG8_SCHED; PG8_LDA(At, 1, 0); PG8_STAGE(PG8_SA(0, 1), a2 + hstep, voffA);
            PG8_WAIT_L(8); PG8_BAR; PG8_WAIT_L(0); PG8_MMA(0, 0, At, B0); PG8_BAR; PG8_SCHED;
            PG8_LDB(B1, 1, 1); PG8_STAGE(PG8_SB(1, 0), b3, voffB);
            PG8_BAR; PG8_WAIT_L(0); PG8_MMA(0, 1, At, B1); PG8_BAR;
            PG8_LDA(At, 1, 1); PG8_STAGE(PG8_SA(1, 0), a3, voffA);
            PG8_BAR; PG8_WAIT_L(0); PG8_MMA(1, 0, At, B0); PG8_BAR; PG8_SCHED;
            PG8_STAGE(PG8_SB(1, 1), b3 + hstepB, voffB);
            PG8_WAIT_V(6); PG8_BAR; PG8_MMA(1, 1, At, B1); PG8_BAR;
            }
        }
        if constexpr (ALIGN_EPI) { if (wr == 0) PG8_BAR; }
        if constexpr (!Epi::AFTER_DRAIN) { E(acc, cur, wr, wc, fr, fq); S.done(cur); }
        if (!has_next) break;
#pragma unroll
        for (int a = 0; a < 2; ++a)
#pragma unroll
            for (int b = 0; b < 2; ++b)
#pragma unroll
                for (int m = 0; m < 4; ++m)
#pragma unroll
                    for (int n = 0; n < 2; ++n) acc[a][b][m][n] = (f32x4){0.f, 0.f, 0.f, 0.f};
        cur = nxt; cA = nA; cB = nB; ++ui;
        if constexpr (ALIGN_EPI) { if (wr == 1) PG8_BAR; }
    }
    PG8_WAIT_V(0);
    if constexpr (!ALIGN_EPI) { if (wr == 0) PG8_BAR; }
    PG8_BAR;
    if constexpr (Epi::AFTER_DRAIN) { E.fused(acc, cur, wr, wc, fr, fq, lds, wid, lane); S.done(cur); }
#undef PG8_SA
#undef PG8_SB
#undef PG8_STAGE
#undef PG8_LDA
#undef PG8_LDB
#undef PG8_MMA
#undef PG8_WAIT_V
#undef PG8_WAIT_L
#undef PG8_BAR
#undef PG8_SCHED
}
}
#define GAS __attribute__((address_space(1)))
#define LAS __attribute__((address_space(3)))
typedef unsigned short bf16;
typedef unsigned v4u __attribute__((ext_vector_type(4)));
typedef float f32x4 __attribute__((ext_vector_type(4)));
typedef short bf16x8 __attribute__((ext_vector_type(8)));
typedef GAS unsigned gu32;
typedef GAS unsigned long long gu64;
#define RLX_AGENT __ATOMIC_RELAXED, __HIP_MEMORY_SCOPE_AGENT
#define LDS_WAIT() asm volatile("s_waitcnt lgkmcnt(0)" ::: "memory")
#define VM_WAIT() asm volatile("s_waitcnt vmcnt(0)" ::: "memory")
__device__ __forceinline__ unsigned long long rt() { return __builtin_amdgcn_s_memrealtime(); }
__device__ __forceinline__ unsigned f2bf(float f) { unsigned u = __builtin_bit_cast(unsigned, f); return (u + 0x7fffu + ((u >> 16) & 1u)) >> 16; }
typedef float pk2_f2_t __attribute__((ext_vector_type(2))); typedef __bf16 pk2_b2_t __attribute__((ext_vector_type(2)));
__device__ __forceinline__ unsigned pk2(float lo, float hi) { pk2_f2_t v = {lo, hi}; return __builtin_bit_cast(unsigned, __builtin_convertvector(v, pk2_b2_t)); }

#define XB_TMO      128
#define XB_XCNT(j)  (256  + 64 * (j))
#define XB_XSUB(j)  (1280 + 64 * (j))
#define XB_XGEN(j)  (2304 + 64 * (j))
#define XB_TOP      3328
#define XB_TOPGEN   3392
#define XCD_BAR_WORDS 3456
#define XB_SPIN_CAP (1u << 18)

__device__ __forceinline__ unsigned xb_ld(unsigned* p)              { return __hip_atomic_load(p, __ATOMIC_RELAXED, __HIP_MEMORY_SCOPE_AGENT); }
__device__ __forceinline__ unsigned xb_add(unsigned* p, unsigned v) { return __hip_atomic_fetch_add(p, v, __ATOMIC_RELAXED, __HIP_MEMORY_SCOPE_AGENT); }
__device__ __forceinline__ unsigned xb_xcc_id() { return (unsigned)__builtin_amdgcn_s_getreg((3 << 11) | 20) & 0xFu; }
#define XB_SPIN(cond, bar) do { unsigned _sp = 0; while (cond) { __builtin_amdgcn_s_sleep(1); \
    if ((++_sp & 255u) == 0u) { if (xb_ld(&(bar)[XB_TMO])) break; if (_sp > XB_SPIN_CAP) { atomicAdd(&(bar)[XB_TMO], 1u); break; } } } } while (0)

struct XcdBarrier {
    unsigned* bar; unsigned x;
    volatile LAS unsigned* st;
};

__device__ __forceinline__ XcdBarrier xcd_barrier_post(unsigned* bar, volatile LAS unsigned* st) {
    XcdBarrier b; b.bar = bar; b.x = xb_xcc_id(); b.st = st;
    if (threadIdx.x == 0) (void)xb_add(&bar[XB_XCNT(b.x)], 1u + ((b.x != (blockIdx.x & 7u)) ? 0x10000u : 0u));
    return b;
}
__device__ __forceinline__ void xcd_barrier_complete(unsigned* bar, unsigned x, unsigned& nloc, unsigned& nx, unsigned* mism_out = nullptr) {
    const unsigned G = gridDim.x * gridDim.y * gridDim.z;
    unsigned sum, cnt, mine, mism, sp = 0u;
    for (;;) {
        sum = 0u; cnt = 0u; mine = 0u; mism = 0u;
#pragma unroll
        for (unsigned j = 0; j < 16; ++j) { const unsigned cw = xb_ld(&bar[XB_XCNT(j)]); const unsigned c = cw & 0xffffu; mism += cw >> 16; sum += c; cnt += (c > 0u) ? 1u : 0u; mine = (j == x) ? c : mine; }
        if (mism_out) *mism_out = mism;
        if (sum == G) break;
        __builtin_amdgcn_s_sleep(1);
        if ((++sp & 255u) == 0u) { if (xb_ld(&bar[XB_TMO])) break; if (sp > XB_SPIN_CAP) { atomicAdd(&bar[XB_TMO], 1u); break; } }
    }
    nloc = mine > 0u ? mine : 1u; nx = cnt > 0u ? cnt : 1u;
}

__device__ __forceinline__ void xcd_barrier(const XcdBarrier& b) {
    asm volatile("s_waitcnt vmcnt(0)" ::: "memory");
    __syncthreads();
    if (threadIdx.x == 0) {
        unsigned* bar = b.bar;
        __builtin_amdgcn_s_waitcnt(0);
        unsigned nloc = b.st[0], nx = b.st[1];
        if (nloc == 0u) { xcd_barrier_complete(bar, b.x, nloc, nx); b.st[0] = nloc; b.st[1] = nx; }
        const unsigned old = xb_add(&bar[XB_XSUB(b.x)], 1u);
        const unsigned gen = old / nloc;
        if (old + 1u == (gen + 1u) * nloc) {
            __builtin_amdgcn_fence(__ATOMIC_RELEASE, "agent");
            asm volatile("s_waitcnt vmcnt(0)" ::: "memory");
            const unsigned og = xb_add(&bar[XB_TOP], 1u);
            const unsigned tg = og / nx;
            if (og + 1u == (tg + 1u) * nx) xb_add(&bar[XB_TOPGEN], 1u);
            else XB_SPIN(xb_ld(&bar[XB_TOPGEN]) == tg, bar);
            __builtin_amdgcn_fence(__ATOMIC_ACQUIRE, "agent");
            xb_add(&bar[XB_XGEN(b.x)], 1u);
            asm volatile("s_waitcnt vmcnt(0)" ::: "memory");
        } else {
            XB_SPIN(xb_ld(&bar[XB_XGEN(b.x)]) == gen, bar);
            __builtin_amdgcn_fence(__ATOMIC_ACQUIRE, "agent");
            asm volatile("s_waitcnt vmcnt(0)" ::: "memory");
        }
    }
    __syncthreads();
}

__device__ __forceinline__ void xcd_barrier2(const XcdBarrier& b, unsigned ord) {
    asm volatile("s_waitcnt vmcnt(0)" ::: "memory");
    __syncthreads();
    if (threadIdx.x == 0) {
        unsigned* bar = b.bar;
        __builtin_amdgcn_s_waitcnt(0);
        unsigned nloc = b.st[0], nx = b.st[1];
        if (nloc == 0u) { xcd_barrier_complete(bar, b.x, nloc, nx); b.st[0] = nloc; b.st[1] = nx; }
        const unsigned old = xb_add(&bar[XB_XSUB(b.x)], 1u);
        const unsigned gen = old / nloc;
        if (old + 1u == (gen + 1u) * nloc) {
            __builtin_amdgcn_fence(__ATOMIC_RELEASE, "agent");
            asm volatile("s_waitcnt vmcnt(0)" ::: "memory");
            const unsigned og = xb_add(&bar[XB_TOP], 1u);
            const unsigned tg = og / nx;
            if (og + 1u == (tg + 1u) * nx) xb_add(&bar[XB_TOPGEN], 1u);
            else XB_SPIN(xb_ld(&bar[XB_TOPGEN]) == tg, bar);
            __builtin_amdgcn_fence(__ATOMIC_ACQUIRE, "agent");
            asm volatile("s_waitcnt vmcnt(0)" ::: "memory");
        } else {
            XB_SPIN(xb_ld(&bar[XB_TOPGEN]) == ord, bar);
            __builtin_amdgcn_fence(__ATOMIC_ACQUIRE, "agent");
            asm volatile("s_waitcnt vmcnt(0)" ::: "memory");
        }
    }
    __syncthreads();
}


__device__ __forceinline__ void xcd_barrier3(const XcdBarrier& b, unsigned ord) {
    asm volatile("s_waitcnt vmcnt(0)" ::: "memory");
    __syncthreads();
    if (threadIdx.x == 0) {
        unsigned* bar = b.bar;
        __builtin_amdgcn_s_waitcnt(0);
        unsigned nloc = b.st[0], nx = b.st[1];
        if (nloc == 0u) { xcd_barrier_complete(bar, b.x, nloc, nx); b.st[0] = nloc; b.st[1] = nx; }
        const unsigned old = xb_add(&bar[XB_XSUB(b.x)], 1u);
        const unsigned gen = old / nloc;
        if (old + 1u == (gen + 1u) * nloc) {
            __builtin_amdgcn_fence(__ATOMIC_RELEASE, "agent");
            asm volatile("s_waitcnt vmcnt(0)" ::: "memory");
            (void)xb_add(&bar[XB_TOP], 1u);
        }
        const unsigned want = (ord + 1u) * nx;
        XB_SPIN(xb_ld(&bar[XB_TOP]) < want, bar);
        __builtin_amdgcn_fence(__ATOMIC_ACQUIRE, "agent");
        asm volatile("s_waitcnt vmcnt(0)" ::: "memory");
    }
    __syncthreads();
}

__device__ __forceinline__ void xcd_barrier4(const XcdBarrier& b, unsigned ord) {
    asm volatile("s_waitcnt vmcnt(0)" ::: "memory");
    __syncthreads();
    if (threadIdx.x == 0) {
        unsigned* bar = b.bar;
        __builtin_amdgcn_s_waitcnt(0);
        unsigned nloc = b.st[0], nx = b.st[1];
        if (nloc == 0u) { unsigned mm_ = 0u; xcd_barrier_complete(bar, b.x, nloc, nx, &mm_); b.st[0] = nloc; b.st[1] = nx; b.st[2] = (mm_ == 0u && nloc == 32u && nx == 8u) ? 1u : 2u; }
        const unsigned old = xb_add(&bar[XB_XSUB(b.x)], 1u);
        const unsigned gen = old / nloc;
        if (old + 1u == (gen + 1u) * nloc) {
            __builtin_amdgcn_fence(__ATOMIC_RELEASE, "agent");
            asm volatile("s_waitcnt vmcnt(0)" ::: "memory");
            (void)xb_add(&bar[XB_TOP], 1u);
        }
        const unsigned want = (ord + 1u) * nx;
        asm volatile("buffer_inv sc1" ::: "memory");
        XB_SPIN(xb_ld(&bar[XB_TOP]) < want, bar);
        asm volatile("s_waitcnt vmcnt(0)" ::: "memory");
    }
    __syncthreads();
}


__device__ __forceinline__ void xcd_barrier_local(const XcdBarrier& b, unsigned ordTot) {
    asm volatile("s_waitcnt vmcnt(0)" ::: "memory");
    __syncthreads();
    if (threadIdx.x == 0) {
        unsigned* bar = b.bar; const unsigned nloc = b.st[0];
        (void)xb_add(&bar[XB_XSUB(b.x)], 1u);
        asm volatile("buffer_inv sc1" ::: "memory");
        const unsigned want = (ordTot + 1u) * nloc;
        XB_SPIN(xb_ld(&bar[XB_XSUB(b.x)]) < want, bar);
        asm volatile("s_waitcnt vmcnt(0)" ::: "memory");
    }
    __syncthreads();
}

#define FB_CNT(j) (3584 + 64 * (j))
__device__ __forceinline__ void flat_barrier(unsigned* bar, unsigned gen, unsigned G) {
    asm volatile("s_waitcnt vmcnt(0)" ::: "memory");
    __syncthreads();
    if (threadIdx.x < 64) {
        const unsigned lane = threadIdx.x;
        if (lane == 0) {
            __builtin_amdgcn_fence(__ATOMIC_RELEASE, "agent");
            asm volatile("s_waitcnt vmcnt(0)" ::: "memory");
            (void)xb_add(&bar[FB_CNT(blockIdx.x & 7u)], 1u);
        }
        const unsigned j = lane & 7u, target = gen * ((G + 7u - j) >> 3);
        unsigned sp = 0u;
        for (;;) {
            unsigned v = 0xffffffffu;
            if (lane < 8u) v = xb_ld(&bar[FB_CNT(j)]);
            if (__all(v >= target)) break;
            __builtin_amdgcn_s_sleep(1);
            if ((++sp & 255u) == 0u) { if (xb_ld(&bar[XB_TMO])) break; if (sp > XB_SPIN_CAP) { atomicAdd(&bar[XB_TMO], 1u); break; } }
        }
        __builtin_amdgcn_fence(__ATOMIC_ACQUIRE, "agent");
        asm volatile("s_waitcnt vmcnt(0)" ::: "memory");
    }
    __syncthreads();
}
#ifndef ATT_PROBE
#define ATT_PROBE 0
#endif
namespace att {
#ifndef RT_PROBE
#define RT_PROBE 0
#endif
#ifndef RET_STORE_CONTRIB
#define RET_STORE_CONTRIB 0
#endif
#if ATT_PROBE == 2
#define ATT_EXP2(x) ((x) * 0.f + 1.f)
#else
#define ATT_EXP2(x) __builtin_amdgcn_exp2f(x)
#endif
using bf16x8 = __attribute__((ext_vector_type(8))) short;
using s16x4  = __attribute__((ext_vector_type(4))) short;
using f32x16 = __attribute__((ext_vector_type(16))) float;
using u32x4  = __attribute__((ext_vector_type(4))) unsigned;
using u32x2  = __attribute__((ext_vector_type(2))) unsigned;
using f32x4  = __attribute__((ext_vector_type(4))) float;
typedef unsigned short bf16;
constexpr int LD = 7168;
constexpr int TILE_B = 64 * 128 * 2;
#define KSWF(row) (((row) & 7) | ((((row) >> 4) & 1) << 3))
#define KSWZ(row, colB) ((row) * 256 + ((colB) ^ (KSWF(row) << 4)))
#define SBAR() __builtin_amdgcn_sched_barrier(0)
__device__ __forceinline__ int crow(int r, int hi) { return (r & 3) + 8 * (r >> 2) + 4 * hi; }
typedef float f32x2_t __attribute__((ext_vector_type(2))); typedef __bf16 bf16x2_t __attribute__((ext_vector_type(2)));
__device__ __forceinline__ unsigned cvtpk(float lo, float hi) { f32x2_t v = {lo, hi}; bf16x2_t b = __builtin_convertvector(v, bf16x2_t); return __builtin_bit_cast(unsigned, b); }
__device__ __forceinline__ bf16x8 ld8(const bf16* p) { return *reinterpret_cast<const bf16x8*>(p); }

constexpr float THR2 = 8.0f;
__device__ __forceinline__ void partialSM(f32x16& p0, f32x16& p1, float& m_reg, float& mn, float& alpha) {
  float pmax = p0[0];
#pragma unroll
  for (int r = 1; r < 16; ++r) pmax = fmaxf(pmax, p0[r]);
#pragma unroll
  for (int r = 0; r < 16; ++r) pmax = fmaxf(pmax, p1[r]);
  { auto rr = __builtin_amdgcn_permlane32_swap(__float_as_uint(pmax), __float_as_uint(pmax), false, false);
    pmax = fmaxf(__uint_as_float(rr[0]), __uint_as_float(rr[1])); }
  if (__builtin_expect(__all(pmax - m_reg <= THR2), 1)) { mn = m_reg; alpha = 1.f; }
  else { mn = fmaxf(m_reg, pmax); alpha = __builtin_amdgcn_exp2f(m_reg - mn); m_reg = mn; }
#pragma unroll
  for (int r = 0; r < 16; ++r) p0[r] = ATT_EXP2(p0[r] - mn);
#pragma unroll
  for (int r = 0; r < 16; ++r) p1[r] -= mn;
}
#define ATT_PK4(P, BASE, OUT) do { unsigned a0 = cvtpk(P[BASE + 0], P[BASE + 1]), a1 = cvtpk(P[BASE + 2], P[BASE + 3]);   \
    unsigned b0 = cvtpk(P[BASE + 4], P[BASE + 5]), b1 = cvtpk(P[BASE + 6], P[BASE + 7]);                              \
    auto r0 = __builtin_amdgcn_permlane32_swap(a0, b0, false, false); auto r1 = __builtin_amdgcn_permlane32_swap(a1, b1, false, false); \
    u32x4 w = {r0[0], r1[0], r0[1], r1[1]}; OUT = *reinterpret_cast<bf16x8*>(&w); } while (0)
__device__ __forceinline__ void finishSM(f32x16& p0, f32x16& p1, float alpha, float& l_reg, bf16x8& pa0, bf16x8& pa1, bf16x8& pa2, bf16x8& pa3) {
#pragma unroll
  for (int r = 0; r < 16; ++r) p1[r] = ATT_EXP2(p1[r]);
  float ps = 0;
#pragma unroll
  for (int r = 0; r < 16; ++r) ps += p0[r];
#pragma unroll
  for (int r = 0; r < 16; ++r) ps += p1[r];
  { auto rr = __builtin_amdgcn_permlane32_swap(__float_as_uint(ps), __float_as_uint(ps), false, false);
    ps = __uint_as_float(rr[0]) + __uint_as_float(rr[1]); }
  l_reg = l_reg * alpha + ps;
  ATT_PK4(p0, 0, pa0); ATT_PK4(p0, 8, pa1); ATT_PK4(p1, 0, pa2); ATT_PK4(p1, 8, pa3);
}
template <bool BATCH> __device__ __forceinline__ void qkt(f32x16& p0, f32x16& p1, const char* Ks, const bf16x8* qr, int r32, int hi) {
  if (BATCH) {
#pragma unroll
    for (int hb = 0; hb < 2; ++hb) {
      bf16x8 b0[4], b1[4]; if (hb) asm volatile("" ::: "memory");
#pragma unroll
      for (int d = 0; d < 4; ++d) { const int cb = ((4 * hb + d) * 16 + hi * 8) * 2;
        b0[d] = *reinterpret_cast<const bf16x8*>(Ks + KSWZ(r32, cb)); b1[d] = *reinterpret_cast<const bf16x8*>(Ks + KSWZ(32 + r32, cb)); }
#pragma unroll
      for (int d = 0; d < 4; ++d) {
        p0 = __builtin_amdgcn_mfma_f32_32x32x16_bf16(b0[d], qr[4 * hb + d], p0, 0, 0, 0);
        p1 = __builtin_amdgcn_mfma_f32_32x32x16_bf16(b1[d], qr[4 * hb + d], p1, 0, 0, 0); }
    }
  } else {
#pragma unroll
    for (int d0 = 0; d0 < 8; ++d0) { const int cb = (d0 * 16 + hi * 8) * 2;
      const bf16x8 b0 = *reinterpret_cast<const bf16x8*>(Ks + KSWZ(r32, cb));
      const bf16x8 b1 = *reinterpret_cast<const bf16x8*>(Ks + KSWZ(32 + r32, cb));
      p0 = __builtin_amdgcn_mfma_f32_32x32x16_bf16(b0, qr[d0], p0, 0, 0, 0);
      p1 = __builtin_amdgcn_mfma_f32_32x32x16_bf16(b1, qr[d0], p1, 0, 0, 0); }
  }
}
template <int OFF> __device__ __forceinline__ bf16x8 lds_rd128(int a) { bf16x8 r; asm volatile("ds_read_b128 %0, %1 offset:%2" : "=&v"(r) : "v"(a), "i"(OFF) : "memory"); return r; }
#define ATT_LGKM_TIE2(N, A, B) asm volatile("s_waitcnt lgkmcnt(" #N ")" : "+v"(A), "+v"(B) :: "memory")
__device__ __forceinline__ void qkt3(f32x16& p0, f32x16& p1, int ka, int X, const bf16x8* qr) {
  bf16x8 a0[3], a1[3];
#define QK_RD(d) do { const int ad_ = ka + ((((d) << 5) ^ X)); a0[(d) % 3] = lds_rd128<0>(ad_); a1[(d) % 3] = lds_rd128<8192>(ad_); } while (0)
#if ATT_PROBE == 3
#define QK_MM(d) do { } while (0)
#else
#define QK_MM(d) do { p0 = __builtin_amdgcn_mfma_f32_32x32x16_bf16(a0[(d) % 3], qr[d], p0, 0, 0, 0); p1 = __builtin_amdgcn_mfma_f32_32x32x16_bf16(a1[(d) % 3], qr[d], p1, 0, 0, 0); } while (0)
#endif
  QK_RD(0); QK_RD(1);
  QK_RD(2); ATT_LGKM_TIE2(4, a0[0], a1[0]); QK_MM(0);
  QK_RD(3); ATT_LGKM_TIE2(4, a0[1], a1[1]); QK_MM(1);
  QK_RD(4); ATT_LGKM_TIE2(4, a0[2], a1[2]); QK_MM(2);
  QK_RD(5); ATT_LGKM_TIE2(4, a0[0], a1[0]); QK_MM(3);
  QK_RD(6); ATT_LGKM_TIE2(4, a0[1], a1[1]); QK_MM(4);
  QK_RD(7); ATT_LGKM_TIE2(4, a0[2], a1[2]); QK_MM(5);
  ATT_LGKM_TIE2(2, a0[0], a1[0]); QK_MM(6);
  ATT_LGKM_TIE2(0, a0[1], a1[1]); QK_MM(7);
#undef QK_RD
#undef QK_MM
}
__device__ __forceinline__ int v_st(int k, int c) { const int kk = (k & ~0xC) | ((k & 4) << 1) | ((k & 8) >> 1); return ((kk >> 3) * 4 + (c >> 5)) * 512 + ((kk & 7) * 32 + (c & 31)) * 2; }
__device__ __forceinline__ int v_rd_base(int lane) { return ((lane & 3) << 3) | (((lane >> 2) & 3) << 6) | (((lane >> 4) & 1) << 5) | (((lane >> 5) & 1) << 8); }
constexpr int v_rd_off(int d0, int ks, int half) { return d0 * 512 + ks * 4096 + half * 2048; }
template <int OFF> __device__ __forceinline__ s16x4 tr_read(int vb) {
  s16x4 r; asm volatile("ds_read_b64_tr_b16 %0, %1 offset:%2" : "=&v"(r) : "v"(vb), "i"(OFF) : "memory"); return r;
}
#define ATT_PK(L, H) (bf16x8){L[0], L[1], L[2], L[3], H[0], H[1], H[2], H[3]}
template <int D0, bool TRANS> __device__ __forceinline__ void pv_one(f32x16& od, int vb, bf16x8 pa0, bf16x8 pa1, bf16x8 pa2, bf16x8 pa3) {
  const s16x4 l0 = tr_read<v_rd_off(D0, 0, 0)>(vb), h0 = tr_read<v_rd_off(D0, 0, 1)>(vb), l1 = tr_read<v_rd_off(D0, 1, 0)>(vb), h1 = tr_read<v_rd_off(D0, 1, 1)>(vb);
  const s16x4 l2 = tr_read<v_rd_off(D0, 2, 0)>(vb), h2 = tr_read<v_rd_off(D0, 2, 1)>(vb), l3 = tr_read<v_rd_off(D0, 3, 0)>(vb), h3 = tr_read<v_rd_off(D0, 3, 1)>(vb);
  asm volatile("s_waitcnt lgkmcnt(0)" ::: "memory"); SBAR();
  if (TRANS) {
    od = __builtin_amdgcn_mfma_f32_32x32x16_bf16(ATT_PK(l0, h0), pa0, od, 0, 0, 0);
    od = __builtin_amdgcn_mfma_f32_32x32x16_bf16(ATT_PK(l1, h1), pa1, od, 0, 0, 0);
    od = __builtin_amdgcn_mfma_f32_32x32x16_bf16(ATT_PK(l2, h2), pa2, od, 0, 0, 0);
    od = __builtin_amdgcn_mfma_f32_32x32x16_bf16(ATT_PK(l3, h3), pa3, od, 0, 0, 0);
  } else {
    od = __builtin_amdgcn_mfma_f32_32x32x16_bf16(pa0, ATT_PK(l0, h0), od, 0, 0, 0);
    od = __builtin_amdgcn_mfma_f32_32x32x16_bf16(pa1, ATT_PK(l1, h1), od, 0, 0, 0);
    od = __builtin_amdgcn_mfma_f32_32x32x16_bf16(pa2, ATT_PK(l2, h2), od, 0, 0, 0);
    od = __builtin_amdgcn_mfma_f32_32x32x16_bf16(pa3, ATT_PK(l3, h3), od, 0, 0, 0);
  }
}
template <int DA, bool TRANS> __device__ __forceinline__ void pv_two(f32x16& oa, f32x16& ob, int vb, bf16x8 pa0, bf16x8 pa1, bf16x8 pa2, bf16x8 pa3) {
  constexpr int DB = DA + 1;
  const s16x4 al0 = tr_read<v_rd_off(DA, 0, 0)>(vb), ah0 = tr_read<v_rd_off(DA, 0, 1)>(vb), al1 = tr_read<v_rd_off(DA, 1, 0)>(vb), ah1 = tr_read<v_rd_off(DA, 1, 1)>(vb);
  const s16x4 al2 = tr_read<v_rd_off(DA, 2, 0)>(vb), ah2 = tr_read<v_rd_off(DA, 2, 1)>(vb), al3 = tr_read<v_rd_off(DA, 3, 0)>(vb), ah3 = tr_read<v_rd_off(DA, 3, 1)>(vb);
  const s16x4 bl0 = tr_read<v_rd_off(DB, 0, 0)>(vb), bh0 = tr_read<v_rd_off(DB, 0, 1)>(vb), bl1 = tr_read<v_rd_off(DB, 1, 0)>(vb), bh1 = tr_read<v_rd_off(DB, 1, 1)>(vb);
  const s16x4 bl2 = tr_read<v_rd_off(DB, 2, 0)>(vb), bh2 = tr_read<v_rd_off(DB, 2, 1)>(vb), bl3 = tr_read<v_rd_off(DB, 3, 0)>(vb), bh3 = tr_read<v_rd_off(DB, 3, 1)>(vb);
  asm volatile("s_waitcnt lgkmcnt(0)" ::: "memory"); SBAR();
  if (TRANS) {
    oa = __builtin_amdgcn_mfma_f32_32x32x16_bf16(ATT_PK(al0, ah0), pa0, oa, 0, 0, 0); ob = __builtin_amdgcn_mfma_f32_32x32x16_bf16(ATT_PK(bl0, bh0), pa0, ob, 0, 0, 0);
    oa = __builtin_amdgcn_mfma_f32_32x32x16_bf16(ATT_PK(al1, ah1), pa1, oa, 0, 0, 0); ob = __builtin_amdgcn_mfma_f32_32x32x16_bf16(ATT_PK(bl1, bh1), pa1, ob, 0, 0, 0);
    oa = __builtin_amdgcn_mfma_f32_32x32x16_bf16(ATT_PK(al2, ah2), pa2, oa, 0, 0, 0); ob = __builtin_amdgcn_mfma_f32_32x32x16_bf16(ATT_PK(bl2, bh2), pa2, ob, 0, 0, 0);
    oa = __builtin_amdgcn_mfma_f32_32x32x16_bf16(ATT_PK(al3, ah3), pa3, oa, 0, 0, 0); ob = __builtin_amdgcn_mfma_f32_32x32x16_bf16(ATT_PK(bl3, bh3), pa3, ob, 0, 0, 0);
  } else {
    oa = __builtin_amdgcn_mfma_f32_32x32x16_bf16(pa0, ATT_PK(al0, ah0), oa, 0, 0, 0); ob = __builtin_amdgcn_mfma_f32_32x32x16_bf16(pa0, ATT_PK(bl0, bh0), ob, 0, 0, 0);
    oa = __builtin_amdgcn_mfma_f32_32x32x16_bf16(pa1, ATT_PK(al1, ah1), oa, 0, 0, 0); ob = __builtin_amdgcn_mfma_f32_32x32x16_bf16(pa1, ATT_PK(bl1, bh1), ob, 0, 0, 0);
    oa = __builtin_amdgcn_mfma_f32_32x32x16_bf16(pa2, ATT_PK(al2, ah2), oa, 0, 0, 0); ob = __builtin_amdgcn_mfma_f32_32x32x16_bf16(pa2, ATT_PK(bl2, bh2), ob, 0, 0, 0);
    oa = __builtin_amdgcn_mfma_f32_32x32x16_bf16(pa3, ATT_PK(al3, ah3), oa, 0, 0, 0); ob = __builtin_amdgcn_mfma_f32_32x32x16_bf16(pa3, ATT_PK(bl3, bh3), ob, 0, 0, 0);
  }
}
template <bool TRANS> __device__ __forceinline__ void pv_d0(f32x16* o, int vb, bf16x8 pa0, bf16x8 pa1, bf16x8 pa2, bf16x8 pa3) {
  if (TRANS) {
    pv_one<0, TRANS>(o[0], vb, pa0, pa1, pa2, pa3); pv_one<1, TRANS>(o[1], vb, pa0, pa1, pa2, pa3); pv_one<2, TRANS>(o[2], vb, pa0, pa1, pa2, pa3); pv_one<3, TRANS>(o[3], vb, pa0, pa1, pa2, pa3);
  } else { pv_two<0, TRANS>(o[0], o[1], vb, pa0, pa1, pa2, pa3); pv_two<2, TRANS>(o[2], o[3], vb, pa0, pa1, pa2, pa3); }
}

constexpr int A_V = 0, A_K = 2 * TILE_B, A_WS = 4 * TILE_B, A_BT = A_WS + 8 * 256, A_BYTES = A_BT + 768;
__device__ __forceinline__ void attn_unit(int b, int h, int g, const bf16* __restrict__ PROJ, const float* __restrict__ relb, bf16* __restrict__ MIX, char* lds) {
  int tid_o = threadIdx.x; asm volatile("" : "+v"(tid_o)); const int tid = tid_o, wid = __builtin_amdgcn_readfirstlane(tid >> 6), lane = tid & 63, r32 = lane & 31, hi = lane >> 5;
  char* V_lds = lds + A_V; char* K_lds = lds + A_K;
  float* ws = (float*)(lds + A_WS) + wid * 64; float* li_l = ws; float* al_l = ws + 32;
  float* btab = (float*)(lds + A_BT);
  if (tid < 192) btab[tid] = relb[h * 192 + tid] * 1.4426950408889634f;
  const int n = 4 * g + (wid >> 1), qi = (wid & 1) * 32 + r32;
  const long rowq = (long)b * 4096 + n * 64 + qi;
  float m_reg = -1e30f, l_reg = 0; f32x16 o[4] = {}; bf16x8 qr[8];
  { const bf16* Qw = PROJ + rowq * LD + 4096 + h * 128 + hi * 8;
#pragma unroll
    for (int d0 = 0; d0 < 8; ++d0) qr[d0] = ld8(Qw + d0 * 16); }
  const bf16* Kh = PROJ + (long)b * 4096 * LD + 5120 + h * 128; const bf16* Vh = Kh + 1024;
  const int sr = tid >> 4, sc = (tid & 15) * 8, vst0 = v_st(sr, sc), vst1 = v_st(32 + sr, sc);
  const int vb0 = (int)(uintptr_t)V_lds + v_rd_base(lane);
  bf16x8 vsA0, vsA1, ksA0, ksA1;
#define A_SLOAD(S, k0) do { vs##S##0 = ld8(&Vh[(long)((k0) + sr) * LD + sc]); vs##S##1 = ld8(&Vh[(long)((k0) + 32 + sr) * LD + sc]); \
    ks##S##0 = ld8(&Kh[(long)((k0) + sr) * LD + sc]); ks##S##1 = ld8(&Kh[(long)((k0) + 32 + sr) * LD + sc]); } while (0)
#define A_SWRITE(S, bb) do { *(bf16x8*)(V_lds + (bb) * TILE_B + vst0) = vs##S##0; *(bf16x8*)(V_lds + (bb) * TILE_B + vst1) = vs##S##1; \
    *(bf16x8*)(K_lds + (bb) * TILE_B + KSWZ(sr, sc * 2)) = ks##S##0; *(bf16x8*)(K_lds + (bb) * TILE_B + KSWZ(32 + sr, sc * 2)) = ks##S##1; } while (0)
  const int kc0 = (4 * g - 8) > 0 ? (4 * g - 8) : 0, NT = 4 * g + 4 - kc0;
  A_SLOAD(A, kc0 * 64); A_SWRITE(A, 0); __syncthreads();
#define A_COMPUTE(j, bb) do { const int kc = kc0 + (j); const int delta = n - kc;                                            \
    if (delta >= 0 && delta <= 8) { \
      f32x16 p0, p1; \
      if (delta >= 3) { const float bc = btab[191]; \
        _Pragma("unroll") for (int r = 0; r < 16; ++r) { p0[r] = bc; p1[r] = bc; } } \
      else { const int base = 64 * delta + qi + 63;                     \
        _Pragma("unroll") for (int r = 0; r < 16; ++r) { const int kl = crow(r, hi); int i0 = base - kl, i1 = base - kl - 32; i0 = i0 > 191 ? 191 : i0; i1 = i1 > 191 ? 191 : i1; p0[r] = btab[i0]; p1[r] = btab[i1]; } } \
      qkt<true>(p0, p1, K_lds + (bb) * TILE_B, qr, r32, hi); \
      float mn, alpha; bf16x8 pa0, pa1, pa2, pa3; \
      partialSM(p0, p1, m_reg, mn, alpha); \
      if (__any(alpha < 1.f)) { if (hi == 0) al_l[r32] = alpha; asm volatile("s_waitcnt lgkmcnt(0)" ::: "memory"); \
        _Pragma("unroll") for (int d = 0; d < 4; ++d) _Pragma("unroll") for (int r = 0; r < 16; ++r) o[d][r] *= al_l[crow(r, hi)]; } \
      finishSM(p0, p1, alpha, l_reg, pa0, pa1, pa2, pa3); SBAR(); \
      pv_d0<false>(o, vb0 + (bb) * TILE_B, pa0, pa1, pa2, pa3); \
    } } while (0)
  for (int j = 0; j < NT; j += 2) {
    A_SLOAD(A, (kc0 + j + 1) * 64);
    A_COMPUTE(j, 0);
    A_SWRITE(A, 1);
    __syncthreads();
    if (j + 2 < NT) A_SLOAD(A, (kc0 + j + 2) * 64);
    A_COMPUTE(j + 1, 1);
    if (j + 2 < NT) A_SWRITE(A, 0);
    __syncthreads();
  }
#undef A_COMPUTE
  if (hi == 0) li_l[r32] = l_reg; asm volatile("s_waitcnt lgkmcnt(0)" ::: "memory");
  { bf16* stg = (bf16*)(lds + wid * 8192);
#pragma unroll
    for (int r = 0; r < 16; ++r) { const int orow = crow(r, hi); const float rl = __builtin_amdgcn_rcpf(li_l[orow]);
#pragma unroll
      for (int d0 = 0; d0 < 4; ++d0) { const unsigned w = cvtpk(o[d0][r] * rl, 0.f); stg[orow * 128 + d0 * 32 + r32] = (bf16)(w & 0xffffu); } }
    asm volatile("s_waitcnt lgkmcnt(0)" ::: "memory");
    bf16* Ow = MIX + ((long)b * 4096 + n * 64 + (wid & 1) * 32) * 2048 + 1024 + h * 128;
#pragma unroll
    for (int i = 0; i < 8; ++i) { const int row = i * 4 + (lane >> 4), ch = lane & 15; const u32x4 v = *(const u32x4*)(stg + row * 128 + ch * 8); *(u32x4*)(Ow + (long)row * 2048 + ch * 8) = v; } }
  __syncthreads();
#undef A_SLOAD
#undef A_SWRITE
}

__device__ __forceinline__ void ret_rows_load(int b, int h, int g, const bf16* __restrict__ PROJ, bf16x8 (&kv)[8], bf16x8 (&vv)[8]);
template <bool PREF = false> __device__ __forceinline__ void attn_unit3(int b, int h, int g, const bf16* __restrict__ PROJ, const float* __restrict__ relb, bf16* __restrict__ MIX, char* lds, char* aux, bf16x8 (*pk)[8] = nullptr, bf16x8 (*pv)[8] = nullptr) {
  int tid_o = threadIdx.x; asm volatile("" : "+v"(tid_o)); const int tid = tid_o, wid = __builtin_amdgcn_readfirstlane(tid >> 6), lane = tid & 63, r32 = lane & 31, hi = lane >> 5;
  float* ws = (float*)aux + wid * 64; float* li_l = ws; float* al_l = ws + 32;
  float* btab = (float*)(aux + 8 * 256);
  const float relv = relb[h * 192 + (tid < 192 ? tid : 191)];
  const int n = 4 * g + (wid >> 1), qi = (wid & 1) * 32 + r32;
  const long rowq = (long)b * 4096 + n * 64 + qi;
  float m_reg = -1e30f, l_reg = 0; f32x16 o[4] = {}; bf16x8 qr[8];
  { const bf16* Qw = PROJ + rowq * LD + 4096 + h * 128 + hi * 8;
#pragma unroll
    for (int d0 = 0; d0 < 8; ++d0) qr[d0] = ld8(Qw + d0 * 16); }
  const char* Kh = (const char*)(PROJ + (long)b * 4096 * LD + 5120 + h * 128); const char* Vh = Kh + 2048;
  unsigned offK[2], offV[2];
#pragma unroll
  for (int i = 0; i < 2; ++i) {
    const int kr = wid * 4 + i * 32 + (lane >> 4), kcp = (lane & 15) ^ KSWF(kr);
    offK[i] = (unsigned)(kr * LD + kcp * 8) * 2u;
    const int kk = (i * 4 + (wid >> 1)) * 8 + ((lane >> 2) & 7), vk = (kk & ~0xC) | ((kk & 4) << 1) | ((kk & 8) >> 1);
    const int vc = ((wid & 1) * 2 + (lane >> 5)) * 32 + (lane & 3) * 8;
    offV[i] = (unsigned)(vk * LD + vc) * 2u;
  }
  const int vb0 = (int)(uintptr_t)lds + TILE_B + v_rd_base(lane);
  PG8_LAS unsigned char* dma = (PG8_LAS unsigned char*)lds + wid * 1024;
#if ATT_PROBE == 1
  const int kc0 = 4 * g, NT = 4;
#else
  const int kc0 = (4 * g - 8) > 0 ? (4 * g - 8) : 0, NT = 4 * g + 4 - kc0;
#endif
#define A_ISSUE(j) do { const char* kb_ = Kh + (size_t)(kc0 + (j)) * (64 * LD * 2); const char* vb_ = kb_ + 2048; PG8_LAS unsigned char* d_ = dma + ((j) & 3) * (2 * TILE_B); \
    _Pragma("unroll") for (int i_ = 0; i_ < 2; ++i_) { \
      __builtin_amdgcn_global_load_lds((const unsigned*)(kb_ + offK[i_]), (PG8_LAS unsigned*)(d_ + i_ * 8192), 16, 0, 0); \
      __builtin_amdgcn_global_load_lds((const unsigned*)(vb_ + offV[i_]), (PG8_LAS unsigned*)(d_ + TILE_B + i_ * 8192), 16, 0, 0); } } while (0)
#define A_WAITB(k) do { if ((k) + 1 < NT) asm volatile("s_waitcnt vmcnt(4)" ::: "memory"); else asm volatile("s_waitcnt vmcnt(0)" ::: "memory"); \
    asm volatile("s_waitcnt lgkmcnt(0)" ::: "memory"); __builtin_amdgcn_s_barrier(); asm volatile("" ::: "memory"); } while (0)
#define A_VRD(D0, V) do { V[0] = tr_read<v_rd_off(D0, 0, 0)>(vbj); V[1] = tr_read<v_rd_off(D0, 0, 1)>(vbj); V[2] = tr_read<v_rd_off(D0, 1, 0)>(vbj); V[3] = tr_read<v_rd_off(D0, 1, 1)>(vbj); \
    V[4] = tr_read<v_rd_off(D0, 2, 0)>(vbj); V[5] = tr_read<v_rd_off(D0, 2, 1)>(vbj); V[6] = tr_read<v_rd_off(D0, 3, 0)>(vbj); V[7] = tr_read<v_rd_off(D0, 3, 1)>(vbj); } while (0)
#define A_TIE16(N, P, Q) asm volatile("s_waitcnt lgkmcnt(" #N ")" : "+v"(P[0]), "+v"(P[1]), "+v"(P[2]), "+v"(P[3]), "+v"(P[4]), "+v"(P[5]), "+v"(P[6]), "+v"(P[7]), \
    "+v"(Q[0]), "+v"(Q[1]), "+v"(Q[2]), "+v"(Q[3]), "+v"(Q[4]), "+v"(Q[5]), "+v"(Q[6]), "+v"(Q[7]) :: "memory")
#define A_TIE8(N, P) asm volatile("s_waitcnt lgkmcnt(" #N ")" : "+v"(P[0]), "+v"(P[1]), "+v"(P[2]), "+v"(P[3]), "+v"(P[4]), "+v"(P[5]), "+v"(P[6]), "+v"(P[7]) :: "memory")
#if ATT_PROBE == 3
#define A_PVMM(D0, V) do { } while (0)
#else
#define A_PVMM(D0, V) do { o[D0] = __builtin_amdgcn_mfma_f32_32x32x16_bf16(pa0, ATT_PK(V[0], V[1]), o[D0], 0, 0, 0); o[D0] = __builtin_amdgcn_mfma_f32_32x32x16_bf16(pa1, ATT_PK(V[2], V[3]), o[D0], 0, 0, 0); \
    o[D0] = __builtin_amdgcn_mfma_f32_32x32x16_bf16(pa2, ATT_PK(V[4], V[5]), o[D0], 0, 0, 0); o[D0] = __builtin_amdgcn_mfma_f32_32x32x16_bf16(pa3, ATT_PK(V[6], V[7]), o[D0], 0, 0, 0); } while (0)
#endif
#define A_FRONT(j, delta) do { const int so_ = ((j) & 3) * (2 * TILE_B); \
    if ((delta) >= 3) { const float bc = btab[191]; \
      _Pragma("unroll") for (int r = 0; r < 16; ++r) { p0[r] = bc; p1[r] = bc; } } \
    else { const int base = 64 * (delta) + qi + 63;                     \
      _Pragma("unroll") for (int r = 0; r < 16; ++r) { const int kl = crow(r, hi); int i0 = base - kl, i1 = base - kl - 32; i0 = i0 > 191 ? 191 : i0; i1 = i1 > 191 ? 191 : i1; p0[r] = btab[i0]; p1[r] = btab[i1]; } } \
    qkt3(p0, p1, ka0 + so_, kX, qr); \
    vbj = vb0 + so_; A_VRD(0, va); A_VRD(1, vb_); \
    partialSM(p0, p1, m_reg, mn, alpha); } while (0)
#define A_BACK(j) do { bf16x8 pa0, pa1, pa2, pa3; s16x4 vc[8], vd[8]; \
    if (__any(alpha < 1.f)) { if (hi == 0) al_l[r32] = alpha; asm volatile("s_waitcnt lgkmcnt(0)" ::: "memory"); \
      _Pragma("unroll") for (int d = 0; d < 4; ++d) _Pragma("unroll") for (int r = 0; r < 16; ++r) o[d][r] *= al_l[crow(r, hi)]; } \
    finishSM(p0, p1, alpha, l_reg, pa0, pa1, pa2, pa3); \
    A_VRD(2, vc); A_TIE16(8, va, vb_); A_PVMM(0, va); A_PVMM(1, vb_); \
    A_VRD(3, vd); A_TIE8(8, vc); A_PVMM(2, vc); A_TIE8(0, vd); A_PVMM(3, vd); } while (0)
  const int ka0 = (int)(uintptr_t)lds + r32 * 256, kX = (hi ^ KSWF(r32)) << 4;
  s16x4 va[8], vb_[8]; int vbj;
  f32x16 p0, p1; float mn, alpha;
  A_ISSUE(0); A_ISSUE(1);
  btab[tid < 192 ? tid : 192 + (tid & 63)] = relv * 1.4426950408889634f;
  if (wid < 4) {
    for (int j = 0; j < NT; ++j) {
      A_WAITB(j); if (j + 2 < NT) A_ISSUE(j + 2);
      const int delta = n - (kc0 + j);
      if (delta >= 0 && delta <= 8) { A_FRONT(j, delta); A_BACK(j); }
    }
  } else {
    A_WAITB(0); A_ISSUE(2);
    for (int j = 0; j < NT; ++j) {
      const int delta = n - (kc0 + j); const bool act = delta >= 0 && delta <= 8;
      if (act) A_FRONT(j, delta);
      if (j + 1 < NT) { A_WAITB(j + 1); if (j + 3 < NT) A_ISSUE(j + 3); }
      if (act) A_BACK(j);
    }
  }
#undef A_WAITB
#undef A_FRONT
#undef A_BACK
#undef A_VRD
#undef A_TIE16
#undef A_TIE8
#undef A_PVMM
#undef A_ISSUE
  if constexpr (PREF) ret_rows_load(b, h, g, PROJ, *pk, *pv);
  if (hi == 0) li_l[r32] = l_reg; asm volatile("s_waitcnt lgkmcnt(0)" ::: "memory");
  { bf16* stg = (bf16*)(lds + wid * 8192);
#pragma unroll
    for (int r = 0; r < 16; ++r) { const int orow = crow(r, hi); const float rl = __builtin_amdgcn_rcpf(li_l[orow]);
#pragma unroll
      for (int d0 = 0; d0 < 4; ++d0) { const unsigned w = cvtpk(o[d0][r] * rl, 0.f); stg[orow * 128 + d0 * 32 + r32] = (bf16)(w & 0xffffu); } }
    asm volatile("s_waitcnt lgkmcnt(0)" ::: "memory");
    bf16* Ow = MIX + ((long)b * 4096 + n * 64 + (wid & 1) * 32) * 2048 + 1024 + h * 128;
#pragma unroll
    for (int i = 0; i < 8; ++i) { const int row = i * 4 + (lane >> 4), ch = lane & 15; const u32x4 v = *(const u32x4*)(stg + row * 128 + ch * 8); *(u32x4*)(Ow + (long)row * 2048 + ch * 8) = v; } }
  __syncthreads();
}

constexpr int R_K = 0, R_V = 4 * TILE_B;
__device__ __forceinline__ bf16x8 scale8(bf16x8 x, float s) {
  const u32x4 w = *reinterpret_cast<const u32x4*>(&x); u32x4 o;
#pragma unroll
  for (int i = 0; i < 4; ++i) o[i] = cvtpk(__uint_as_float(w[i] << 16) * s, __uint_as_float(w[i] & 0xffff0000u) * s);
  return *reinterpret_cast<bf16x8*>(&o);
}
template <bool KIMG> __device__ __forceinline__ void ret_stage(int b, int h, int g, const bf16* __restrict__ PROJ, char* lds, float lg2h) {
  int tid_o = threadIdx.x; asm volatile("" : "+v"(tid_o)); const int tid = tid_o, c = __builtin_amdgcn_readfirstlane(tid >> 7), t2 = tid & 127, sr = t2 >> 4, sc = (t2 & 15) * 8;
  const bf16* Kc = PROJ + ((long)b * 4096 + (4 * g + c) * 64) * LD + 1024 + h * 128; const bf16* Vc = Kc + 1024;
  char* Kt = lds + R_K + c * TILE_B; char* Vt = lds + R_V + c * TILE_B;
  constexpr int NB = 1, PB = 8 / NB;
#pragma unroll
  for (int hb = 0; hb < NB; ++hb) {
    bf16x8 kv[PB], vv[PB];
#pragma unroll
    for (int i = 0; i < PB; ++i) { const int row = sr + 8 * (PB * hb + i); kv[i] = ld8(Kc + (long)row * LD + sc); vv[i] = ld8(Vc + (long)row * LD + sc); }
#pragma unroll
    for (int i = 0; i < PB; ++i) { const int row = sr + 8 * (PB * hb + i);
      if (KIMG) *(bf16x8*)(Kt + v_st(row, sc)) = scale8(kv[i], __builtin_amdgcn_exp2f(lg2h * (float)(63 - row)));
      else *(bf16x8*)(Kt + KSWZ(row, sc * 2)) = kv[i];
      *(bf16x8*)(Vt + v_st(row, sc)) = vv[i]; }
  }
  __syncthreads();
}
__device__ __forceinline__ void ret_rows_load(int b, int h, int g, const bf16* __restrict__ PROJ, bf16x8 (&kv)[8], bf16x8 (&vv)[8]) {
  int tid_o = threadIdx.x; asm volatile("" : "+v"(tid_o)); const int tid = tid_o, c = __builtin_amdgcn_readfirstlane(tid >> 7), t2 = tid & 127, sr = t2 >> 4, sc = (t2 & 15) * 8;
  const bf16* Pq = PROJ; asm volatile("" : "+s"(Pq));
  const bf16* Kc = Pq + ((long)b * 4096 + (4 * g + c) * 64) * LD + 1024 + h * 128; const bf16* Vc = Kc + 1024;
#pragma unroll
  for (int i = 0; i < 8; ++i) { const int row = sr + 8 * i; kv[i] = ld8(Kc + (long)row * LD + sc); vv[i] = ld8(Vc + (long)row * LD + sc); }
}
__device__ __forceinline__ void ret_rows_stage_img(const bf16x8 (&kv)[8], const bf16x8 (&vv)[8], char* lds, float lg2h) {
  int tid_o = threadIdx.x; asm volatile("" : "+v"(tid_o)); const int tid = tid_o, c = __builtin_amdgcn_readfirstlane(tid >> 7), t2 = tid & 127, sr = t2 >> 4, sc = (t2 & 15) * 8;
  char* Kt = lds + R_K + c * TILE_B; char* Vt = lds + R_V + c * TILE_B;
#pragma unroll
  for (int i = 0; i < 8; ++i) { const int row = sr + 8 * i;
    *(bf16x8*)(Kt + v_st(row, sc)) = scale8(kv[i], __builtin_amdgcn_exp2f(lg2h * (float)(63 - row)));
    *(bf16x8*)(Vt + v_st(row, sc)) = vv[i]; }
  __syncthreads();
}
template <int D0, int KS> __device__ __forceinline__ bf16x8 img_frag(int vb) {
  const s16x4 l = tr_read<v_rd_off(D0, KS, 0)>(vb), hh = tr_read<v_rd_off(D0, KS, 1)>(vb);
  asm volatile("s_waitcnt lgkmcnt(0)" ::: "memory"); SBAR();
  return ATT_PK(l, hh);
}
template <bool PRE = false> __device__ __forceinline__ void contrib_unit(int b, int h, int g, const bf16* __restrict__ PROJ, bf16* __restrict__ CONTRIB, bf16* __restrict__ AGG, char* lds, float lg2h, const bf16x8 (*pkv)[8] = nullptr, const bf16x8 (*pvv)[8] = nullptr) {
  if constexpr (PRE) ret_rows_stage_img(*pkv, *pvv, lds, lg2h); else ret_stage<true>(b, h, g, PROJ, lds, lg2h);
  int tid_o = threadIdx.x; asm volatile("" : "+v"(tid_o)); const int tid = tid_o, wid = __builtin_amdgcn_readfirstlane(tid >> 6), lane = tid & 63, r32 = lane & 31, hi = lane >> 5, c = wid >> 1, dvh = wid & 1;
  const int kb = (int)(uintptr_t)(lds + R_K + c * TILE_B) + v_rd_base(lane), vb = (int)(uintptr_t)(lds + R_V + c * TILE_B) + v_rd_base(lane);
  f32x16 acc[4][2] = {};
#define C_RD(D0, KS, B, L, H) const s16x4 L = tr_read<v_rd_off(D0, KS, 0)>(B), H = tr_read<v_rd_off(D0, KS, 1)>(B)
#define C_STEP(KS) do { bf16x8 v0, v1; { s16x4 v0l, v0h, v1l, v1h; if (dvh) { v0l = tr_read<v_rd_off(2, KS, 0)>(vb); v0h = tr_read<v_rd_off(2, KS, 1)>(vb); v1l = tr_read<v_rd_off(3, KS, 0)>(vb); v1h = tr_read<v_rd_off(3, KS, 1)>(vb); } \
      else { v0l = tr_read<v_rd_off(0, KS, 0)>(vb); v0h = tr_read<v_rd_off(0, KS, 1)>(vb); v1l = tr_read<v_rd_off(1, KS, 0)>(vb); v1h = tr_read<v_rd_off(1, KS, 1)>(vb); } \
      asm volatile("s_waitcnt lgkmcnt(0)" ::: "memory"); SBAR(); v0 = ATT_PK(v0l, v0h); v1 = ATT_PK(v1l, v1h); } \
    C_RD(0, KS, kb, k0l, k0h); C_RD(1, KS, kb, k1l, k1h); C_RD(2, KS, kb, k2l, k2h); C_RD(3, KS, kb, k3l, k3h); \
    asm volatile("s_waitcnt lgkmcnt(0)" ::: "memory"); SBAR();        \
    const bf16x8 ka0 = ATT_PK(k0l, k0h), ka1 = ATT_PK(k1l, k1h), ka2 = ATT_PK(k2l, k2h), ka3 = ATT_PK(k3l, k3h); \
    acc[0][0] = __builtin_amdgcn_mfma_f32_32x32x16_bf16(ka0, v0, acc[0][0], 0, 0, 0); acc[0][1] = __builtin_amdgcn_mfma_f32_32x32x16_bf16(ka0, v1, acc[0][1], 0, 0, 0); \
    acc[1][0] = __builtin_amdgcn_mfma_f32_32x32x16_bf16(ka1, v0, acc[1][0], 0, 0, 0); acc[1][1] = __builtin_amdgcn_mfma_f32_32x32x16_bf16(ka1, v1, acc[1][1], 0, 0, 0); \
    acc[2][0] = __builtin_amdgcn_mfma_f32_32x32x16_bf16(ka2, v0, acc[2][0], 0, 0, 0); acc[2][1] = __builtin_amdgcn_mfma_f32_32x32x16_bf16(ka2, v1, acc[2][1], 0, 0, 0); \
    acc[3][0] = __builtin_amdgcn_mfma_f32_32x32x16_bf16(ka3, v0, acc[3][0], 0, 0, 0); acc[3][1] = __builtin_amdgcn_mfma_f32_32x32x16_bf16(ka3, v1, acc[3][1], 0, 0, 0); } while (0)
  C_STEP(0); C_STEP(1); C_STEP(2); C_STEP(3);
#undef C_STEP
#undef C_RD
  const int unit = (b * 8 + h) * 64 + 4 * g + c;
  bf16* Cb = CONTRIB + (long)unit * 16384 + dvh * 64 * 128;
  __syncthreads();
  { char* stg = lds + wid * 16384;
#pragma unroll
    for (int dkb = 0; dkb < 4; ++dkb)
#pragma unroll
      for (int dvb = 0; dvb < 2; ++dvb) { const int row = 32 * dvb + r32;
#pragma unroll
        for (int rq = 0; rq < 4; ++rq) { const int dk = 32 * dkb + 8 * rq + 4 * hi; const f32x16& a = acc[dkb][dvb];
          u32x2 w; w.x = cvtpk(a[4 * rq], a[4 * rq + 1]); w.y = cvtpk(a[4 * rq + 2], a[4 * rq + 3]);
          *(u32x2*)(stg + row * 256 + ((((dk >> 3) ^ (row & 15)) << 4) | ((dk & 4) << 1))) = w; } }
    asm volatile("s_waitcnt lgkmcnt(0)" ::: "memory");
#pragma unroll
    for (int i = 0; i < 16; ++i) { const int row = i * 4 + (lane >> 4), ch = lane & 15; const u32x4 v = *(const u32x4*)(stg + row * 256 + ((ch ^ (row & 15)) << 4)); if (RET_STORE_CONTRIB) *(u32x4*)(Cb + row * 128 + ch * 8) = v; } }
  __syncthreads();
  { const float dec = __builtin_amdgcn_exp2f(lg2h * 64.f); const float w3 = dec * dec * dec, w2 = dec * dec;
    bf16* Ab = AGG + (long)((b * 8 + h) * 16 + g) * 16384;
#pragma unroll
    for (int i = 0; i < 4; ++i) { const int q = wid * 256 + i * 64 + lane, dv = q >> 4, ch = q & 15, row = dv & 63, srcw = dv >> 6;
      float a[8] = {0.f, 0.f, 0.f, 0.f, 0.f, 0.f, 0.f, 0.f};
#pragma unroll
      for (int cc = 0; cc < 4; ++cc) { const u32x4 v = *(const u32x4*)(lds + (2 * cc + srcw) * 16384 + row * 256 + ((ch ^ (row & 15)) << 4)); const float wgt = cc == 0 ? w3 : cc == 1 ? w2 : cc == 2 ? dec : 1.f;
#pragma unroll
        for (int e = 0; e < 4; ++e) { a[2 * e] += wgt * __uint_as_float(v[e] << 16); a[2 * e + 1] += wgt * __uint_as_float(v[e] & 0xffff0000u); } }
      u32x4 o; o.x = cvtpk(a[0], a[1]); o.y = cvtpk(a[2], a[3]); o.z = cvtpk(a[4], a[5]); o.w = cvtpk(a[6], a[7]);
      *(u32x4*)(Ab + q * 8) = o; } }
  __syncthreads();
}
__device__ __forceinline__ void state_build(int b, int h, int g, const bf16* __restrict__ AGG, const bf16* __restrict__ CONTRIB, bf16* __restrict__ PREV, float lg2h) {
  const int tid = threadIdx.x, wid = __builtin_amdgcn_readfirstlane(tid >> 6), lane = tid & 63;
  const float dec = __builtin_amdgcn_exp2f(lg2h * 64.f), D = __builtin_amdgcn_exp2f(lg2h * 256.f);
  const long toff = (long)(wid * 256 + lane) * 8;
  float S[4][8];
#pragma unroll
  for (int i = 0; i < 4; ++i)
#pragma unroll
    for (int e = 0; e < 8; ++e) S[i][e] = 0.f;
  const bf16* Ab = AGG + (long)((b * 8 + h) * 16) * 16384 + toff;
  const long ub = ((long)(b * 8 + h) * 64 + 4 * g) * 16384 + toff;
  u32x4 cv[3][4];
#pragma unroll
  for (int c = 0; c < 3; ++c)
#pragma unroll
    for (int i = 0; i < 4; ++i) cv[c][i] = *(const u32x4*)(CONTRIB + ub + (long)c * 16384 + i * 512);
#pragma unroll 1
  for (int g0 = 0; g0 < g; g0 += 4) {
    u32x4 v[4][4];
#pragma unroll
    for (int k = 0; k < 4; ++k) if (g0 + k < g) {
#pragma unroll
      for (int i = 0; i < 4; ++i) v[k][i] = *(const u32x4*)(Ab + (long)(g0 + k) * 16384 + i * 512); }
#pragma unroll
    for (int k = 0; k < 4; ++k) if (g0 + k < g) {
#pragma unroll
      for (int i = 0; i < 4; ++i)
#pragma unroll
        for (int e = 0; e < 4; ++e) { S[i][2 * e] = D * S[i][2 * e] + __uint_as_float(v[k][i][e] << 16); S[i][2 * e + 1] = D * S[i][2 * e + 1] + __uint_as_float(v[k][i][e] & 0xffff0000u); } }
  }
#pragma unroll
  for (int c = 0; c < 4; ++c) {
#pragma unroll
    for (int i = 0; i < 4; ++i) { u32x4 o; o.x = cvtpk(S[i][0], S[i][1]); o.y = cvtpk(S[i][2], S[i][3]); o.z = cvtpk(S[i][4], S[i][5]); o.w = cvtpk(S[i][6], S[i][7]);
      *(u32x4*)(PREV + ub + (long)c * 16384 + i * 512) = o; }
    if (c < 3) {
#pragma unroll
      for (int i = 0; i < 4; ++i)
#pragma unroll
        for (int e = 0; e < 4; ++e) { S[i][2 * e] = dec * S[i][2 * e] + __uint_as_float(cv[c][i][e] << 16); S[i][2 * e + 1] = dec * S[i][2 * e + 1] + __uint_as_float(cv[c][i][e] & 0xffff0000u); } }
  }
  asm volatile("s_waitcnt vmcnt(0)" ::: "memory");
  __syncthreads();
}
template <int RT_EXP = 0> __device__ __forceinline__ void retout_unit(int b, int h, int g, const bf16* __restrict__ PROJ, const bf16* __restrict__ PREV, const float* __restrict__ gn, bf16* __restrict__ MIX, char* lds, float* dtab, float lg2h) {
  const int tid = threadIdx.x, wid = __builtin_amdgcn_readfirstlane(tid >> 6), lane = tid & 63, r32 = lane & 31, hi = lane >> 5, c = wid >> 1;
  if (tid < 64) dtab[tid] = __builtin_amdgcn_exp2f(lg2h * (float)tid);
  const int n = 4 * g + c, qi = (wid & 1) * 32 + r32;
  const long rowq = (long)b * 4096 + n * 64 + qi;
  bf16x8 qr[8];
  { const bf16* Qw = PROJ + rowq * LD + h * 128 + hi * 8;
#pragma unroll
    for (int d0 = 0; d0 < 8; ++d0) qr[d0] = ld8(Qw + d0 * 16); }
  ret_stage<false>(b, h, g, PROJ, lds, lg2h);
  f32x16 p0 = {}, p1 = {};
  if (RT_EXP != 2) qkt<false>(p0, p1, lds + R_K + c * TILE_B, qr, r32, hi);
  { const float iq = __builtin_amdgcn_exp2f(-lg2h * (float)(qi + 1));
#pragma unroll
    for (int r = 0; r < 16; ++r) { const int kl = crow(r, hi); const int d0 = qi > kl ? qi - kl : kl - qi; const int d1 = qi > kl + 32 ? qi - kl - 32 : kl + 32 - qi;
      p0[r] *= dtab[d0] * iq; p1[r] *= dtab[d1] * iq; } }
  bf16x8 pa0, pa1, pa2, pa3;
  ATT_PK4(p0, 0, pa0); ATT_PK4(p0, 8, pa1); ATT_PK4(p1, 0, pa2); ATT_PK4(p1, 8, pa3);
  f32x16 o[4] = {};
  if (RT_EXP != 2) pv_d0<true>(o, (int)(uintptr_t)(lds + R_V + c * TILE_B) + v_rd_base(lane), pa0, pa1, pa2, pa3);
  if (RT_EXP != 1) { const int unit = (b * 8 + h) * 64 + n; const bf16* Pb = PREV + (long)unit * 16384 + hi * 8;
#pragma unroll
    for (int d0 = 0; d0 < 4; ++d0) { bf16x8 a[8]; asm volatile("" ::: "memory");
#pragma unroll
      for (int s = 0; s < 8; ++s) a[s] = ld8(Pb + (32 * d0 + r32) * 128 + 16 * s);
#pragma unroll
      for (int s = 0; s < 8; ++s) o[d0] = __builtin_amdgcn_mfma_f32_32x32x16_bf16(a[s], qr[s], o[d0], 0, 0, 0); } }
  float s1 = 0.f;
#pragma unroll
  for (int d0 = 0; d0 < 4; ++d0)
#pragma unroll
    for (int r = 0; r < 16; ++r) s1 += o[d0][r];
  { auto rr = __builtin_amdgcn_permlane32_swap(__float_as_uint(s1), __float_as_uint(s1), false, false); s1 = __uint_as_float(rr[0]) + __uint_as_float(rr[1]); }
  const float mu = s1 * (1.f / 128.f); float s2 = 0.f;
#pragma unroll
  for (int d0 = 0; d0 < 4; ++d0)
#pragma unroll
    for (int r = 0; r < 16; ++r) { o[d0][r] -= mu; s2 += o[d0][r] * o[d0][r]; }
  { auto rr = __builtin_amdgcn_permlane32_swap(__float_as_uint(s2), __float_as_uint(s2), false, false); s2 = __uint_as_float(rr[0]) + __uint_as_float(rr[1]); }
  const float qd = __builtin_amdgcn_exp2f(lg2h * (float)(qi + 1));
  const float sc = qd / sqrtf(qd * qd * s2 * (1.f / 128.f) + 1e-5f);
  const bf16* Gq = PROJ + rowq * LD + 3072 + h * 128; const float* gnh = gn + h * 128;
  __syncthreads();
  { char* stg = lds + wid * 8192;
#pragma unroll
    for (int d0 = 0; d0 < 4; ++d0) { asm volatile("" ::: "memory");
#pragma unroll
      for (int rq = 0; rq < 4; ++rq) { const int dv = 32 * d0 + 8 * rq + 4 * hi;
        const u32x2 gt = *(const u32x2*)(Gq + dv); const f32x4 gg = *(const f32x4*)(gnh + dv);
        const float y0 = o[d0][4 * rq] * sc * gg[0] * __uint_as_float(gt.x << 16), y1 = o[d0][4 * rq + 1] * sc * gg[1] * __uint_as_float(gt.x & 0xffff0000u);
        const float y2 = o[d0][4 * rq + 2] * sc * gg[2] * __uint_as_float(gt.y << 16), y3 = o[d0][4 * rq + 3] * sc * gg[3] * __uint_as_float(gt.y & 0xffff0000u);
        u32x2 w; w.x = cvtpk(y0, y1); w.y = cvtpk(y2, y3);
        *(u32x2*)(stg + r32 * 256 + ((((dv >> 3) ^ (r32 & 15)) << 4) | ((dv & 4) << 1))) = w; } }
    asm volatile("s_waitcnt lgkmcnt(0)" ::: "memory");
    bf16* Ow = MIX + ((long)b * 4096 + n * 64 + (wid & 1) * 32) * 2048 + h * 128;
#pragma unroll
    for (int i = 0; i < 8; ++i) { const int row = i * 4 + (lane >> 4), ch = lane & 15; const u32x4 v = *(const u32x4*)(stg + row * 256 + ((ch ^ (row & 15)) << 4)); *(u32x4*)(Ow + (long)row * 2048 + ch * 8) = v; } }
  __syncthreads();
}
__device__ __forceinline__ void retout_unit2(int b, int h, int g, const bf16* __restrict__ PROJ, const bf16* __restrict__ AGG, const bf16* __restrict__ CONTRIB, const float* __restrict__ gn,
                                             bf16* __restrict__ MIX, char* lds, float* dtab, float lg2h) {
  int tid_ = threadIdx.x; asm volatile("" : "+v"(tid_));
  const int tid = tid_, wid = __builtin_amdgcn_readfirstlane(tid >> 6), lane = tid & 63, r32 = lane & 31, hi = lane >> 5, c = wid >> 1;
  if (tid < 64) dtab[tid] = __builtin_amdgcn_exp2f(lg2h * (float)tid);
  const int n = 4 * g + c, qi = (wid & 1) * 32 + r32;
  const long rowq = (long)b * 4096 + n * 64 + qi;
  { const float dec = __builtin_amdgcn_exp2f(lg2h * 64.f), D = __builtin_amdgcn_exp2f(lg2h * 256.f);
    const long toff = (long)(wid * 256 + lane) * 8;
    float S[4][8];
#pragma unroll
    for (int i = 0; i < 4; ++i)
#pragma unroll
      for (int e = 0; e < 8; ++e) S[i][e] = 0.f;
    const bf16* Ab = AGG + (long)((b * 8 + h) * 16) * 16384 + toff;
    const long ub = ((long)(b * 8 + h) * 64 + 4 * g) * 16384 + toff;
#pragma unroll 1
    for (int g0 = 0; g0 < g; g0 += 4) {
      u32x4 v[4][4];
#pragma unroll
      for (int k = 0; k < 4; ++k) if (g0 + k < g) {
#pragma unroll
        for (int i = 0; i < 4; ++i) v[k][i] = *(const u32x4*)(Ab + (long)(g0 + k) * 16384 + i * 512); }
#pragma unroll
      for (int k = 0; k < 4; ++k) if (g0 + k < g) {
#pragma unroll
        for (int i = 0; i < 4; ++i)
#pragma unroll
          for (int e = 0; e < 4; ++e) { S[i][2 * e] = D * S[i][2 * e] + __uint_as_float(v[k][i][e] << 16); S[i][2 * e + 1] = D * S[i][2 * e + 1] + __uint_as_float(v[k][i][e] & 0xffff0000u); } }
    }
    u32x4 cv[3][4];
#pragma unroll
    for (int cc = 0; cc < 3; ++cc)
#pragma unroll
      for (int i = 0; i < 4; ++i) cv[cc][i] = *(const u32x4*)(CONTRIB + ub + (long)cc * 16384 + i * 512);
#pragma unroll
    for (int cc = 0; cc < 4; ++cc) {
#pragma unroll
      for (int i = 0; i < 4; ++i) { const int q = wid * 256 + i * 64 + lane, dv = q >> 4, ch = q & 15;
        u32x4 o4; o4.x = cvtpk(S[i][0], S[i][1]); o4.y = cvtpk(S[i][2], S[i][3]); o4.z = cvtpk(S[i][4], S[i][5]); o4.w = cvtpk(S[i][6], S[i][7]);
        *(u32x4*)(lds + cc * 32768 + dv * 256 + ((ch ^ (dv & 15)) << 4)) = o4; }
      if (cc < 3) {
#pragma unroll
        for (int i = 0; i < 4; ++i)
#pragma unroll
          for (int e = 0; e < 4; ++e) { S[i][2 * e] = dec * S[i][2 * e] + __uint_as_float(cv[cc][i][e] << 16); S[i][2 * e + 1] = dec * S[i][2 * e + 1] + __uint_as_float(cv[cc][i][e] & 0xffff0000u); } }
    }
  }
  bf16x8 qr[8];
  { const bf16* Qw = PROJ + rowq * LD + h * 128 + hi * 8;
#pragma unroll
    for (int d0 = 0; d0 < 8; ++d0) qr[d0] = ld8(Qw + d0 * 16); }
  __syncthreads();
  f32x16 o[4] = {};
  { const char* Pl = lds + c * 32768;
#pragma unroll
    for (int d0 = 0; d0 < 4; ++d0) { const int dv = 32 * d0 + r32; bf16x8 a[8];
#pragma unroll
      for (int s = 0; s < 8; ++s) a[s] = *reinterpret_cast<const bf16x8*>(Pl + dv * 256 + ((((2 * s + hi)) ^ (dv & 15)) << 4));
#pragma unroll
      for (int s = 0; s < 8; ++s) o[d0] = __builtin_amdgcn_mfma_f32_32x32x16_bf16(a[s], qr[s], o[d0], 0, 0, 0); } }
  __syncthreads();
  ret_stage<false>(b, h, g, PROJ, lds, lg2h);
  { f32x16 p0 = {}, p1 = {};
    qkt<false>(p0, p1, lds + R_K + c * TILE_B, qr, r32, hi);
    const float iq = __builtin_amdgcn_exp2f(-lg2h * (float)(qi + 1));
#pragma unroll
    for (int r = 0; r < 16; ++r) { const int kl = crow(r, hi); const int d0 = qi > kl ? qi - kl : kl - qi; const int d1 = qi > kl + 32 ? qi - kl - 32 : kl + 32 - qi;
      p0[r] *= dtab[d0] * iq; p1[r] *= dtab[d1] * iq; }
    bf16x8 pa0, pa1, pa2, pa3;
    ATT_PK4(p0, 0, pa0); ATT_PK4(p0, 8, pa1); ATT_PK4(p1, 0, pa2); ATT_PK4(p1, 8, pa3);
    pv_d0<true>(o, (int)(uintptr_t)(lds + R_V + c * TILE_B) + v_rd_base(lane), pa0, pa1, pa2, pa3); }
  float s1 = 0.f;
#pragma unroll
  for (int d0 = 0; d0 < 4; ++d0)
#pragma unroll
    for (int r = 0; r < 16; ++r) s1 += o[d0][r];
  { auto rr = __builtin_amdgcn_permlane32_swap(__float_as_uint(s1), __float_as_uint(s1), false, false); s1 = __uint_as_float(rr[0]) + __uint_as_float(rr[1]); }
  const float mu = s1 * (1.f / 128.f); float s2 = 0.f;
#pragma unroll
  for (int d0 = 0; d0 < 4; ++d0)
#pragma unroll
    for (int r = 0; r < 16; ++r) { o[d0][r] -= mu; s2 += o[d0][r] * o[d0][r]; }
  { auto rr = __builtin_amdgcn_permlane32_swap(__float_as_uint(s2), __float_as_uint(s2), false, false); s2 = __uint_as_float(rr[0]) + __uint_as_float(rr[1]); }
  const float qd = __builtin_amdgcn_exp2f(lg2h * (float)(qi + 1));
  const float sc = qd / sqrtf(qd * qd * s2 * (1.f / 128.f) + 1e-5f);
  __syncthreads();
  { char* stg = lds + wid * 16384;
#pragma unroll
    for (int d0 = 0; d0 < 4; ++d0)
#pragma unroll
      for (int rq = 0; rq < 4; ++rq) { const int ch = 8 * d0 + 2 * rq + hi;
        const f32x4 y = {o[d0][4 * rq] * sc, o[d0][4 * rq + 1] * sc, o[d0][4 * rq + 2] * sc, o[d0][4 * rq + 3] * sc};
        *(f32x4*)(stg + r32 * 512 + ((ch ^ r32) << 4)) = y; }
    asm volatile("s_waitcnt lgkmcnt(0)" ::: "memory");
    const long row0g = (long)b * 4096 + n * 64 + (wid & 1) * 32;
    const float* gnh = gn + h * 128;
#pragma unroll
    for (int i = 0; i < 8; ++i) { if ((i & 3) == 0) asm volatile("" ::: "memory"); const int row = i * 4 + (lane >> 4), c8 = lane & 15;
      const f32x4 ya = *(const f32x4*)(stg + row * 512 + (((2 * c8) ^ row) << 4)), yb = *(const f32x4*)(stg + row * 512 + (((2 * c8 + 1) ^ row) << 4));
      const u32x4 gt = *(const u32x4*)(PROJ + (row0g + row) * LD + 3072 + h * 128 + c8 * 8);
      const f32x4 ga = *(const f32x4*)(gnh + c8 * 8), gb = *(const f32x4*)(gnh + c8 * 8 + 4);
      u32x4 w;
      w.x = cvtpk(ya[0] * ga[0] * __uint_as_float(gt.x << 16), ya[1] * ga[1] * __uint_as_float(gt.x & 0xffff0000u));
      w.y = cvtpk(ya[2] * ga[2] * __uint_as_float(gt.y << 16), ya[3] * ga[3] * __uint_as_float(gt.y & 0xffff0000u));
      w.z = cvtpk(yb[0] * gb[0] * __uint_as_float(gt.z << 16), yb[1] * gb[1] * __uint_as_float(gt.z & 0xffff0000u));
      w.w = cvtpk(yb[2] * gb[2] * __uint_as_float(gt.w << 16), yb[3] * gb[3] * __uint_as_float(gt.w & 0xffff0000u));
      *(u32x4*)(MIX + (row0g + row) * 2048 + h * 128 + c8 * 8) = w; } }
  __syncthreads();
}

__device__ __forceinline__ void retout_unit3(int b, int h, int g, const bf16* __restrict__ PROJ, const bf16* __restrict__ AGG, const bf16* __restrict__ CONTRIB, const float* __restrict__ gn,
                                             bf16* __restrict__ MIX, char* lds, float* dtab, float lg2h) {
  int tid_ = threadIdx.x; asm volatile("" : "+v"(tid_));
  const int tid = tid_, wid = __builtin_amdgcn_readfirstlane(tid >> 6), lane = tid & 63, r32 = lane & 31, hi = lane >> 5, c = wid >> 1;
  if (tid < 64) dtab[tid] = __builtin_amdgcn_exp2f(lg2h * (float)tid);
  const int n = 4 * g + c, qi = (wid & 1) * 32 + r32;
  const long rowq = (long)b * 4096 + n * 64 + qi;
  { const float dec = __builtin_amdgcn_exp2f(lg2h * 64.f), D = __builtin_amdgcn_exp2f(lg2h * 256.f);
    const long toff = (long)(wid * 256 + lane) * 8;
    float S[4][8];
#pragma unroll
    for (int i = 0; i < 4; ++i)
#pragma unroll
      for (int e = 0; e < 8; ++e) S[i][e] = 0.f;
    const bf16* Ab = AGG + (long)((b * 8 + h) * 16) * 16384 + toff;
    const long ub = ((long)(b * 8 + h) * 64 + 4 * g) * 16384 + toff;
#define LB_LOAD(V, gb) do { _Pragma("unroll") for (int k = 0; k < 4; ++k) if ((gb) + k < g) { _Pragma("unroll") for (int i = 0; i < 4; ++i) V[k][i] = *(const u32x4*)(Ab + (long)((gb) + k) * 16384 + i * 512); } } while (0)
#define LB_ACC(V, gb) do { _Pragma("unroll") for (int k = 0; k < 4; ++k) if ((gb) + k < g) { _Pragma("unroll") for (int i = 0; i < 4; ++i) _Pragma("unroll") for (int e = 0; e < 4; ++e) { \
      S[i][2 * e] = D * S[i][2 * e] + __uint_as_float(V[k][i][e] << 16); S[i][2 * e + 1] = D * S[i][2 * e + 1] + __uint_as_float(V[k][i][e] & 0xffff0000u); } } } while (0)
    u32x4 va[4][4], vb[4][4], cv[3][4];
    LB_LOAD(va, 0); LB_LOAD(vb, 4);
#pragma unroll
    for (int cc = 0; cc < 3; ++cc)
#pragma unroll
      for (int i = 0; i < 4; ++i) cv[cc][i] = *(const u32x4*)(CONTRIB + ub + (long)cc * 16384 + i * 512);
#pragma unroll 1
    for (int g0 = 0; g0 < g; g0 += 8) {
      LB_ACC(va, g0);
      if (g0 + 8 < g) LB_LOAD(va, g0 + 8);
      if (g0 + 4 < g) { LB_ACC(vb, g0 + 4); if (g0 + 12 < g) LB_LOAD(vb, g0 + 12); }
    }
#undef LB_LOAD
#undef LB_ACC
#pragma unroll
    for (int cc = 0; cc < 4; ++cc) {
#pragma unroll
      for (int i = 0; i < 4; ++i) { const int q = wid * 256 + i * 64 + lane, dv = q >> 4, ch = q & 15;
        u32x4 o4; o4.x = cvtpk(S[i][0], S[i][1]); o4.y = cvtpk(S[i][2], S[i][3]); o4.z = cvtpk(S[i][4], S[i][5]); o4.w = cvtpk(S[i][6], S[i][7]);
        *(u32x4*)(lds + cc * 32768 + dv * 256 + ((ch ^ (dv & 15)) << 4)) = o4; }
      if (cc < 3) {
#pragma unroll
        for (int i = 0; i < 4; ++i)
#pragma unroll
          for (int e = 0; e < 4; ++e) { S[i][2 * e] = dec * S[i][2 * e] + __uint_as_float(cv[cc][i][e] << 16); S[i][2 * e + 1] = dec * S[i][2 * e + 1] + __uint_as_float(cv[cc][i][e] & 0xffff0000u); } }
    }
  }
  bf16x8 qr[8];
  { const bf16* Qw = PROJ + rowq * LD + h * 128 + hi * 8;
#pragma unroll
    for (int d0 = 0; d0 < 8; ++d0) qr[d0] = ld8(Qw + d0 * 16); }
  __syncthreads();
  const int kc_ = __builtin_amdgcn_readfirstlane(tid >> 7), kt2 = tid & 127, ksr = kt2 >> 4, ksc = (kt2 & 15) * 8;
  bf16x8 kvr[8], vvr[8];
  { const bf16* Kc = PROJ + ((long)b * 4096 + (4 * g + kc_) * 64) * LD + 1024 + h * 128; const bf16* Vc = Kc + 1024;
#pragma unroll
    for (int i = 0; i < 8; ++i) { kvr[i] = ld8(Kc + (long)(ksr + 8 * i) * LD + ksc); vvr[i] = ld8(Vc + (long)(ksr + 8 * i) * LD + ksc); } }
  f32x16 o[4] = {};
  { const char* Pl = lds + c * 32768;
#pragma unroll
    for (int d0 = 0; d0 < 4; ++d0) { const int dv = 32 * d0 + r32; bf16x8 a[8];
#pragma unroll
      for (int s = 0; s < 8; ++s) a[s] = *reinterpret_cast<const bf16x8*>(Pl + dv * 256 + ((((2 * s + hi)) ^ (dv & 15)) << 4));
#pragma unroll
      for (int s = 0; s < 8; ++s) o[d0] = __builtin_amdgcn_mfma_f32_32x32x16_bf16(a[s], qr[s], o[d0], 0, 0, 0); } }
  __syncthreads();
  { char* Kt = lds + R_K + kc_ * TILE_B; char* Vt = lds + R_V + kc_ * TILE_B;
#pragma unroll
    for (int i = 0; i < 8; ++i) { const int row = ksr + 8 * i; *(bf16x8*)(Kt + KSWZ(row, ksc * 2)) = kvr[i]; *(bf16x8*)(Vt + v_st(row, ksc)) = vvr[i]; } }
  __syncthreads();
  u32x4 gt[8];
  const long row0g = (long)b * 4096 + n * 64 + (wid & 1) * 32;
  { f32x16 p0 = {}, p1 = {};
    qkt<false>(p0, p1, lds + R_K + c * TILE_B, qr, r32, hi);
    const float iq = __builtin_amdgcn_exp2f(-lg2h * (float)(qi + 1));
#pragma unroll
    for (int r = 0; r < 16; ++r) { const int kl = crow(r, hi); const int d0 = qi > kl ? qi - kl : kl - qi; const int d1 = qi > kl + 32 ? qi - kl - 32 : kl + 32 - qi;
      p0[r] *= dtab[d0] * iq; p1[r] *= dtab[d1] * iq; }
    bf16x8 pa0, pa1, pa2, pa3;
    ATT_PK4(p0, 0, pa0); ATT_PK4(p0, 8, pa1); ATT_PK4(p1, 0, pa2); ATT_PK4(p1, 8, pa3);
#pragma unroll
    for (int i = 0; i < 8; ++i) gt[i] = *(const u32x4*)(PROJ + (row0g + i * 4 + (lane >> 4)) * LD + 3072 + h * 128 + (lane & 15) * 8);
    pv_d0<true>(o, (int)(uintptr_t)(lds + R_V + c * TILE_B) + v_rd_base(lane), pa0, pa1, pa2, pa3); }
  float s1 = 0.f;
#pragma unroll
  for (int d0 = 0; d0 < 4; ++d0)
#pragma unroll
    for (int r = 0; r < 16; ++r) s1 += o[d0][r];
  { auto rr = __builtin_amdgcn_permlane32_swap(__float_as_uint(s1), __float_as_uint(s1), false, false); s1 = __uint_as_float(rr[0]) + __uint_as_float(rr[1]); }
  const float mu = s1 * (1.f / 128.f); float s2 = 0.f;
#pragma unroll
  for (int d0 = 0; d0 < 4; ++d0)
#pragma unroll
    for (int r = 0; r < 16; ++r) { o[d0][r] -= mu; s2 += o[d0][r] * o[d0][r]; }
  { auto rr = __builtin_amdgcn_permlane32_swap(__float_as_uint(s2), __float_as_uint(s2), false, false); s2 = __uint_as_float(rr[0]) + __uint_as_float(rr[1]); }
  const float qd = __builtin_amdgcn_exp2f(lg2h * (float)(qi + 1));
  const float sc = qd / sqrtf(qd * qd * s2 * (1.f / 128.f) + 1e-5f);
  __syncthreads();
  { char* stg = lds + wid * 16384;
#pragma unroll
    for (int d0 = 0; d0 < 4; ++d0)
#pragma unroll
      for (int rq = 0; rq < 4; ++rq) { const int ch = 8 * d0 + 2 * rq + hi;
        const f32x4 y = {o[d0][4 * rq] * sc, o[d0][4 * rq + 1] * sc, o[d0][4 * rq + 2] * sc, o[d0][4 * rq + 3] * sc};
        *(f32x4*)(stg + r32 * 512 + ((ch ^ r32) << 4)) = y; }
    asm volatile("s_waitcnt lgkmcnt(0)" ::: "memory");
    const float* gnh = gn + h * 128;
    const f32x4 ga = *(const f32x4*)(gnh + (lane & 15) * 8), gb = *(const f32x4*)(gnh + (lane & 15) * 8 + 4);
#pragma unroll
    for (int i = 0; i < 8; ++i) { const int row = i * 4 + (lane >> 4), c8 = lane & 15;
      const f32x4 ya = *(const f32x4*)(stg + row * 512 + (((2 * c8) ^ row) << 4)), yb = *(const f32x4*)(stg + row * 512 + (((2 * c8 + 1) ^ row) << 4));
      u32x4 w;
      w.x = cvtpk(ya[0] * ga[0] * __uint_as_float(gt[i].x << 16), ya[1] * ga[1] * __uint_as_float(gt[i].x & 0xffff0000u));
      w.y = cvtpk(ya[2] * ga[2] * __uint_as_float(gt[i].y << 16), ya[3] * ga[3] * __uint_as_float(gt[i].y & 0xffff0000u));
      w.z = cvtpk(yb[0] * gb[0] * __uint_as_float(gt[i].z << 16), yb[1] * gb[1] * __uint_as_float(gt[i].z & 0xffff0000u));
      w.w = cvtpk(yb[2] * gb[2] * __uint_as_float(gt[i].w << 16), yb[3] * gb[3] * __uint_as_float(gt[i].w & 0xffff0000u));
      *(u32x4*)(MIX + (row0g + row) * 2048 + h * 128 + c8 * 8) = w; } }
  __syncthreads();
}

__device__ __forceinline__ void retout_unit4(int b, int h, int g, const bf16* __restrict__ PROJ, const bf16* __restrict__ AGG, const bf16* __restrict__ CONTRIB, const float* __restrict__ gn,
                                             bf16* __restrict__ MIX, char* lds, float* dtab, float lg2h) {
  int tid_ = threadIdx.x; asm volatile("" : "+v"(tid_));
  const int tid = tid_, wid = __builtin_amdgcn_readfirstlane(tid >> 6), lane = tid & 63, r32 = lane & 31, hi = lane >> 5, c = wid >> 1;
#if RT_PROBE
#define RT_STAMP(k) do { if (blockIdx.x == 0 && tid == 0) { const unsigned long long t_ = __builtin_amdgcn_s_memrealtime(); volatile unsigned* m_ = (volatile unsigned*)(lds + 139584); m_[32 + 2 * (k)] = (unsigned)t_; m_[33 + 2 * (k)] = (unsigned)(t_ >> 32); } } while (0)
#else
#define RT_STAMP(k) do { } while (0)
#endif
  RT_STAMP(10);
  if (tid < 192) dtab[tid] = __builtin_amdgcn_exp2f(lg2h * (float)tid);
  const int n = 4 * g + c, qi = (wid & 1) * 32 + r32;
  const long rowq = (long)b * 4096 + n * 64 + qi;
  bf16x8 qr[8];
  { const bf16* Qw = PROJ + rowq * LD + h * 128 + hi * 8;
#pragma unroll
    for (int d0 = 0; d0 < 8; ++d0) qr[d0] = ld8(Qw + d0 * 16); }
  { const float dec = __builtin_amdgcn_exp2f(lg2h * 64.f), D = __builtin_amdgcn_exp2f(lg2h * 256.f);
    const long toff = (long)(wid * 256 + lane) * 8;
    float S[4][8];
#pragma unroll
    for (int i = 0; i < 4; ++i)
#pragma unroll
      for (int e = 0; e < 8; ++e) S[i][e] = 0.f;
    const bf16* Ab = AGG + (long)((b * 8 + h) * 16) * 16384 + toff;
    const long ub = ((long)(b * 8 + h) * 64 + 4 * g) * 16384 + toff;
#define LB_LOAD(V, gb) do { _Pragma("unroll") for (int k = 0; k < 4; ++k) if ((gb) + k < g) { _Pragma("unroll") for (int i = 0; i < 4; ++i) V[k][i] = *(const u32x4*)(Ab + (long)((gb) + k) * 16384 + i * 512); } } while (0)
#define LB_ACC(V, gb) do { _Pragma("unroll") for (int k = 0; k < 4; ++k) if ((gb) + k < g) { _Pragma("unroll") for (int i = 0; i < 4; ++i) _Pragma("unroll") for (int e = 0; e < 4; ++e) { \
      S[i][2 * e] = D * S[i][2 * e] + __uint_as_float(V[k][i][e] << 16); S[i][2 * e + 1] = D * S[i][2 * e + 1] + __uint_as_float(V[k][i][e] & 0xffff0000u); } } } while (0)
    u32x4 va[4][4], vb[4][4];
    LB_LOAD(va, 0); LB_LOAD(vb, 4);
#pragma unroll 1
    for (int g0 = 0; g0 < g; g0 += 8) {
      LB_ACC(va, g0);
      if (g0 + 8 < g) LB_LOAD(va, g0 + 8);
      if (g0 + 4 < g) { LB_ACC(vb, g0 + 4); if (g0 + 12 < g) LB_LOAD(vb, g0 + 12); }
    }
#undef LB_LOAD
#undef LB_ACC
#pragma unroll
    for (int i = 0; i < 4; ++i) { const int q = wid * 256 + i * 64 + lane, dv = q >> 4, ch = q & 15;
      u32x4 o4; o4.x = cvtpk(S[i][0], S[i][1]); o4.y = cvtpk(S[i][2], S[i][3]); o4.z = cvtpk(S[i][4], S[i][5]); o4.w = cvtpk(S[i][6], S[i][7]);
      *(u32x4*)(lds + dv * 256 + ((ch ^ (dv & 15)) << 4)) = o4; }
  }
  __syncthreads(); RT_STAMP(11);
  const int kc_ = __builtin_amdgcn_readfirstlane(tid >> 7), kt2 = tid & 127, ksr = kt2 >> 4, ksc = (kt2 & 15) * 8;
  bf16x8 kvr[8], vvr[8];
  { const bf16* Kc = PROJ + ((long)b * 4096 + (4 * g + kc_) * 64) * LD + 1024 + h * 128; const bf16* Vc = Kc + 1024;
#pragma unroll
    for (int i = 0; i < 8; ++i) { kvr[i] = ld8(Kc + (long)(ksr + 8 * i) * LD + ksc); vvr[i] = ld8(Vc + (long)(ksr + 8 * i) * LD + ksc); } }
  f32x16 o[4] = {};
  { const char* Pl = lds;
#pragma unroll
    for (int d0 = 0; d0 < 4; ++d0) { const int dv = 32 * d0 + r32; bf16x8 a[8];
#pragma unroll
      for (int s = 0; s < 8; ++s) a[s] = *reinterpret_cast<const bf16x8*>(Pl + dv * 256 + ((((2 * s + hi)) ^ (dv & 15)) << 4));
#pragma unroll
      for (int s = 0; s < 8; ++s) o[d0] = __builtin_amdgcn_mfma_f32_32x32x16_bf16(a[s], qr[s], o[d0], 0, 0, 0); }
    const float dc = __builtin_amdgcn_exp2f(lg2h * 64.f * (float)c);
#pragma unroll
    for (int d0 = 0; d0 < 4; ++d0)
#pragma unroll
      for (int r = 0; r < 16; ++r) o[d0][r] *= dc; }
  __syncthreads(); RT_STAMP(12);
  { char* Kt = lds + R_K + kc_ * TILE_B; char* Vt = lds + R_V + kc_ * TILE_B;
#pragma unroll
    for (int i = 0; i < 8; ++i) { const int row = ksr + 8 * i; *(bf16x8*)(Kt + KSWZ(row, ksc * 2)) = kvr[i]; *(bf16x8*)(Vt + v_st(row, ksc)) = vvr[i]; } }
  __syncthreads(); RT_STAMP(13);
  u32x4 gt[8];
  const long row0g = (long)b * 4096 + n * 64 + (wid & 1) * 32;
#pragma unroll
  for (int i = 0; i < 8; ++i) gt[i] = *(const u32x4*)(PROJ + (row0g + i * 4 + (lane >> 4)) * LD + 3072 + h * 128 + (lane & 15) * 8);
  const f32x4 ga = *(const f32x4*)(gn + h * 128 + (lane & 15) * 8), gb = *(const f32x4*)(gn + h * 128 + (lane & 15) * 8 + 4);
  const float iq = __builtin_amdgcn_exp2f(-lg2h * (float)(qi + 1));
#pragma unroll 1
  for (int cp = 0; cp < c; ++cp) {
    f32x16 p0 = {}, p1 = {};
    qkt<false>(p0, p1, lds + R_K + cp * TILE_B, qr, r32, hi);
    const float* dt = dtab + 64 * (c - 1 - cp) + 63 - 4 * hi;
#pragma unroll
    for (int r = 0; r < 16; ++r) { const int k0 = (r & 3) + 8 * (r >> 2); p0[r] *= dt[-k0]; p1[r] *= dt[-k0 - 32]; }
    bf16x8 pa0, pa1, pa2, pa3;
    ATT_PK4(p0, 0, pa0); ATT_PK4(p0, 8, pa1); ATT_PK4(p1, 0, pa2); ATT_PK4(p1, 8, pa3);
    pv_d0<true>(o, (int)(uintptr_t)(lds + R_V + cp * TILE_B) + v_rd_base(lane), pa0, pa1, pa2, pa3);
  }
  { f32x16 p0 = {}, p1 = {};
    qkt<false>(p0, p1, lds + R_K + c * TILE_B, qr, r32, hi);
#pragma unroll
    for (int r = 0; r < 16; ++r) { const int kl = crow(r, hi); const int d0 = qi > kl ? qi - kl : kl - qi; const int d1 = qi > kl + 32 ? qi - kl - 32 : kl + 32 - qi;
      p0[r] *= dtab[d0] * iq; p1[r] *= dtab[d1] * iq; }
    bf16x8 pa0, pa1, pa2, pa3;
    ATT_PK4(p0, 0, pa0); ATT_PK4(p0, 8, pa1); ATT_PK4(p1, 0, pa2); ATT_PK4(p1, 8, pa3);
    pv_d0<true>(o, (int)(uintptr_t)(lds + R_V + c * TILE_B) + v_rd_base(lane), pa0, pa1, pa2, pa3); }
  RT_STAMP(14);
  float s1 = 0.f;
#pragma unroll
  for (int d0 = 0; d0 < 4; ++d0)
#pragma unroll
    for (int r = 0; r < 16; ++r) s1 += o[d0][r];
  { auto rr = __builtin_amdgcn_permlane32_swap(__float_as_uint(s1), __float_as_uint(s1), false, false); s1 = __uint_as_float(rr[0]) + __uint_as_float(rr[1]); }
  const float mu = s1 * (1.f / 128.f); float s2 = 0.f;
#pragma unroll
  for (int d0 = 0; d0 < 4; ++d0)
#pragma unroll
    for (int r = 0; r < 16; ++r) { o[d0][r] -= mu; s2 += o[d0][r] * o[d0][r]; }
  { auto rr = __builtin_amdgcn_permlane32_swap(__float_as_uint(s2), __float_as_uint(s2), false, false); s2 = __uint_as_float(rr[0]) + __uint_as_float(rr[1]); }
  const float qd = __builtin_amdgcn_exp2f(lg2h * (float)(qi + 1));
  const float sc = qd / sqrtf(qd * qd * s2 * (1.f / 128.f) + 1e-5f);
  __syncthreads();
  { char* stg = lds + wid * 16384;
#pragma unroll
    for (int d0 = 0; d0 < 4; ++d0)
#pragma unroll
      for (int rq = 0; rq < 4; ++rq) { const int ch = 8 * d0 + 2 * rq + hi;
        const f32x4 y = {o[d0][4 * rq] * sc, o[d0][4 * rq + 1] * sc, o[d0][4 * rq + 2] * sc, o[d0][4 * rq + 3] * sc};
        *(f32x4*)(stg + r32 * 512 + ((ch ^ r32) << 4)) = y; }
    asm volatile("s_waitcnt lgkmcnt(0)" ::: "memory");
#pragma unroll
    for (int i = 0; i < 8; ++i) { const int row = i * 4 + (lane >> 4), c8 = lane & 15;
      const f32x4 ya = *(const f32x4*)(stg + row * 512 + (((2 * c8) ^ row) << 4)), yb = *(const f32x4*)(stg + row * 512 + (((2 * c8 + 1) ^ row) << 4));
      u32x4 w;
      w.x = cvtpk(ya[0] * ga[0] * __uint_as_float(gt[i].x << 16), ya[1] * ga[1] * __uint_as_float(gt[i].x & 0xffff0000u));
      w.y = cvtpk(ya[2] * ga[2] * __uint_as_float(gt[i].y << 16), ya[3] * ga[3] * __uint_as_float(gt[i].y & 0xffff0000u));
      w.z = cvtpk(yb[0] * gb[0] * __uint_as_float(gt[i].z << 16), yb[1] * gb[1] * __uint_as_float(gt[i].z & 0xffff0000u));
      w.w = cvtpk(yb[2] * gb[2] * __uint_as_float(gt[i].w << 16), yb[3] * gb[3] * __uint_as_float(gt[i].w & 0xffff0000u));
      *(u32x4*)(MIX + (row0g + row) * 2048 + h * 128 + c8 * 8) = w; } }
  __syncthreads(); RT_STAMP(15);
#undef RT_STAMP
}
}
#ifndef NAIVE_CONTRIB
#define NAIVE_CONTRIB 0
#endif
#ifndef NAIVE_RETOUT
#define NAIVE_RETOUT 0
#endif
#ifndef PROBE_REPEAT_MASK
#define PROBE_REPEAT_MASK 0
#endif
#ifndef PROBE_EXTRA_BARS
#define PROBE_EXTRA_BARS 0
#endif
#define REPS(k)
#ifndef RET_FUSED
#define RET_FUSED 0
#endif
#ifndef BAR_FLAT
#define BAR_FLAT 4
#endif
#ifndef P1_LOCAL
#define P1_LOCAL 1
#endif
#ifndef BAR_LOCAL
#define BAR_LOCAL 1
#endif
#ifndef CONV_C1
#define CONV_C1 18432
#endif
#ifndef CONV_C2
#define CONV_C2 18432
#endif
#ifndef CONV_C3
#define CONV_C3 18432
#endif
#ifndef CONV_WGS
#define CONV_WGS 32
#endif
#ifndef CV_PW
#define CV_PW 4
#endif
#ifndef PROBE_X
#define PROBE_X 0
#endif
#ifndef PROBE_XN
#define PROBE_XN 1
#endif
#ifndef PROBE_T
#define PROBE_T 0
#endif
#ifndef PROBE_TA
#define PROBE_TA 0
#endif
#ifndef PROBE_TB
#define PROBE_TB 8
#endif
#ifndef PROBE_TOFF
#define PROBE_TOFF 0
#endif
#ifndef PROBE_TQ
#define PROBE_TQ 1
#endif
#ifndef PROBE_TTHR
#define PROBE_TTHR 0
#endif
#ifndef WGM_P1
#define WGM_P1 8
#endif
#ifndef WGM_P5
#define WGM_P5 4
#endif
#ifndef WGM_P6
#define WGM_P6 2
#endif
#ifndef WGM_P7
#define WGM_P7 4
#endif
constexpr int NWAVES = 8;
#ifndef MK_N_LAUNCHES
#define MK_N_LAUNCHES 1
#endif
constexpr int PER_PHASE = 8;
constexpr int N_LAUNCHES = MK_N_LAUNCHES;

constexpr int BATCH = 2, SEQ = 4096, DM = 2048, M = BATCH * SEQ, NIN = 7168, DFF = 8192;
constexpr int CH = 64, NCH = SEQ / CH, NH = 8, HD = 128, LEFT = 8, RELSZ = 192;
constexpr float EPS = 1e-6f, GN_EPS = 1e-5f, LOG2E = 1.4426950408889634f;
constexpr int SEC_RQ = 0, SEC_RK = 1024, SEC_RV = 2048, SEC_RG = 3072, SEC_AQ = 4096, SEC_AK = 5120, SEC_AV = 6144;

constexpr size_t MiB = 1u << 20;
constexpr size_t WS_CTL = 0, CTL_ZERO_BYTES = 32768;
constexpr size_t WS_WOT = 1 * MiB, WS_W1T = 9 * MiB, WS_W2T = 41 * MiB, WS_WINT = 73 * MiB;
constexpr size_t WS_MIX = 73 * MiB;
constexpr size_t WS_PROJ = 105 * MiB;
constexpr size_t WS_PREV = 217 * MiB;
constexpr size_t WS_X1B = 217 * MiB;
constexpr size_t WS_CS = 249 * MiB;
constexpr size_t WS_ROWSS = 251 * MiB;
constexpr size_t WS_U = 73 * MiB;
constexpr size_t WS_CSSTEP = 252 * MiB;
constexpr size_t WS_RSTD1 = 252 * MiB + 4096;
constexpr size_t WS_END = 252 * MiB + 4096 + 32768;
static_assert(!RET_STORE_CONTRIB, "XN lives where the contribution tiles were");
constexpr size_t OUT_XN = 32 * MiB, OUT_CONTRIB = 32 * MiB, OUT_AGG = 0;
constexpr size_t OUT_PAD_ = 0;
static_assert(WS_U + (size_t)M * DFF * 2 <= WS_X1B && WS_WINT + (size_t)NIN * DM * 2 <= WS_PROJ && WS_PROJ + (size_t)M * NIN * 2 <= WS_PREV, "d_ws map");
constexpr int CW_TMO = 0, CW_CODE = 1;
constexpr int CW_BAR = 4096;
constexpr int CW_RDY = 2048;
constexpr int CW_CONV = 1024;

constexpr int RING_OFF = 0, RING_BYTES = 131072;
constexpr int XCH_OFF = RING_BYTES, XCH_BYTES = 8192;
constexpr int LDSCTL_OFF = XCH_OFF + XCH_BYTES, MISC_OFF = LDSCTL_OFF + 320;
constexpr int LDS_BYTES = 147456;
static_assert(MISC_OFF + 128 <= LDS_BYTES, "LDS map");

struct Frame {
    LAS unsigned char* lds;
    volatile LAS unsigned* MISC;
    gu32* ctl;
    int tid, lane, wave;
    int vcu, G;
};
__device__ __forceinline__ float wave_sum(float v) {
#pragma unroll
    for (int o = 1; o < 64; o <<= 1) v += __shfl_xor(v, o);
    return v;
}
__device__ __forceinline__ float wave_max(float v) {
#pragma unroll
    for (int o = 1; o < 64; o <<= 1) v = fmaxf(v, __shfl_xor(v, o));
    return v;
}
__device__ __forceinline__ float bf_lo(unsigned u) { return __uint_as_float(u << 16); }
__device__ __forceinline__ float bf_hi(unsigned u) { return __uint_as_float(u & 0xffff0000u); }

template <bool ROT, bool BLKOUT = false>
__device__ __forceinline__ void p0_transpose_item(const float* W, int K, int N, bf16* WT, LAS float* scr, int item, int lane) {
    const int nblk = N / 32, kb = item / nblk, nb = item % nblk, k0 = 64 * kb, n0 = 32 * nb;
    f32x4 v[8];
    { const float* p = W + (size_t)(k0 + (lane >> 3)) * N + n0 + 4 * (lane & 7);
#pragma unroll
      for (int i = 0; i < 8; ++i) v[i] = __builtin_nontemporal_load((const GAS f32x4*)(p + (size_t)(8 * i) * N)); }
#pragma unroll
    for (int i = 0; i < 8; ++i) { LAS float* d = scr + (8 * i + (lane >> 3)) * 33 + 4 * (lane & 7); d[0] = v[i].x; d[1] = v[i].y; d[2] = v[i].z; d[3] = v[i].w; }
    LDS_WAIT(); asm volatile("" ::: "memory");
    const int c = lane & 7;
#pragma unroll
    for (int j = 0; j < 4; ++j) { const int n = (lane >> 3) + 8 * j; const LAS float* s = scr + (8 * c) * 33 + n;
        v4u o; o.x = pk2(s[0 * 33], s[1 * 33]); o.y = pk2(s[2 * 33], s[3 * 33]); o.z = pk2(s[4 * 33], s[5 * 33]); o.w = pk2(s[6 * 33], s[7 * 33]);
        int row = n0 + n;
        if (ROT && row < 2048) { const int d = row & 127; row = (row & ~127) + 2 * (d & 63) + (d >> 6); }
        if (BLKOUT) *(GAS v4u*)((GAS char*)WT + ((size_t)(row >> 8) * (K / 64) + kb) * 32768 + (row & 255) * 128 + 16 * c) = o;
        else *(GAS v4u*)(WT + (size_t)row * K + k0 + 8 * c) = o; }
    LDS_WAIT(); asm volatile("" ::: "memory");
}

__device__ __forceinline__ void tr_load(const float* W, int N, int item, f32x4 (&v)[8], int lane) {
    const int nblk = N / 32, kb = item / nblk, nb = item % nblk;
    const float* p = W + (size_t)(64 * kb + (lane >> 3)) * N + 32 * nb + 4 * (lane & 7);
#pragma unroll
    for (int i = 0; i < 8; ++i) v[i] = __builtin_nontemporal_load((const GAS f32x4*)(p + (size_t)(8 * i) * N));
}
__device__ __forceinline__ void tr_load_g(const float* W, int N, int item, f32x4 (&v)[8], int lane, const float* g) {
    const int nblk = N / 32, kb = item / nblk, nb = item % nblk;
    const float* p = W + (size_t)(64 * kb + (lane >> 3)) * N + 32 * nb + 4 * (lane & 7);
    float gk[8];
#pragma unroll
    for (int i = 0; i < 8; ++i) gk[i] = g[64 * kb + 8 * i + (lane >> 3)];
#pragma unroll
    for (int i = 0; i < 8; ++i) v[i] = __builtin_nontemporal_load((const GAS f32x4*)(p + (size_t)(8 * i) * N));
#pragma unroll
    for (int i = 0; i < 8; ++i) v[i] *= gk[i];
}
template <bool ROT>
__device__ __forceinline__ void tr_finish(bf16* WT, int K, int N, int item, const f32x4 (&v)[8], LAS float* scr, int lane) {
    const int nblk = N / 32, kb = item / nblk, nb = item % nblk, k0 = 64 * kb, n0 = 32 * nb;
#pragma unroll
    for (int i = 0; i < 8; ++i) { LAS float* d = scr + (8 * i + (lane >> 3)) * 33 + 4 * (lane & 7); d[0] = v[i].x; d[1] = v[i].y; d[2] = v[i].z; d[3] = v[i].w; }
    LDS_WAIT(); asm volatile("" ::: "memory");
    const int c = lane & 7;
#pragma unroll
    for (int j = 0; j < 4; ++j) { const int n = (lane >> 3) + 8 * j; const LAS float* s = scr + (8 * c) * 33 + n;
        v4u o; o.x = pk2(s[0 * 33], s[1 * 33]); o.y = pk2(s[2 * 33], s[3 * 33]); o.z = pk2(s[4 * 33], s[5 * 33]); o.w = pk2(s[6 * 33], s[7 * 33]);
        int row = n0 + n;
        if (ROT && row < 2048) { const int d = row & 127; row = (row & ~127) + 2 * (d & 63) + (d >> 6); }
        *(GAS v4u*)(WT + (size_t)row * K + k0 + 8 * c) = o; }
    LDS_WAIT(); asm volatile("" ::: "memory");
}
struct CvMats { const float* w_out; const float* w1; const float* w2; bf16* WoT; bf16* W1T; bf16* W2T; const float* g2; };
constexpr int CV_I_O = (DM / 64) * (DM / 32), CV_I_1 = (DM / 64) * (DFF / 32), CV_I_2 = (DFF / 64) * (DM / 32);
__device__ __forceinline__ void cv_load(const CvMats& m, int r, f32x4 (&v)[8], int lane) {
    const float* W; int N, item;
    if (r < CV_I_O) { W = m.w_out; N = DM; item = r; } else if (r < CV_I_O + CV_I_1) { W = m.w1; N = DFF; item = r - CV_I_O; } else { W = m.w2; N = DM; item = r - CV_I_O - CV_I_1; }
    const int nblk = N / 32, kb = item / nblk, nb = item % nblk;
    const float* p = W + (size_t)(64 * kb + (lane >> 3)) * N + 32 * nb + 4 * (lane & 7);
#pragma unroll
    for (int i = 0; i < 8; ++i) v[i] = __builtin_nontemporal_load((const GAS f32x4*)(p + (size_t)(8 * i) * N));
    if (r >= CV_I_O && r < CV_I_O + CV_I_1) {
#pragma unroll
        for (int i = 0; i < 8; ++i) v[i] *= m.g2[64 * kb + 8 * i + (lane >> 3)];
    }
}
__device__ __forceinline__ void cv_finish(const CvMats& m, int r, const f32x4 (&v)[8], LAS float* scr, int lane) {
    bf16* WT; int K, N, item; bool blk = false;
    if (r < CV_I_O) { WT = m.WoT; K = DM; N = DM; item = r; } else if (r < CV_I_O + CV_I_1) { WT = m.W1T; K = DM; N = DFF; item = r - CV_I_O; } else { WT = m.W2T; K = DFF; N = DM; item = r - CV_I_O - CV_I_1; blk = true; }
    const int nblk = N / 32, kb = item / nblk, nb = item % nblk, k0 = 64 * kb, n0 = 32 * nb;
#pragma unroll
    for (int i = 0; i < 8; ++i) { LAS float* d = scr + (8 * i + (lane >> 3)) * 33 + 4 * (lane & 7); d[0] = v[i].x; d[1] = v[i].y; d[2] = v[i].z; d[3] = v[i].w; }
    LDS_WAIT(); asm volatile("" ::: "memory");
    const int c = lane & 7;
#pragma unroll
    for (int j = 0; j < 4; ++j) { const int n = (lane >> 3) + 8 * j; const LAS float* s = scr + (8 * c) * 33 + n;
        v4u o; o.x = pk2(s[0 * 33], s[1 * 33]); o.y = pk2(s[2 * 33], s[3 * 33]); o.z = pk2(s[4 * 33], s[5 * 33]); o.w = pk2(s[6 * 33], s[7 * 33]);
        const int row = n0 + n;
        if (blk) __builtin_nontemporal_store(o, (GAS v4u*)((GAS char*)WT + ((size_t)(row >> 8) * (K / 64) + kb) * 32768 + (row & 255) * 128 + 16 * c));
        else __builtin_nontemporal_store(o, (GAS v4u*)(WT + (size_t)row * K + k0 + 8 * c)); }
    LDS_WAIT(); asm volatile("" ::: "memory");
}
struct Args { const float* in[11]; float* out; unsigned char* ws; float lg[8]; int ph_lo, ph_hi, li, pad; };
#define LGSEL(h) ((h) == 0 ? args.lg[0] : (h) == 1 ? args.lg[1] : (h) == 2 ? args.lg[2] : (h) == 3 ? args.lg[3] : (h) == 4 ? args.lg[4] : (h) == 5 ? args.lg[5] : (h) == 6 ? args.lg[6] : args.lg[7])

__global__ void __launch_bounds__(NWAVES * 64, 2) hymba_fwd(Args args) {
    extern __shared__ __attribute__((aligned(16))) unsigned char lds[];
    Frame F;
    F.lds = (LAS unsigned char*)lds;
    F.MISC = (volatile LAS unsigned*)(F.lds + MISC_OFF);
    F.tid = threadIdx.x; F.lane = F.tid & 63; F.wave = __builtin_amdgcn_readfirstlane(F.tid >> 6);
    F.G = gridDim.x; { const int bx = blockIdx.x; F.vcu = (F.G % 8 == 0) ? (bx % 8) * (F.G / 8) + bx / 8 : bx; }
    unsigned char* ws = args.ws;
    F.ctl = (gu32*)(ws + WS_CTL);
    const float* x = args.in[0]; const float* g1 = args.in[1]; const float* w_in = args.in[2]; const float* gn = args.in[3];
    const float* qg = args.in[4]; const float* kg = args.in[5]; const float* relb = args.in[6]; const float* w_out = args.in[7];
    const float* g2 = args.in[8]; const float* w1 = args.in[9]; const float* w2 = args.in[10];
    float* out = args.out;
    bf16* WinT = (bf16*)(ws + WS_WINT); bf16* WoT = (bf16*)(ws + WS_WOT); bf16* W1T = (bf16*)(ws + WS_W1T); bf16* W2T = (bf16*)(ws + WS_W2T);
    bf16* MIX = (bf16*)(ws + WS_MIX); bf16* PROJ = (bf16*)(ws + WS_PROJ); bf16* PREV = (bf16*)(ws + WS_PREV); bf16* X1B = (bf16*)(ws + WS_X1B);
    float* CS = (float*)(ws + WS_CS); float* ROWSS = (float*)(ws + WS_ROWSS); bf16* U = (bf16*)(ws + WS_U);
    bf16* XN = (bf16*)((unsigned char*)out + OUT_XN); bf16* CONTRIB = (bf16*)((unsigned char*)out + OUT_CONTRIB); bf16* AGG = (bf16*)((unsigned char*)out + OUT_AGG);

    for (int u = F.tid; u < (LDS_BYTES - LDSCTL_OFF) / 4; u += NWAVES * 64) ((LAS unsigned*)(F.lds + LDSCTL_OFF))[u] = 0u;
    __syncthreads();
    XcdBarrier bar; bar.bar = (unsigned*)(F.ctl + CW_BAR); bar.x = 0; bar.st = nullptr;
    if (N_LAUNCHES != PER_PHASE && BAR_FLAT != 1) bar = xcd_barrier_post((unsigned*)(F.ctl + CW_BAR), F.MISC + 8);
    unsigned bgen = 0u, btot = 0u;
#define GRID_BAR(seam) do { if (N_LAUNCHES == PER_PHASE) { if (F.tid == 0) __hip_atomic_store(F.ctl + CW_TMO, 0xBADBA0u | (unsigned)(seam), RLX_AGENT); } \
    else if (BAR_FLAT == 1) { flat_barrier((unsigned*)(F.ctl + CW_BAR), ++bgen, (unsigned)F.G); } else if (BAR_FLAT == 2) { xcd_barrier2(bar, bgen++); } else if (BAR_FLAT == 3) { xcd_barrier3(bar, bgen++); } else if (BAR_FLAT == 4) { xcd_barrier4(bar, bgen++); ++btot; } else { xcd_barrier(bar); } } while (0)
static_assert(WGM_P5 == 4 && WGM_P6 == 2 && WGM_P7 == 4, "the XCD-local seams assume these tile walks (row panels 4x .. 4x+3 on XCD x in P5, P6 and P7)");
#define GRID_BAR_L(seam) do { if (BAR_LOCAL && N_LAUNCHES != PER_PHASE && BAR_FLAT == 4 && F.G == 256 && bar.st[2] == 1u) { xcd_barrier_local(bar, btot); ++btot; } else GRID_BAR(seam); } while (0)
    const int lo = args.ph_lo, hi = args.ph_hi;
#if PROBE_T
#define TSTAMP(k) do { if (blockIdx.x == 0 && F.tid == 0) { const unsigned long long t_ = __builtin_amdgcn_s_memrealtime(); F.MISC[32 + 2 * (k)] = (unsigned)t_; F.MISC[33 + 2 * (k)] = (unsigned)(t_ >> 32); } } while (0)
#else
#define TSTAMP(k) do { } while (0)
#endif
    TSTAMP(0);
#define IN(k) (lo <= (k) && (k) < hi)
#define BOTH(k) (IN(k) && IN((k) + 1))
    const int gw = F.vcu * NWAVES + F.wave, NGW = F.G * NWAVES;

    constexpr int I_IN = (DM / 64) * (NIN / 32), I_O = (DM / 64) * (DM / 32), I_1 = (DM / 64) * (DFF / 32), I_2 = (DFF / 64) * (DM / 32), NCONV = I_O + I_1 + I_2;
#define CONV_PULL(k) do { if (conv_lo[(k) + 1] > conv_lo[(k)]) { LAS float* scr_ = (LAS float*)(F.lds + RING_OFF + F.wave * 16384); const int lo_ = conv_lo[(k)], n_ = conv_lo[(k) + 1] - lo_; \
        for (;;) { __syncthreads();                                     \
            if (F.tid == 0) { unsigned t_ = __hip_atomic_load(F.ctl + CW_CONV + 64 * (k), RLX_AGENT); if ((int)t_ < n_) t_ = __hip_atomic_fetch_add(F.ctl + CW_CONV + 64 * (k), (unsigned)(8 * CV_PW), RLX_AGENT); F.MISC[16] = t_; } \
            __syncthreads(); const int b_ = (int)F.MISC[16]; if (b_ >= n_) break; \
            const int i0_ = b_ + F.wave * CV_PW, ne_ = (n_ - i0_) < CV_PW ? (n_ - i0_) : CV_PW;       \
            if (ne_ > 0) { f32x4 va_[8], vb_[8]; cv_load(cvm, lo_ + i0_, va_, F.lane); \
                for (int j_ = 0; j_ < ne_; j_ += 2) { if (j_ + 1 < ne_) cv_load(cvm, lo_ + i0_ + j_ + 1, vb_, F.lane); cv_finish(cvm, lo_ + i0_ + j_, va_, scr_, F.lane); \
                    if (j_ + 2 < ne_) cv_load(cvm, lo_ + i0_ + j_ + 2, va_, F.lane); if (j_ + 1 < ne_) cv_finish(cvm, lo_ + i0_ + j_ + 1, vb_, scr_, F.lane); } } } } } while (0)
    constexpr int conv_lo[5] = {0, CONV_C1, CONV_C2, CONV_C3, NCONV};
    const CvMats cvm{w_out, w1, w2, WoT, W1T, W2T, g2};

    if (IN(0)) { REPS(0) {
        LAS float* scr = (LAS float*)(F.lds + RING_OFF + F.wave * 16384);
        {
            f32x4 va[8], vb[8]; int it = gw;
            if (it < I_IN) tr_load_g(w_in, NIN, it, va, F.lane, g1);
            for (; it < I_IN; it += 2 * NGW) { const int it2 = it + NGW, it3 = it + 2 * NGW;
                if (it2 < I_IN) tr_load_g(w_in, NIN, it2, vb, F.lane, g1);
                tr_finish<true>(WinT, DM, NIN, it, va, scr, F.lane);
                if (it3 < I_IN) tr_load_g(w_in, NIN, it3, va, F.lane, g1);
                if (it2 < I_IN) tr_finish<true>(WinT, DM, NIN, it2, vb, scr, F.lane); }
        }
        {
            float* RSTD1 = (float*)(ws + WS_RSTD1);
            f32x4 va[8], vb[8]; int m = gw;
#define XN_LOAD(V, mm) do { const GAS f32x4* xr_ = (const GAS f32x4*)(x + (size_t)(mm) * DM) + F.lane; _Pragma("unroll") for (int j = 0; j < 8; ++j) V[j] = __builtin_nontemporal_load(&xr_[64 * j]); } while (0)
#define XN_FIN(V, mm) do { float s_ = 0.f; _Pragma("unroll") for (int j = 0; j < 8; ++j) s_ += (V[j].x * V[j].x + V[j].y * V[j].y) + (V[j].z * V[j].z + V[j].w * V[j].w); \
            const float rstd_ = 1.f / sqrtf(wave_sum(s_) * (1.f / DM) + EPS); GAS unsigned long long* o8_ = (GAS unsigned long long*)(XN + (size_t)(mm) * DM) + F.lane; \
            if (F.lane == 0) RSTD1[(mm)] = rstd_; \
            _Pragma("unroll") for (int j = 0; j < 8; ++j) { const f32x4 y_ = V[j]; \
                o8_[64 * j] = (unsigned long long)pk2(y_.x, y_.y) | ((unsigned long long)pk2(y_.z, y_.w) << 32); } } while (0)
            if (m < M) XN_LOAD(va, m);
            for (; m < M; m += 2 * NGW) { const int m2 = m + NGW, m3 = m + 2 * NGW;
                if (m2 < M) XN_LOAD(vb, m2);
                XN_FIN(va, m);
                if (m3 < M) XN_LOAD(va, m3);
                if (m2 < M) XN_FIN(vb, m2); }
#undef XN_LOAD
#undef XN_FIN
        }
        for (int i = (F.vcu * NWAVES * 64) + F.tid; i < (SEQ + 1) * 64; i += F.G * NWAVES * 64) {
            const int pos = (i >> 6) == SEQ ? 16 : (i >> 6), p = i & 63;
            const float invf = __builtin_amdgcn_exp2f(-(float)p * 0.20762050593046014f);
            const double rev = (double)pos * (double)invf * 0.15915494309189535;
            const float fr = (float)(rev - __builtin_floor(rev));
            float* dst = ((i >> 6) == SEQ) ? (float*)(ws + WS_CSSTEP) + 2 * p : CS + 2 * i;
            dst[0] = __builtin_amdgcn_cosf(fr); dst[1] = __builtin_amdgcn_sinf(fr);
        }
        }
        for (int eb = 0; eb < PROBE_EXTRA_BARS; ++eb) GRID_BAR(0);
        if (BOTH(0)) GRID_BAR(0);
        TSTAMP(1);
    }

    if (IN(1)) { REPS(1) {
        const int GG = (F.G > 64) ? F.G - CONV_WGS : F.G;
        if ((int)blockIdx.x < GG) {
        pg8::Gemm g{XN, WinT, M, NIN, DM}; pg8::OrderP1Local S; S.init(M, NIN, GG, (int)blockIdx.x, WGM_P1);
        S.loc = (P1_LOCAL && F.G == 256) ? 1 : 0; S.x = (int)blockIdx.x & 7; S.j = (int)blockIdx.x >> 3;
        pg8::EpiProj E{PROJ, CS, (const float*)(ws + WS_CSSTEP), qg, kg, (LAS float*)(F.lds + XCH_OFF), -1, (const float*)(ws + WS_RSTD1)};
        pg8::gemm_phase<pg8::EpiProj, pg8::OrderP1Local, true, true>(F.lds + RING_OFF, g, S, E);
        }
        CONV_PULL(0);
        }
        if (BOTH(1)) { if (P1_LOCAL) GRID_BAR_L(1); else GRID_BAR(1); }
        TSTAMP(2);
    }

    if (IN(2)) { REPS(2) {
#if RET_FUSED == 2
        for (int u = F.vcu; u < BATCH * NH * (NCH / 4); u += F.G)
            att::attn_unit3(u >> 7, (u >> 4) & 7, u & 15, PROJ, relb, MIX, (char*)lds + RING_OFF, (char*)lds + XCH_OFF);
#endif
#if NAIVE_CONTRIB
        for (int unit = F.vcu; unit < BATCH * NH * NCH; unit += F.G) {
            const int n = unit & 63, h = (unit >> 6) & 7, b = unit >> 9;
            const int dv = F.tid >> 2, dk0 = (F.tid & 3) * 32;
            const float lgh = LGSEL(h);
            float acc[32];
#pragma unroll
            for (int q = 0; q < 32; ++q) acc[q] = 0.f;
            const bf16* base = PROJ + (size_t)(b * SEQ + n * CH) * NIN + h * HD;
            for (int j = 0; j < CH; ++j) {
                const float kd = __builtin_amdgcn_exp2f(lgh * LOG2E * (float)(CH - 1 - j));
                const float vv = bf_lo((unsigned)base[(size_t)j * NIN + SEC_RV + dv]) * kd;
                const GAS v4u* kr = (const GAS v4u*)(base + (size_t)j * NIN + SEC_RK + dk0);
#pragma unroll
                for (int c = 0; c < 4; ++c) { const v4u k4 = kr[c];
                    acc[8 * c + 0] += vv * bf_lo(k4.x); acc[8 * c + 1] += vv * bf_hi(k4.x); acc[8 * c + 2] += vv * bf_lo(k4.y); acc[8 * c + 3] += vv * bf_hi(k4.y);
                    acc[8 * c + 4] += vv * bf_lo(k4.z); acc[8 * c + 5] += vv * bf_hi(k4.z); acc[8 * c + 6] += vv * bf_lo(k4.w); acc[8 * c + 7] += vv * bf_hi(k4.w); }
            }
            GAS v4u* o = (GAS v4u*)(CONTRIB + (size_t)unit * (HD * HD) + dv * HD + dk0);
#pragma unroll
            for (int c = 0; c < 4; ++c) { v4u w; w.x = pk2(acc[8 * c], acc[8 * c + 1]); w.y = pk2(acc[8 * c + 2], acc[8 * c + 3]); w.z = pk2(acc[8 * c + 4], acc[8 * c + 5]); w.w = pk2(acc[8 * c + 6], acc[8 * c + 7]); o[c] = w; }
        }
#else
        for (int u = F.vcu; u < BATCH * NH * (NCH / 4); u += F.G) {
            const int h = (u >> 4) & 7;
#if !RET_FUSED
            att::bf16x8 pk_[8], pv_[8];
            att::attn_unit3<true>(u >> 7, h, u & 15, PROJ, relb, MIX, (char*)lds + RING_OFF, (char*)lds + XCH_OFF, &pk_, &pv_);
            att::contrib_unit<true>(u >> 7, h, u & 15, PROJ, CONTRIB, AGG, (char*)lds + RING_OFF, LGSEL(h) * LOG2E, &pk_, &pv_);
#else
            att::contrib_unit(u >> 7, h, u & 15, PROJ, CONTRIB, AGG, (char*)lds + RING_OFF, LGSEL(h) * LOG2E);
#endif
#if RET_FUSED
            asm volatile("s_waitcnt vmcnt(0)" ::: "memory"); __syncthreads();
            if (F.tid == 0) { __builtin_amdgcn_fence(__ATOMIC_RELEASE, "agent"); asm volatile("s_waitcnt vmcnt(0)" ::: "memory");
                (void)__hip_atomic_fetch_add(F.ctl + CW_RDY + 64 * (u >> 4), 1u, RLX_AGENT); }
#endif
        }
#endif
#if RET_FUSED
        for (int u = F.vcu; RET_FUSED == 1 && u < BATCH * NH * (NCH / 4); u += F.G)
            att::attn_unit3(u >> 7, (u >> 4) & 7, u & 15, PROJ, relb, MIX, (char*)lds + RING_OFF, (char*)lds + XCH_OFF);
        for (int u = F.vcu; u < BATCH * NH * (NCH / 4); u += F.G) {
            const int h = (u >> 4) & 7;
            if (F.tid == 0) { unsigned sp_ = 0u;
                while (__hip_atomic_load(F.ctl + CW_RDY + 64 * (u >> 4), RLX_AGENT) < (unsigned)(NCH / 4)) { __builtin_amdgcn_s_sleep(1); if (++sp_ > (1u << 22)) { __hip_atomic_store(F.ctl + CW_TMO, 0xBADF1A6u, RLX_AGENT); break; } }
                __builtin_amdgcn_fence(__ATOMIC_ACQUIRE, "agent"); asm volatile("s_waitcnt vmcnt(0)" ::: "memory"); }
            __syncthreads();
            att::retout_unit4(u >> 7, h, (RT_PROBE && (u & ~15) == 0) ? 15 - (u & 15) : (u & 15), PROJ, AGG, CONTRIB, gn, MIX, (char*)lds + RING_OFF, (float*)((char*)lds + XCH_OFF), LGSEL(h) * LOG2E);
        }
#endif
        CONV_PULL(1);
        }
#if !RET_FUSED
        if (BOTH(2)) GRID_BAR_L(2);
#endif
        TSTAMP(3);
    }

    if (IN(3)) {
        TSTAMP(4);
    }

    if (IN(4)) { REPS(4) {
#if NAIVE_RETOUT
        LAS float* sl = (LAS float*)(F.lds + RING_OFF + F.wave * 4096);
        LAS float* ql = sl + 64;
        for (int t0 = gw * 32; t0 < M * NH; t0 += NGW * 32) {
            for (int tt = 0; tt < 32; ++tt) {
                const int t = t0 + tt;
                const int i = t & 63, n = (t >> 6) & 63, h = (t >> 12) & 7, b = t >> 15;
                const int r = b * SEQ + n * CH + i; const int unit = (b * NH + h) * NCH + n;
                const float lgh = LGSEL(h) * LOG2E;
                unsigned qp[64];
                { const GAS v4u* qrow = (const GAS v4u*)(PROJ + (size_t)r * NIN + SEC_RQ + h * HD);
#pragma unroll
                  for (int c = 0; c < 16; ++c) { const v4u q4 = qrow[c]; qp[4 * c] = q4.x; qp[4 * c + 1] = q4.y; qp[4 * c + 2] = q4.z; qp[4 * c + 3] = q4.w; } }
                { const unsigned q2 = *((const GAS unsigned*)(PROJ + (size_t)r * NIN + SEC_RQ + h * HD) + F.lane); ql[2 * F.lane] = bf_lo(q2); ql[2 * F.lane + 1] = bf_hi(q2); }
                {
                    const GAS v4u* krow = (const GAS v4u*)(PROJ + (size_t)(b * SEQ + n * CH + F.lane) * NIN + SEC_RK + h * HD);
                    float s = 0.f;
#pragma unroll
                    for (int c = 0; c < 16; ++c) { const v4u k4 = krow[c];
                        s += bf_lo(k4.x) * bf_lo(qp[4 * c]) + bf_hi(k4.x) * bf_hi(qp[4 * c]);
                        s += bf_lo(k4.y) * bf_lo(qp[4 * c + 1]) + bf_hi(k4.y) * bf_hi(qp[4 * c + 1]);
                        s += bf_lo(k4.z) * bf_lo(qp[4 * c + 2]) + bf_hi(k4.z) * bf_hi(qp[4 * c + 2]);
                        s += bf_lo(k4.w) * bf_lo(qp[4 * c + 3]) + bf_hi(k4.w) * bf_hi(qp[4 * c + 3]); }
                    const int dist = i > F.lane ? i - F.lane : F.lane - i;
                    sl[F.lane] = s * __builtin_amdgcn_exp2f(lgh * (float)dist);
                }
                LDS_WAIT(); asm volatile("" ::: "memory");
                float y0 = 0.f, y1 = 0.f;
                { const GAS unsigned* vb = (const GAS unsigned*)(PROJ + (size_t)(b * SEQ + n * CH) * NIN + SEC_RV + h * HD) + F.lane;
#pragma unroll 8
                  for (int j = 0; j < CH; ++j) { const float s = sl[j]; const unsigned v2 = vb[(size_t)j * (NIN / 2)]; y0 += s * bf_lo(v2); y1 += s * bf_hi(v2); } }
                {
                    const float qdec = __builtin_amdgcn_exp2f(lgh * (float)(i + 1));
                    const GAS v4u* pa = (const GAS v4u*)(PREV + (size_t)unit * (HD * HD) + (2 * F.lane) * HD);
                    float c0 = 0.f, c1 = 0.f;
#pragma unroll 4
                    for (int c = 0; c < 16; ++c) { const v4u a4 = pa[c], b4 = pa[16 + c]; const LAS float* q8 = ql + 8 * c;
                        c0 += bf_lo(a4.x) * q8[0] + bf_hi(a4.x) * q8[1] + bf_lo(a4.y) * q8[2] + bf_hi(a4.y) * q8[3] + bf_lo(a4.z) * q8[4] + bf_hi(a4.z) * q8[5] + bf_lo(a4.w) * q8[6] + bf_hi(a4.w) * q8[7];
                        c1 += bf_lo(b4.x) * q8[0] + bf_hi(b4.x) * q8[1] + bf_lo(b4.y) * q8[2] + bf_hi(b4.y) * q8[3] + bf_lo(b4.z) * q8[4] + bf_hi(b4.z) * q8[5] + bf_lo(b4.w) * q8[6] + bf_hi(b4.w) * q8[7]; }
                    y0 += qdec * c0; y1 += qdec * c1;
                }
                const float mu = wave_sum(y0 + y1) * (1.f / HD);
                const float d0 = y0 - mu, d1 = y1 - mu;
                const float var = wave_sum(d0 * d0 + d1 * d1) * (1.f / HD);
                const float rs = 1.f / sqrtf(var + GN_EPS);
                const float ga = gn[h * HD + 2 * F.lane], gb = gn[h * HD + 2 * F.lane + 1];
                const unsigned sg = *((const GAS unsigned*)(PROJ + (size_t)r * NIN + SEC_RG + h * HD) + F.lane);
                *((GAS unsigned*)(MIX + (size_t)r * DM + h * HD) + F.lane) = pk2(d0 * rs * ga * bf_lo(sg), d1 * rs * gb * bf_hi(sg));
                LDS_WAIT(); asm volatile("" ::: "memory");
            }
        }
#else
        for (int u = F.vcu; !RET_FUSED && u < BATCH * NH * (NCH / 4); u += F.G) {
            const int h = (u >> 4) & 7;
            att::retout_unit4(u >> 7, h, (RT_PROBE && (u & ~15) == 0) ? 15 - (u & 15) : (u & 15), PROJ, AGG, CONTRIB, gn, MIX, (char*)lds + RING_OFF, (float*)((char*)lds + XCH_OFF), LGSEL(h) * LOG2E);
        }
#endif
        CONV_PULL(3);
        }
        if (BOTH(4)) GRID_BAR(4);
        TSTAMP(5);
    }

    if (IN(5)) { REPS(5) {
        pg8::Gemm g{MIX, WoT, M, DM, DM}; pg8::StaticOrder S; S.init(M, DM, F.G, (int)blockIdx.x, WGM_P5);
        pg8::EpiOut E{XN, X1B, ROWSS, DM};
        pg8::gemm_phase<pg8::EpiOut, pg8::StaticOrder, true, true>(F.lds + RING_OFF, g, S, E);
        }
        if (BOTH(5)) GRID_BAR_L(5);
        TSTAMP(6);
    }

#define R2L_PREP() do { pg8::StaticOrder S7_; S7_.init(M, DM, F.G, (int)blockIdx.x, WGM_P7); pg8::Unit u7_; \
        if (S7_.next(0, u7_) && F.tid < 256) { const GAS f32x4* rs_ = (const GAS f32x4*)(ROWSS + (size_t)(u7_.pm * 256 + F.tid) * 32); f32x4 s4_ = rs_[0]; \
            _Pragma("unroll") for (int j = 1; j < 8; ++j) s4_ += rs_[j]; \
            ((LAS float*)(F.lds + XCH_OFF))[F.tid] = 1.0f / (((s4_[0] + s4_[1]) + (s4_[2] + s4_[3])) * (1.0f / DM) + EPS); } } while (0)
    if (IN(6)) { REPS(6) {
        pg8::Gemm g{X1B, W1T, M, DFF, DM}; pg8::StaticOrder S; S.init(M, DFF, F.G, (int)blockIdx.x, WGM_P6);
        pg8::EpiRelu2 E{U, DFF};
        pg8::gemm_phase<pg8::EpiRelu2, pg8::StaticOrder, true, true>(F.lds + RING_OFF, g, S, E);
        }
        if (BOTH(6)) GRID_BAR_L(6);
        TSTAMP(7);
    }

    if (IN(7)) {
        pg8::Gemm g{U, W2T, M, DM, DFF}; pg8::StaticOrder S; S.init(M, DM, F.G, (int)blockIdx.x, WGM_P7);
        LAS float* r2l = (LAS float*)(F.lds + XCH_OFF);
        pg8::Unit u0; u0.pm = -1; u0.pn = 0; S.next(0, u0);
        pg8::EpiFinal E{out, r2l, DM, ROWSS, u0.pm, X1B};
        pg8::gemm_phase<pg8::EpiFinal, pg8::StaticOrder, true, true, true>(F.lds + RING_OFF, g, S, E);
    }
#if PROBE_T
    if (IN(7)) { GRID_BAR(7); TSTAMP(8);
        if (blockIdx.x == 0 && F.tid == 0) {
            const unsigned long long ta = ((unsigned long long)F.MISC[33 + 2 * PROBE_TA] << 32) | F.MISC[32 + 2 * PROBE_TA], tb = ((unsigned long long)F.MISC[33 + 2 * PROBE_TB] << 32) | F.MISC[32 + 2 * PROBE_TB];
#if PROBE_TTHR
            out[0] += ((double)(tb - ta) * 0.01 > (double)PROBE_TTHR) ? 64.f : 32.f;
#else
            out[0] += (float)(PROBE_TQ * (int)((double)(tb - ta) * 0.01 / PROBE_TQ)) - (float)PROBE_TOFF;
#endif
        } }
#endif
#if PROBE_X
    if (IN(8)) {
#if PROBE_X == 1
        pg8::Gemm g{U, W2T, M, DM, DFF}; pg8::StaticOrder S; S.init(M, DM, F.G, (int)blockIdx.x);
        pg8::EpiNull E{ROWSS};
        pg8::gemm_phase<pg8::EpiNull, pg8::StaticOrder, true, true, true>(F.lds + RING_OFF, g, S, E);
#elif PROBE_X == 2
        pg8::Gemm g{U, W2T, M, DM, DFF}; pg8::StaticOrderA0 S; S.init(M, DM, F.G, (int)blockIdx.x);
        pg8::EpiNull E{ROWSS};
        pg8::gemm_phase<pg8::EpiNull, pg8::StaticOrderA0, true, true, true>(F.lds + RING_OFF, g, S, E);
#elif PROBE_X == 3
        pg8::Gemm g{X1B, W1T, M, DFF, DM}; pg8::StaticOrder S; S.init(M, DFF, F.G, (int)blockIdx.x);
        pg8::EpiNull E{ROWSS};
        pg8::gemm_phase<pg8::EpiNull, pg8::StaticOrder, true, true>(F.lds + RING_OFF, g, S, E);
#elif PROBE_X == 5
        pg8::Gemm g{U, W2T, M, DM, DFF}; pg8::StaticOrder S; S.init(M, DM, F.G, (int)blockIdx.x);
        LAS float* r2l = (LAS float*)(F.lds + XCH_OFF); pg8::Unit u0; u0.pm = -1; u0.pn = 0; S.next(0, u0);
        if (F.tid < 256) r2l[F.tid] = 0.f;
        __syncthreads();
        pg8::EpiFinal E{out, r2l, DM, ROWSS, u0.pm, X1B};
        pg8::gemm_phase<pg8::EpiFinal, pg8::StaticOrder, true, true, true>(F.lds + RING_OFF, g, S, E);
#elif PROBE_X == 6
        pg8::Gemm g{X1B, W1T, M, DFF, DM}; pg8::StaticOrder S; S.init(M, DFF, F.G, (int)blockIdx.x);
        pg8::EpiNull E{ROWSS};
        pg8::gemm_phase<pg8::EpiNull, pg8::StaticOrder, true, true, true>(F.lds + RING_OFF, g, S, E);
#elif PROBE_X == 7
        for (int u = F.vcu; u < BATCH * NH * (NCH / 4); u += F.G) att::attn_unit(u >> 7, (u >> 4) & 7, u & 15, PROJ, relb, MIX, (char*)lds + RING_OFF);
#elif PROBE_X == 8
        for (int u = F.vcu; u < BATCH * NH * (NCH / 4); u += F.G) { const int h = (u >> 4) & 7; att::contrib_unit(u >> 7, h, u & 15, PROJ, CONTRIB, AGG, (char*)lds + RING_OFF, LGSEL(h) * LOG2E); }
#elif PROBE_X >= 20 && PROBE_X <= 22
        for (int u = F.vcu; u < BATCH * NH * (NCH / 4); u += F.G) { const int h = (u >> 4) & 7; att::retout_unit<PROBE_X - 20>(u >> 7, h, u & 15, PROJ, PREV, gn, CONTRIB, (char*)lds + RING_OFF, (float*)((char*)lds + XCH_OFF), LGSEL(h) * LOG2E); }
#elif PROBE_X == 9
        for (int u = F.vcu; u < BATCH * NH * (NCH / 4); u += F.G) { const int h = (u >> 4) & 7; att::retout_unit(u >> 7, h, u & 15, PROJ, PREV, gn, MIX, (char*)lds + RING_OFF, (float*)((char*)lds + XCH_OFF), LGSEL(h) * LOG2E); }
#elif PROBE_X == 10
        if ((int)blockIdx.x < F.G - CONV_WGS) { pg8::Gemm g{XN, WinT, M, NIN, DM}; pg8::StaticOrder S; S.init(M, NIN, F.G - CONV_WGS, (int)blockIdx.x);
            pg8::EpiNull E{ROWSS};
            pg8::gemm_phase<pg8::EpiNull, pg8::StaticOrder, true, true>(F.lds + RING_OFF, g, S, E); }
#elif PROBE_X >= 11 && PROBE_X <= 14
        if ((int)blockIdx.x < F.G - CONV_WGS) { pg8::Gemm g{XN, WinT, M, NIN, DM}; pg8::StaticOrder S; S.init(M, NIN, F.G - CONV_WGS, (int)blockIdx.x);
            pg8::EpiProj E{PROJ, CS, (const float*)(ws + WS_CSSTEP), qg, kg, (LAS float*)(F.lds + XCH_OFF), PROBE_X == 11 ? -1 : PROBE_X == 12 ? 2 : PROBE_X == 13 ? 0 : 4, (const float*)(ws + WS_RSTD1)};
            pg8::gemm_phase<pg8::EpiProj, pg8::StaticOrder, true, true>(F.lds + RING_OFF, g, S, E); }
#elif PROBE_X == 4
        pg8::Gemm g{U, W2T, M, DM, DFF}; pg8::StaticOrder S; S.init(M, DM, F.G, (int)blockIdx.x);
        pg8::EpiNull E{ROWSS};
        pg8::gemm_phase<pg8::EpiNull, pg8::StaticOrder, true, false, true>(F.lds + RING_OFF, g, S, E);
#endif
    }
#endif
#undef IN
#undef BOTH
}

extern "C" void kernel_launch(void* const* d_in, const int* in_sizes, int n_in, void* d_out, int out_size, void* d_ws, size_t ws_size, hipStream_t stream) {
    static int grid = 0;
    if (grid == 0) {
        if (n_in != 11 || in_sizes[0] != M * DM || out_size != M * DM || ws_size < WS_END) { fprintf(stderr, "kernel_launch: shape/workspace mismatch: n_in %d in0 %d out %d ws %zu (need %zu)\n", n_in, n_in > 0 ? in_sizes[0] : -1, out_size, ws_size, (size_t)WS_END); grid = -1; return; }
        int dev = 0, cus = 0, per_cu = 0;
        if (hipGetDevice(&dev) != hipSuccess || hipDeviceGetAttribute(&cus, hipDeviceAttributeMultiprocessorCount, dev) != hipSuccess) { fprintf(stderr, "kernel_launch: device query failed\n"); grid = -1; return; }
        if (hipFuncSetAttribute((const void*)hymba_fwd, hipFuncAttributeMaxDynamicSharedMemorySize, LDS_BYTES) != hipSuccess) { fprintf(stderr, "kernel_launch: hipFuncSetAttribute failed\n"); grid = -1; return; }
        if (hipOccupancyMaxActiveBlocksPerMultiprocessor(&per_cu, (const void*)hymba_fwd, NWAVES * 64, LDS_BYTES) != hipSuccess || per_cu < 1)
            fprintf(stderr, "kernel_launch: note: occupancy query reports %d workgroups per CU\n", per_cu);
        (void)hipGetLastError();
        grid = cus;
    }
    if (grid < 0) return;
    if (hipMemsetAsync((char*)d_ws + WS_CTL, 0, CTL_ZERO_BYTES, stream) != hipSuccess) { fprintf(stderr, "kernel_launch: hipMemsetAsync failed\n"); return; }
    Args a{};
    for (int i = 0; i < 11; ++i) a.in[i] = (const float*)d_in[i];
    a.out = (float*)d_out; a.ws = (unsigned char*)d_ws;
    for (int h = 0; h < 8; ++h) a.lg[h] = (float)log1p(-exp2(-(5.0 + (double)h)));
    for (int li = 0; li < N_LAUNCHES; ++li) {
        a.ph_lo = (N_LAUNCHES == PER_PHASE) ? li : 0; a.ph_hi = (N_LAUNCHES == PER_PHASE) ? li + 1 : PER_PHASE; a.li = li;
        const int nrep = (N_LAUNCHES == PER_PHASE && ((PROBE_REPEAT_MASK >> li) & 1)) ? 2 : 1;
        for (int rep = 0; rep < nrep; ++rep) hipLaunchKernelGGL(hymba_fwd, dim3(grid), dim3(NWAVES * 64), LDS_BYTES, stream, a);
#if PROBE_X
        if (N_LAUNCHES == PER_PHASE && li == ((PROBE_X == 5 || (PROBE_X >= 11 && PROBE_X <= 14)) ? 7 : (PROBE_X == 7 || PROBE_X == 8) ? 2 : (PROBE_X == 9 || (PROBE_X >= 20 && PROBE_X <= 22)) ? 4 : PROBE_X == 10 ? 1 : 6)) { Args ax = a; ax.ph_lo = 8; ax.ph_hi = 9; for (int rep = 0; rep < PROBE_XN; ++rep) hipLaunchKernelGGL(hymba_fwd, dim3(grid), dim3(NWAVES * 64), LDS_BYTES, stream, ax); }
#endif
        const hipError_t le = hipPeekAtLastError();
        if (le != hipSuccess) { fprintf(stderr, "kernel_launch: launch %d failed: %s\n", li, hipGetErrorName(le)); break; }
    }
}
```
